# Optimizing an MI355X kernel written in HIP

```python
import math
import jax
import jax.numpy as jnp
from jax import lax
import numpy as np

D_MODEL = 1024
BATCH = 16
SEQ = 256
DEPTH = 4
DEC_BATCH = 4
DEC_SEQ = 2048
PAST_LEN = 256

GRID_W = 64
ROPE_BASE = 10000.0
EPS = 1e-6
Q_BLOCK = 128
CHUNK = 128
D_FF = 4 * D_MODEL
N_MOD = 6

H_A = 4
NOPE_A = 64
ROPE_A = 32
V_A = 64
Q_RANK = 256
KV_RANK = 128
H_B = 4
DH_B = 32
H_C = 8
P_C = 64
N_C = 64
G_C = 2
CONV_K = 5
D_INNER = H_C * P_C
CONV_DIM = D_INNER + 2 * G_C * N_C

SPLIT_SIZES = (Q_RANK, KV_RANK, ROPE_A, H_B * 2 * DH_B, H_B * 2 * DH_B, H_B * 2 * DH_B, D_INNER, CONV_DIM, 2 * H_C)
D_IN_PROJ = sum(SPLIT_SIZES)
MIX_WIDTH = H_A * V_A + H_B * 2 * DH_B + D_INNER

kernel_name = 'hybrid_mla_diff_ssd_flow_step'


def rmsnorm(x, g):
    xf = x.astype(jnp.float32)
    y = xf * lax.rsqrt(jnp.mean(xf * xf, axis=-1, keepdims=True) + EPS)
    return (y * g.astype(jnp.float32)).astype(x.dtype)


def grid_angles(n_tok, rot_dim):
    n_rows = n_tok // GRID_W
    rows = jnp.repeat(jnp.arange(n_rows, dtype=jnp.float32), GRID_W)
    cols = jnp.tile(jnp.arange(GRID_W, dtype=jnp.float32), n_rows)
    half = rot_dim // 2
    freqs = ROPE_BASE ** (-jnp.arange(0, half, 2, dtype=jnp.float32) / half)
    return rows[:, None] * freqs, cols[:, None] * freqs


def axial_rope(x, ang_r, ang_c):
    half = x.shape[-1] // 2
    extra = (1,) * (x.ndim - 3)

    def rot(xa, ang):
        m = xa.shape[-1] // 2
        cos = jnp.cos(ang).reshape(ang.shape[0], *extra, m)
        sin = jnp.sin(ang).reshape(ang.shape[0], *extra, m)
        x1 = xa[..., :m].astype(jnp.float32)
        x2 = xa[..., m:].astype(jnp.float32)
        return jnp.concatenate([x1 * cos - x2 * sin, x2 * cos + x1 * sin], axis=-1)

    out = jnp.concatenate([rot(x[..., :half], ang_r), rot(x[..., half:], ang_c)], axis=-1)
    return out.astype(x.dtype)


def to_query_blocks(q):
    b, n = q.shape[:2]
    return jnp.moveaxis(q.reshape(b, n // Q_BLOCK, Q_BLOCK, *q.shape[2:]), 1, 0)


def from_query_blocks(o):
    nb, b = o.shape[:2]
    return jnp.moveaxis(o, 0, 1).reshape(b, nb * Q_BLOCK, *o.shape[3:])


def softmax_attention(q, k, v):
    scale = q.shape[-1] ** -0.5
    kf = k.astype(jnp.float32)
    vf = v.astype(jnp.float32)

    def one_block(qb):
        s = jnp.einsum('bqhd,bkhd->bhqk', qb.astype(jnp.float32), kf) * scale
        p = jax.nn.softmax(s, axis=-1)
        return jnp.einsum('bhqk,bkhd->bqhd', p, vf)

    return from_query_blocks(lax.map(one_block, to_query_blocks(q))).astype(v.dtype)


def differential_attention(q, k, v, lam):
    scale = q.shape[-1] ** -0.5
    kf = k.astype(jnp.float32)
    vf = v.astype(jnp.float32)

    def one_block(qb):
        s = jnp.einsum('bqhmd,bkhmd->bmhqk', qb.astype(jnp.float32), kf) * scale
        p = jax.nn.softmax(s, axis=-1)
        w = p[:, 0] - lam * p[:, 1]
        return jnp.einsum('bhqk,bkhd->bqhd', w, vf)

    return from_query_blocks(lax.map(one_block, to_query_blocks(q))).astype(v.dtype)


def diff_lambda(p, layer):
    lam_init = 0.8 - 0.6 * math.exp(-0.3 * layer)
    lq1 = p['diff_lq1'].astype(jnp.float32)
    lk1 = p['diff_lk1'].astype(jnp.float32)
    lq2 = p['diff_lq2'].astype(jnp.float32)
    lk2 = p['diff_lk2'].astype(jnp.float32)
    lam = jnp.exp(jnp.sum(lq1 * lk1)) - jnp.exp(jnp.sum(lq2 * lk2)) + lam_init
    return lam, lam_init


def ssd_scan(x, dt, a_neg, b_in, c_in, h0):
    bsz, n = x.shape[:2]
    nc = n // CHUNK
    rep = H_C // G_C
    xc = x.astype(jnp.float32).reshape(bsz, nc, CHUNK, H_C, P_C)
    bc = jnp.repeat(b_in.astype(jnp.float32), rep, axis=2).reshape(bsz, nc, CHUNK, H_C, N_C)
    cc = jnp.repeat(c_in.astype(jnp.float32), rep, axis=2).reshape(bsz, nc, CHUNK, H_C, N_C)
    dtc = dt.reshape(bsz, nc, CHUNK, H_C)
    a_cum = jnp.cumsum(dtc * a_neg, axis=2)
    seg = a_cum[:, :, :, None, :] - a_cum[:, :, None, :, :]
    lower = jnp.tril(jnp.ones((CHUNK, CHUNK), dtype=bool))[:, :, None]
    decay_in = jnp.exp(jnp.where(lower, seg, -jnp.inf))
    scores = jnp.einsum('bcihn,bcjhn->bcijh', cc, bc) * decay_in
    y_diag = jnp.einsum('bcijh,bcjh,bcjhp->bcihp', scores, dtc, xc)
    decay_end = jnp.exp(a_cum[:, :, -1:, :] - a_cum)
    states = jnp.einsum('bcjhn,bcjh,bcjhp->bchpn', bc, decay_end * dtc, xc)
    chunk_decay = jnp.exp(a_cum[:, :, -1, :])

    def step(h, inp):
        dec, st = inp
        return dec[:, :, None, None] * h + st, h

    h_final, h_prev = lax.scan(step, h0.astype(jnp.float32),
                               (jnp.moveaxis(chunk_decay, 1, 0), jnp.moveaxis(states, 1, 0)))
    h_prev = jnp.moveaxis(h_prev, 0, 1)
    y_off = jnp.einsum('bcihn,bchpn->bcihp', cc, h_prev) * jnp.exp(a_cum)[..., None]
    return (y_diag + y_off).reshape(bsz, n, H_C, P_C), h_final


def dwconv(u, w, bias):
    out = lax.conv_general_dilated(u, w[:, None, :].astype(u.dtype), window_strides=(1,),
                                   padding=[(CONV_K // 2, CONV_K // 2)],
                                   dimension_numbers=('NWC', 'WIO', 'NWC'),
                                   feature_group_count=u.shape[-1])
    return out + bias


def ssm_mixer(z, xbc, dt_raw, p, h0):
    bsz, n = z.shape[:2]
    xbc = jax.nn.silu(dwconv(xbc, p['ssm_conv_w'], p['ssm_conv_b']))
    xs, b_in, c_in = jnp.split(xbc, [D_INNER, D_INNER + G_C * N_C], axis=-1)
    xs = xs.reshape(bsz, n, H_C, P_C)
    b_in = b_in.reshape(bsz, n, G_C, N_C)
    c_in = c_in.reshape(bsz, n, G_C, N_C)
    dt = jax.nn.softplus(dt_raw.astype(jnp.float32).reshape(bsz, n, 2, H_C)
                         + p['ssm_dt_bias'].astype(jnp.float32))
    a_neg = -jnp.exp(p['ssm_A_log'].astype(jnp.float32))
    y_f, h_f = ssd_scan(xs, dt[:, :, 0], a_neg[0], b_in, c_in, h0[:, 0])
    y_b, h_b = ssd_scan(xs[:, ::-1], dt[:, ::-1, 1], a_neg[1], b_in[:, ::-1], c_in[:, ::-1], h0[:, 1])
    y = y_f + y_b[:, ::-1] + p['ssm_D'].astype(jnp.float32)[:, None] * xs.astype(jnp.float32)
    y = y.reshape(bsz, n, D_INNER) * jax.nn.silu(z.astype(jnp.float32))
    y = rmsnorm(y, p['ssm_norm_g']).astype(z.dtype)
    return y, jnp.stack([h_f, h_b], axis=1)


def mla_expand(ckv, krope, p):
    bsz, n = ckv.shape[:2]
    kv = (ckv @ p['w_ukv']).reshape(bsz, n, H_A, NOPE_A + V_A)
    k_nope, v = kv[..., :NOPE_A], kv[..., NOPE_A:]
    k_rope = jnp.broadcast_to(krope[:, :, None, :], (bsz, n, H_A, ROPE_A))
    k = rmsnorm(jnp.concatenate([k_nope, k_rope], axis=-1), p['mla_qk_norm_k'])
    return k, v


def rope_tail(x, ang_r, ang_c):
    return jnp.concatenate([x[..., :NOPE_A], axial_rope(x[..., NOPE_A:], ang_r, ang_c)], axis=-1)


def mixing_sublayer(h, p, layer, ctx):
    bsz, n, _ = h.shape
    offs = np.cumsum(SPLIT_SIZES)[:-1].tolist()
    cq, ckv, krope, dq, dk, dv, z, xbc, dt_raw = jnp.split(h @ p['w_in'], offs, axis=-1)
    q_a = (rmsnorm(cq, p['mla_q_norm_g']) @ p['w_uq']).reshape(bsz, n, H_A, NOPE_A + ROPE_A)
    q_a = rmsnorm(q_a, p['mla_qk_norm_q'])
    ckv = rmsnorm(ckv, p['mla_kv_norm_g'])
    k_a, v_a = mla_expand(ckv, krope, p)
    q_d = rmsnorm(dq.reshape(bsz, n, H_B, 2, DH_B), p['diff_q_norm_g'])
    k_d = rmsnorm(dk.reshape(bsz, n, H_B, 2, DH_B), p['diff_k_norm_g'])
    v_d = dv.reshape(bsz, n, H_B, 2 * DH_B)
    if ctx is None:
        ctx_out = (ckv, krope, k_d.reshape(bsz, n, H_B, 2 * DH_B), v_d)
        h0 = jnp.zeros((bsz, 2, H_C, P_C, N_C), jnp.float32)
    else:
        ckv_c, krope_c, kd_c, vd_c, h0 = ctx
        ang_r, ang_c = grid_angles(n, ROPE_A)
        q_a = rope_tail(q_a, ang_r, ang_c)
        k_a = rope_tail(k_a, ang_r, ang_c)
        q_d = axial_rope(q_d, ang_r, ang_c)
        k_d = axial_rope(k_d, ang_r, ang_c)
        k_ac, v_ac = mla_expand(ckv_c, krope_c, p)
        k_a = jnp.concatenate([k_ac, k_a], axis=1)
        v_a = jnp.concatenate([v_ac, v_a], axis=1)
        k_d = jnp.concatenate([kd_c.reshape(bsz, -1, H_B, 2, DH_B), k_d], axis=1)
        v_d = jnp.concatenate([vd_c, v_d], axis=1)
        ctx_out = None
    o_a = softmax_attention(q_a, k_a, v_a).reshape(bsz, n, H_A * V_A)
    lam, lam_init = diff_lambda(p, layer)
    o_d = differential_attention(q_d, k_d, v_d, lam)
    o_d = (rmsnorm(o_d, p['diff_subln_g']) * (1.0 - lam_init)).reshape(bsz, n, H_B * 2 * DH_B)
    o_c, h_last = ssm_mixer(z, xbc, dt_raw, p, h0)
    out = jnp.concatenate([o_a, o_d, o_c], axis=-1) @ p['w_out']
    if ctx is None:
        return out, (ctx_out[0], ctx_out[1], ctx_out[2], ctx_out[3], h_last)
    return out, None


def trunk_layer(x, mod, p, layer, ctx):
    shift1, scale1, gate1, shift2, scale2, gate2 = jnp.split(mod, N_MOD, axis=-1)
    h = rmsnorm(x, p['norm1_g']) * (1.0 + scale1) + shift1
    mix, ctx_out = mixing_sublayer(h, p, layer, ctx)
    x = x + gate1 * mix
    h = rmsnorm(x, p['norm2_g']) * (1.0 + scale2) + shift2
    u = jnp.square(jax.nn.relu(h @ p['w_ff1']))
    x = x + gate2 * (u @ p['w_ff2'])
    return x, ctx_out


def setup_inputs(seed: int = 0) -> dict:
    key = jax.random.key(seed)
    ks = iter(jax.random.split(key, 40))

    def nrm(shape, scale):
        return jax.random.normal(next(ks), shape, jnp.float32) * scale

    def gain(shape):
        return 1.0 + 0.02 * jax.random.normal(next(ks), shape, jnp.float32)

    dt0 = jnp.exp(jax.random.uniform(next(ks), (DEPTH, 2, H_C), jnp.float32,
                                     minval=math.log(1e-3), maxval=math.log(1e-1)))
    return {
        'x_prompt': nrm((BATCH, SEQ, D_MODEL), 1.0),
        'x_sample': nrm((DEC_BATCH, DEC_SEQ, D_MODEL), 1.0),
        'cache_mla_ckv': nrm((DEC_BATCH, DEPTH, PAST_LEN, KV_RANK), 1.0),
        'cache_mla_krope': nrm((DEC_BATCH, DEPTH, PAST_LEN, ROPE_A), 1.0),
        'cache_diff_k': nrm((DEC_BATCH, DEPTH, PAST_LEN, H_B, 2 * DH_B), 1.0),
        'cache_diff_v': nrm((DEC_BATCH, DEPTH, PAST_LEN, H_B, 2 * DH_B), 1.0),
        'state_ssm': nrm((DEC_BATCH, DEPTH, 2, H_C, P_C, N_C), 0.1),
        'c': nrm((DEC_BATCH, D_MODEL), 1.0),
        'c_ctx': nrm((D_MODEL,), 1.0),
        'norm1_g': gain((DEPTH, D_MODEL)),
        'norm2_g': gain((DEPTH, D_MODEL)),
        'w_ada': nrm((DEPTH, D_MODEL, N_MOD * D_MODEL), D_MODEL ** -0.5),
        'b_ada': nrm((DEPTH, N_MOD * D_MODEL), 0.01),
        'w_in': nrm((DEPTH, D_MODEL, D_IN_PROJ), D_MODEL ** -0.5),
        'w_out': nrm((DEPTH, MIX_WIDTH, D_MODEL), MIX_WIDTH ** -0.5),
        'mla_q_norm_g': gain((DEPTH, Q_RANK)),
        'mla_kv_norm_g': gain((DEPTH, KV_RANK)),
        'w_uq': nrm((DEPTH, Q_RANK, H_A * (NOPE_A + ROPE_A)), Q_RANK ** -0.5),
        'w_ukv': nrm((DEPTH, KV_RANK, H_A * (NOPE_A + V_A)), KV_RANK ** -0.5),
        'mla_qk_norm_q': gain((DEPTH, NOPE_A + ROPE_A)),
        'mla_qk_norm_k': gain((DEPTH, NOPE_A + ROPE_A)),
        'diff_q_norm_g': gain((DEPTH, DH_B)),
        'diff_k_norm_g': gain((DEPTH, DH_B)),
        'diff_lq1': nrm((DEPTH, DH_B), 0.1),
        'diff_lk1': nrm((DEPTH, DH_B), 0.1),
        'diff_lq2': nrm((DEPTH, DH_B), 0.1),
        'diff_lk2': nrm((DEPTH, DH_B), 0.1),
        'diff_subln_g': gain((DEPTH, 2 * DH_B)),
        'ssm_conv_w': nrm((DEPTH, CONV_K, CONV_DIM), CONV_K ** -0.5),
        'ssm_conv_b': nrm((DEPTH, CONV_DIM), 0.01),
        'ssm_A_log': jnp.log(jax.random.uniform(next(ks), (DEPTH, 2, H_C), jnp.float32, minval=1.0, maxval=16.0)),
        'ssm_dt_bias': dt0 + jnp.log(-jnp.expm1(-dt0)),
        'ssm_D': gain((DEPTH, H_C)),
        'ssm_norm_g': gain((DEPTH, D_INNER)),
        'w_ff1': nrm((DEPTH, D_MODEL, D_FF), D_MODEL ** -0.5),
        'w_ff2': nrm((DEPTH, D_FF, D_MODEL), D_FF ** -0.5),
    }


def reference(x_prompt, x_sample, cache_mla_ckv, cache_mla_krope, cache_diff_k, cache_diff_v, state_ssm,
              c, c_ctx, norm1_g, norm2_g, w_ada, b_ada, w_in, w_out, mla_q_norm_g, mla_kv_norm_g,
              w_uq, w_ukv, mla_qk_norm_q, mla_qk_norm_k, diff_q_norm_g, diff_k_norm_g,
              diff_lq1, diff_lk1, diff_lq2, diff_lk2, diff_subln_g, ssm_conv_w, ssm_conv_b,
              ssm_A_log, ssm_dt_bias, ssm_D, ssm_norm_g, w_ff1, w_ff2):
    xp = x_prompt
    xs = x_sample
    ckv_l, krope_l, kd_l, vd_l, st_l = [], [], [], [], []
    for l in range(DEPTH):
        p = dict(norm1_g=norm1_g[l], norm2_g=norm2_g[l], w_in=w_in[l], w_out=w_out[l],
                 mla_q_norm_g=mla_q_norm_g[l], mla_kv_norm_g=mla_kv_norm_g[l], w_uq=w_uq[l], w_ukv=w_ukv[l],
                 mla_qk_norm_q=mla_qk_norm_q[l], mla_qk_norm_k=mla_qk_norm_k[l],
                 diff_q_norm_g=diff_q_norm_g[l], diff_k_norm_g=diff_k_norm_g[l],
                 diff_lq1=diff_lq1[l], diff_lk1=diff_lk1[l], diff_lq2=diff_lq2[l], diff_lk2=diff_lk2[l],
                 diff_subln_g=diff_subln_g[l], ssm_conv_w=ssm_conv_w[l], ssm_conv_b=ssm_conv_b[l],
                 ssm_A_log=ssm_A_log[l], ssm_dt_bias=ssm_dt_bias[l], ssm_D=ssm_D[l], ssm_norm_g=ssm_norm_g[l],
                 w_ff1=w_ff1[l], w_ff2=w_ff2[l])
        mod_ctx = (jax.nn.silu(c_ctx) @ w_ada[l] + b_ada[l])[None, None, :]
        xp, (ckv, krope, kd, vd, st) = trunk_layer(xp, mod_ctx, p, l, None)
        ckv_l.append(ckv)
        krope_l.append(krope)
        kd_l.append(kd)
        vd_l.append(vd)
        st_l.append(st)
        mod_lat = (jax.nn.silu(c) @ w_ada[l] + b_ada[l])[:, None, :]
        xs, _ = trunk_layer(xs, mod_lat, p, l,
                            (cache_mla_ckv[:, l], cache_mla_krope[:, l], cache_diff_k[:, l],
                             cache_diff_v[:, l], state_ssm[:, l]))
    new_mla_ckv = jnp.stack(ckv_l, axis=1)
    new_mla_krope = jnp.stack(krope_l, axis=1)
    new_diff_k = jnp.stack(kd_l, axis=1)
    new_diff_v = jnp.stack(vd_l, axis=1)
    new_ssm_state = jnp.stack(st_l, axis=1)
    return (xp, xs, new_mla_ckv, new_mla_krope, new_diff_k, new_diff_v, new_ssm_state)
```

```cpp
#include <hip/hip_runtime.h>
#include <hip/hip_cooperative_groups.h>
#include <stdint.h>
#include <stdio.h>
namespace cg = cooperative_groups;

#ifndef MULTI_LAUNCH
#define MULTI_LAUNCH 0
#endif

#define DI __device__ __forceinline__
#define LAS __attribute__((address_space(3)))
typedef unsigned short bf16_t;
typedef short bf16x8 __attribute__((ext_vector_type(8)));
typedef short s16x4 __attribute__((ext_vector_type(4)));
typedef float f32x16 __attribute__((ext_vector_type(16)));
typedef float f32x4 __attribute__((ext_vector_type(4)));
typedef unsigned u32x4 __attribute__((ext_vector_type(4)));
typedef unsigned u32x2 __attribute__((ext_vector_type(2)));
#define MFMA32(a, b, c) __builtin_amdgcn_mfma_f32_32x32x16_bf16((a), (b), (c), 0, 0, 0)

constexpr int D = 1024, TP = 4096, TS = 8192, T = 12288, DEPTH = 4, PAST = 256;
constexpr int NPROJ = 2480, NPROJP = 2560, DFF = 4096;
constexpr int NKEY = 4096 + 4 * 2304;
constexpr int C_CQ = 0, C_CKV = 256, C_KR = 384, C_DQ = 416, C_DK = 672, C_DV = 928, C_Z = 1184, C_XBC = 1696, C_DT = 2464;
constexpr float EPS = 1e-6f;
constexpr int NCHUNK = 96;

constexpr size_t O_Y = 0, O_CKV = 12582912, O_KROPE = 14680064, O_DK = 15204352, O_DV = 19398656, O_SSM = 23592960;

constexpr size_t OFF_BAR = 0;
constexpr size_t OFF_XRANK = 14080;
constexpr size_t OFF_CTR = 14336;
constexpr size_t OFF_LAM = 15360;
constexpr size_t OFF_MOD = 16384;
constexpr size_t OFF_ROPE = OFF_MOD + 4ull * 5 * 6144 * 4;
constexpr size_t OFF_WIN = OFF_ROPE + 2048ull * 32 * 4;
constexpr size_t OFF_WOUT = OFF_WIN + 4ull * NPROJP * 1024 * 2;
constexpr size_t OFF_WFF1 = OFF_WOUT + 4ull * 1024 * 1024 * 2;
constexpr size_t OFF_WFF2 = OFF_WFF1 + 4ull * 4096 * 1024 * 2;
constexpr size_t OFF_WUQ = OFF_WFF2 + 4ull * 4096 * 1024 * 2;
constexpr size_t OFF_WUKV = OFF_WUQ + 4ull * 384 * 256 * 2;
constexpr size_t OFF_HBUF = OFF_WUKV + 4ull * 512 * 128 * 2;
constexpr size_t OFF_MIX = OFF_HBUF + (size_t)T * 1024 * 2;
constexpr size_t OFF_DT = OFF_MIX + (size_t)T * 1024 * 2;
constexpr size_t OFF_R = OFF_DT + (size_t)T * 16 * 4;
constexpr size_t OFF_UBUF = OFF_R;
constexpr size_t OFF_PROJ = OFF_R;
constexpr size_t OFF_QA = OFF_PROJ + (size_t)T * NPROJP * 2;
constexpr size_t OFF_KA = OFF_QA + (size_t)T * 384 * 2;
constexpr size_t OFF_VAT = OFF_KA + (size_t)NKEY * 384 * 2;
constexpr size_t OFF_QD = OFF_VAT + 256ull * NKEY * 2;
constexpr size_t OFF_KD = OFF_QD + (size_t)T * 256 * 2;
constexpr size_t OFF_VDT = OFF_KD + (size_t)NKEY * 256 * 2;
constexpr size_t OFF_XBC = OFF_VDT + 256ull * NKEY * 2;
constexpr size_t OFF_ST = OFF_XBC + (size_t)T * 768 * 2;
constexpr size_t OFF_HP = OFF_ST + 96ull * 8 * 2 * 4096 * 4;
constexpr size_t OFF_CDEC = OFF_HP + 96ull * 8 * 2 * 4096 * 2;
constexpr size_t OFF_XB = OFF_CDEC + 96ull * 16 * 4;
constexpr size_t WS_END = OFF_XB + (size_t)T * 1024 * 2;

struct Params {
  const float* in[36];
  float* out;
  char* ws;
  int ph_begin, ph_end;
};

DI unsigned pk2(float lo, float hi) { unsigned r; asm("v_cvt_pk_bf16_f32 %0, %1, %2" : "=v"(r) : "v"(lo), "v"(hi)); return r; }
DI float bflo(unsigned u) { return __uint_as_float(u << 16); }
DI float bfhi(unsigned u) { return __uint_as_float(u & 0xffff0000u); }
DI float bf1(bf16_t h) { return __uint_as_float(((unsigned)h) << 16); }
DI bf16_t f2bf(float x) { return (bf16_t)(pk2(x, 0.f) & 0xffffu); }
DI int crow(int r, int half) { return (r & 3) + 8 * (r >> 2) + 4 * half; }
DI float xor32(float v) { return __shfl_xor(v, 32); }
DI float wave_sum(float v) {
#pragma unroll
  for (int o = 32; o > 0; o >>= 1) v += __shfl_xor(v, o);
  return v;
}
DI f32x16 zero16() { f32x16 z; for (int i = 0; i < 16; ++i) z[i] = 0.f; return z; }
DI int get_tid() { int t = threadIdx.x; asm volatile("" : "+v"(t)); return t; }
DI int get_tid4() { return get_tid() & 255; }
DI int get_hb() { return get_tid() >> 8; }
DI int modrow_of(int m) { return m < TP ? 0 : 1 + ((m - TP) >> 11); }

#define XB_TMO      128
#define XB_XCNT(j)  (256  + 64 * (j))
#define XB_XSUB(j)  (1280 + 64 * (j))
#define XB_XGEN(j)  (2304 + 64 * (j))
#define XB_TOP      3328
#define XB_TOPGEN   3392
#define XCD_BAR_WORDS 3456
#define XB_SPIN_CAP (1u << 22)
DI unsigned xb_ld(unsigned* p) { return __hip_atomic_load(p, __ATOMIC_RELAXED, __HIP_MEMORY_SCOPE_AGENT); }
DI unsigned xb_add(unsigned* p, unsigned v) { return __hip_atomic_fetch_add(p, v, __ATOMIC_RELAXED, __HIP_MEMORY_SCOPE_AGENT); }
DI unsigned xb_xcc_id() { return (unsigned)__builtin_amdgcn_s_getreg((3 << 11) | 20) & 0xFu; }
#define XB_SPIN(cond, bar) do { unsigned _sp = 0; while (cond) { __builtin_amdgcn_s_sleep(1); \
    if ((++_sp & 255u) == 0u) { if (xb_ld(&(bar)[XB_TMO])) break; if (_sp > XB_SPIN_CAP) { atomicAdd(&(bar)[XB_TMO], 1u); break; } } } } while (0)
struct XcdBarrier { unsigned* bar; unsigned x; volatile LAS unsigned* st; };
DI XcdBarrier xcd_barrier_post(unsigned* bar, volatile LAS unsigned* st) {
  XcdBarrier b; b.bar = bar; b.x = xb_xcc_id(); b.st = st;
  if (threadIdx.x == 0) (void)xb_add(&bar[XB_XCNT(b.x)], 1u);
  return b;
}
DI void xcd_barrier_complete(unsigned* bar, unsigned x, unsigned& nloc, unsigned& nx) {
  const unsigned G = gridDim.x * gridDim.y * gridDim.z;
  unsigned sum, cnt, mine, sp = 0u;
  for (;;) {
    sum = 0u; cnt = 0u; mine = 0u;
#pragma unroll
    for (unsigned j = 0; j < 16; ++j) { const unsigned c = xb_ld(&bar[XB_XCNT(j)]); sum += c; cnt += (c > 0u) ? 1u : 0u; mine = (j == x) ? c : mine; }
    if (sum == G) break;
    __builtin_amdgcn_s_sleep(1);
    if ((++sp & 255u) == 0u) { if (xb_ld(&bar[XB_TMO])) break; if (sp > XB_SPIN_CAP) { atomicAdd(&bar[XB_TMO], 1u); break; } }
  }
  nloc = mine > 0u ? mine : 1u; nx = cnt > 0u ? cnt : 1u;
}
DI void xcd_barrier(const XcdBarrier& b) {
  asm volatile("s_waitcnt vmcnt(0)" ::: "memory");
  __syncthreads();
  if (threadIdx.x == 0) {
    unsigned* bar = b.bar;
    __builtin_amdgcn_s_waitcnt(0);
    unsigned nloc = b.st[0], nx = b.st[1];
    if (nloc == 0u) { xcd_barrier_complete(bar, b.x, nloc, nx); b.st[0] = nloc; b.st[1] = nx; }
    const unsigned old = xb_add(&bar[XB_XSUB(b.x)], 1u);
    const unsigned gen = old / nloc;
    if (old + 1u == (gen + 1u) * nloc) {
      __builtin_amdgcn_fence(__ATOMIC_RELEASE, "agent");
      asm volatile("s_waitcnt vmcnt(0)" ::: "memory");
      const unsigned og = xb_add(&bar[XB_TOP], 1u);
      const unsigned tg = og / nx;
      if (og + 1u == (tg + 1u) * nx) xb_add(&bar[XB_TOPGEN], 1u);
      else XB_SPIN(xb_ld(&bar[XB_TOPGEN]) == tg, bar);
      __builtin_amdgcn_fence(__ATOMIC_ACQUIRE, "agent");
      xb_add(&bar[XB_XGEN(b.x)], 1u);
      asm volatile("s_waitcnt vmcnt(0)" ::: "memory");
    } else {
      XB_SPIN(xb_ld(&bar[XB_XGEN(b.x)]) == gen, bar);
      __builtin_amdgcn_fence(__ATOMIC_ACQUIRE, "agent");
      asm volatile("s_waitcnt vmcnt(0)" ::: "memory");
    }
  }
  __syncthreads();
}

constexpr int HALF_LDS = 75776;
constexpr int LDS_BYTES = 2 * HALF_LDS;
constexpr int PITCH64 = 144;
constexpr int PITCH128 = 272;
constexpr int PITCH96 = 208;

DI void transpose_tile4(const float* src, int K, int N, bf16_t* dst, int t0, int ncols, char* lds) {
  float* tile = (float*)lds;
  const int tid = get_tid4();
  f32x4 v[4][4];
#pragma unroll
  for (int q = 0; q < 4; ++q) {
    const int k0 = ((t0 + q) / ncols) * 64, n0 = ((t0 + q) % ncols) * 64;
#pragma unroll
    for (int i = 0; i < 4; ++i) {
      const int r = (tid >> 4) + 16 * i, c4 = (tid & 15) * 4;
      v[q][i] = (f32x4){0.f, 0.f, 0.f, 0.f};
      if (n0 + c4 < N) v[q][i] = *(const f32x4*)(src + (size_t)(k0 + r) * N + n0 + c4);
    }
  }
  __syncthreads();
#pragma unroll
  for (int q = 0; q < 4; ++q)
#pragma unroll
    for (int i = 0; i < 4; ++i) {
      const int r = (tid >> 4) + 16 * i, c4 = (tid & 15) * 4;
      float* t = tile + q * (64 * 65) + r * 65 + c4;
      t[0] = v[q][i][0]; t[1] = v[q][i][1]; t[2] = v[q][i][2]; t[3] = v[q][i][3];
    }
  __syncthreads();
#pragma unroll
  for (int q = 0; q < 4; ++q) {
    const int k0 = ((t0 + q) / ncols) * 64, n0 = ((t0 + q) % ncols) * 64;
    const float* tq = tile + q * (64 * 65);
#pragma unroll
    for (int i = 0; i < 2; ++i) {
      const int n = (tid >> 3) + 32 * i, kc = (tid & 7) * 8;
      u32x4 w;
      w[0] = pk2(tq[(kc + 0) * 65 + n], tq[(kc + 1) * 65 + n]);
      w[1] = pk2(tq[(kc + 2) * 65 + n], tq[(kc + 3) * 65 + n]);
      w[2] = pk2(tq[(kc + 4) * 65 + n], tq[(kc + 5) * 65 + n]);
      w[3] = pk2(tq[(kc + 6) * 65 + n], tq[(kc + 7) * 65 + n]);
      *(u32x4*)(dst + (size_t)(n0 + n) * K + k0 + kc) = w;
    }
  }
}

DI void mod_item(const Params& p, int item, char* lds) {
  float* sc = (float*)lds;
  float* red = sc + 5 * 1024;
  const int tid = get_tid4(), lane = tid & 63, w = tid >> 6;
  const int l = item / 96, j0 = (item % 96) * 64;
  __syncthreads();
  for (int i = tid; i < 5 * 1024; i += 256) {
    const int r = i >> 10, k = i & 1023;
    const float v = (r == 0) ? p.in[8][k] : p.in[7][(r - 1) * 1024 + k];
    sc[i] = v / (1.f + __expf(-v));
  }
  __syncthreads();
  const float* W = p.in[11] + (size_t)l * 1024 * 6144 + j0 + lane;
  float a0 = 0.f, a1 = 0.f, a2 = 0.f, a3 = 0.f, a4 = 0.f;
  const int kb = w * 256;
#pragma unroll 32
  for (int k = 0; k < 256; ++k) {
    const float wv = W[(size_t)(kb + k) * 6144];
    a0 += sc[kb + k] * wv; a1 += sc[1024 + kb + k] * wv; a2 += sc[2048 + kb + k] * wv; a3 += sc[3072 + kb + k] * wv; a4 += sc[4096 + kb + k] * wv;
  }
  red[(w * 5 + 0) * 64 + lane] = a0; red[(w * 5 + 1) * 64 + lane] = a1; red[(w * 5 + 2) * 64 + lane] = a2;
  red[(w * 5 + 3) * 64 + lane] = a3; red[(w * 5 + 4) * 64 + lane] = a4;
  __syncthreads();
  for (int i = tid; i < 320; i += 256) {
    const int r = i / 64, c = i % 64;
    const float s = red[(0 * 5 + r) * 64 + c] + red[(1 * 5 + r) * 64 + c] + red[(2 * 5 + r) * 64 + c] + red[(3 * 5 + r) * 64 + c];
    float* mod = (float*)(p.ws + OFF_MOD);
    mod[((size_t)l * 5 + r) * 6144 + j0 + c] = s + p.in[12][(size_t)l * 6144 + j0 + c];
  }
}

constexpr int TR_N_IN = 16 * 40 / 4, TR_N_OUT = 16 * 16 / 4, TR_N_F1 = 16 * 64 / 4, TR_N_F2 = 64 * 16 / 4, TR_N_UQ = 4 * 6 / 4, TR_N_UKV = 2 * 8 / 4;
constexpr int TR_PER_L = TR_N_IN + TR_N_OUT + TR_N_F1 + TR_N_F2 + TR_N_UQ + TR_N_UKV;
DI void tr_item(const Params& p, int it, char* lds) {
  const int l = it / TR_PER_L; int r = it % TR_PER_L;
  if (r < TR_N_IN) { transpose_tile4(p.in[13] + (size_t)l * 1024 * NPROJ, 1024, NPROJ, (bf16_t*)(p.ws + OFF_WIN) + (size_t)l * NPROJP * 1024, r * 4, 40, lds); return; }
  r -= TR_N_IN;
  if (r < TR_N_OUT) { transpose_tile4(p.in[14] + (size_t)l * 1024 * 1024, 1024, 1024, (bf16_t*)(p.ws + OFF_WOUT) + (size_t)l * 1024 * 1024, r * 4, 16, lds); return; }
  r -= TR_N_OUT;
  if (r < TR_N_F1) { transpose_tile4(p.in[34] + (size_t)l * 1024 * 4096, 1024, 4096, (bf16_t*)(p.ws + OFF_WFF1) + (size_t)l * 4096 * 1024, r * 4, 64, lds); return; }
  r -= TR_N_F1;
  if (r < TR_N_F2) { transpose_tile4(p.in[35] + (size_t)l * 4096 * 1024, 4096, 1024, (bf16_t*)(p.ws + OFF_WFF2) + (size_t)l * 1024 * 4096, r * 4, 16, lds); return; }
  r -= TR_N_F2;
  if (r < TR_N_UQ) { transpose_tile4(p.in[17] + (size_t)l * 256 * 384, 256, 384, (bf16_t*)(p.ws + OFF_WUQ) + (size_t)l * 384 * 256, r * 4, 6, lds); return; }
  r -= TR_N_UQ;
  transpose_tile4(p.in[18] + (size_t)l * 128 * 512, 128, 512, (bf16_t*)(p.ws + OFF_WUKV) + (size_t)l * 512 * 128, r * 4, 8, lds);
}
DI void setup_phase(const Params& p, char* lds) {
  constexpr int N_TR = TR_PER_L, N_MOD = 384, N_ROPE = 64;
  static_assert((N_MOD + N_TR) % 2 == 0, "pairing");
  if (blockIdx.x == 0 && get_tid() < 4) {
    const int l = get_tid();
    float d1 = 0.f, d2 = 0.f;
    for (int k = 0; k < 32; ++k) { d1 += p.in[23][l * 32 + k] * p.in[24][l * 32 + k]; d2 += p.in[25][l * 32 + k] * p.in[26][l * 32 + k]; }
    const float lam_init = 0.8f - 0.6f * expf(-0.3f * (float)l);
    float* lamp = (float*)(p.ws + OFF_LAM);
    lamp[l * 2] = expf(d1) - expf(d2) + lam_init; lamp[l * 2 + 1] = lam_init;
  }
  const int hb = get_hb();
  lds += hb * HALF_LDS;
  for (int pair = blockIdx.x; pair < (N_MOD + N_TR) / 2; pair += gridDim.x) {
    const int item = pair * 2 + hb;
    if (item < N_MOD) { mod_item(p, item, lds); continue; }
    tr_item(p, item - N_MOD, lds);
  }
  for (int it = blockIdx.x; it < N_ROPE; it += gridDim.x) {
    {
      const int idx = it * 512 + get_tid();
      const int pos = idx >> 4, j = idx & 15;
      const float fr = __builtin_amdgcn_exp2f(-(float)(j & 7) * (13.287712379549449f / 8.f));
      const float base = (j < 8) ? (float)(pos >> 6) : (float)(pos & 63);
      float rev = base * fr * 0.15915494309189535f;
      rev -= floorf(rev);
      float* tab = (float*)(p.ws + OFF_ROPE);
      tab[idx * 2 + 0] = __builtin_amdgcn_cosf(rev);
      tab[idx * 2 + 1] = __builtin_amdgcn_sinf(rev);
    }
  }
}

DI const float* x_row_in(const Params& p, int l, int m) {
  if (l == 0) return m < TP ? p.in[0] + (size_t)m * D : p.in[1] + (size_t)(m - TP) * D;
  return p.out + (size_t)m * D;
}
DI void norm_phase(const Params& p, int l, int which) {
  const int tid = get_tid(), lane = tid & 63, w = tid >> 6;
  const float* g = p.in[which == 0 ? 9 : 10] + (size_t)l * D;
  const float* modl = (const float*)(p.ws + OFF_MOD) + (size_t)l * 5 * 6144;
  bf16_t* hbuf = (bf16_t*)(p.ws + OFF_HBUF);
  constexpr int RW = 6;
  for (int item = blockIdx.x; item < T / (8 * RW); item += gridDim.x) {
    const int m0 = item * 8 * RW + w * RW;
    f32x4 v[RW][4];
#pragma unroll
    for (int rr = 0; rr < RW; ++rr) {
      if (which == 0 && l == 0) {
        const float* x = x_row_in(p, 0, m0 + rr);
#pragma unroll
        for (int i = 0; i < 4; ++i) v[rr][i] = *(const f32x4*)(x + i * 256 + lane * 4);
      } else {
        const bf16_t* x = (const bf16_t*)(p.ws + OFF_XB) + (size_t)(m0 + rr) * D;
#pragma unroll
        for (int i = 0; i < 4; ++i) { const u32x2 r = *(const u32x2*)(x + i * 256 + lane * 4); v[rr][i] = (f32x4){bflo(r[0]), bfhi(r[0]), bflo(r[1]), bfhi(r[1])}; }
      }
    }
    f32x4 gg[4];
#pragma unroll
    for (int i = 0; i < 4; ++i) gg[i] = *(const f32x4*)(g + i * 256 + lane * 4);
#pragma unroll
    for (int rr = 0; rr < RW; ++rr) {
      const int m = m0 + rr;
      const float* mod = modl + (size_t)modrow_of(m) * 6144 + (which == 0 ? 0 : 3072);
      float ss = 0.f;
#pragma unroll
      for (int i = 0; i < 4; ++i) ss += v[rr][i][0] * v[rr][i][0] + v[rr][i][1] * v[rr][i][1] + v[rr][i][2] * v[rr][i][2] + v[rr][i][3] * v[rr][i][3];
      ss = wave_sum(ss);
      const float rstd = rsqrtf(ss * (1.f / D) + EPS);
#pragma unroll
      for (int i = 0; i < 4; ++i) {
        const int c = i * 256 + lane * 4;
        const f32x4 sh = *(const f32x4*)(mod + c), scl = *(const f32x4*)(mod + 1024 + c);
        float o[4];
#pragma unroll
        for (int e = 0; e < 4; ++e) o[e] = v[rr][i][e] * rstd * gg[i][e] * (1.f + scl[e]) + sh[e];
        u32x2 wv; wv[0] = pk2(o[0], o[1]); wv[1] = pk2(o[2], o[3]);
        *(u32x2*)(hbuf + (size_t)m * D + c) = wv;
      }
    }
  }
}

DI int lds_byte2(int r, int c) { const int st = (r >> 4) * 2 + (c >> 5), ob = (r & 15) * 64 + (c & 31) * 2; return st * 1024 + (ob ^ (((ob >> 9) & 1) << 5)); }
DI void stage_rc2(int b, int& R, int& C) { const int st = b >> 10, sb = b & 1023, swz = sb ^ (((sb >> 9) & 1) << 5); R = (st >> 1) * 16 + swz / 64; C = (st & 1) * 32 + (swz % 64) / 2; }
#define WAIT_V0() asm volatile("s_waitcnt vmcnt(0)" ::: "memory")
DI bool unit_next(int vb, int i, int nM, int nN, int& pm, int& pn) {
  const int nwg = nM * nN;
  const long L = (long)i * gridDim.x + vb; if (L >= nwg) return false;
  int wgid = (int)L; { const int q = nwg / 8, r = nwg % 8, xcd = wgid % 8, off = wgid / 8; wgid = (xcd < r ? xcd * (q + 1) : r * (q + 1) + (xcd - r) * q) + off; }
  const int nig = 8 * nN, gid = wgid / nig, fm = gid * 8, gsz = (nM - fm) < 8 ? (nM - fm) : 8;
  pm = fm + ((wgid % nig) % gsz); pn = (wgid % nig) / gsz; return true;
}
template <int BM, class Epi>
DI void gemm_phase(const bf16_t* __restrict__ A, int lda, const bf16_t* __restrict__ Bt, int ldb, int K, int nM, int nN, char* shm, int vb, Epi epi) {
  constexpr int BK = 64, TILE_B = 256 * BK * 2, GL = 4, STAGE_B = 2 * TILE_B, GLA = BM / 64, MB = BM / 32;
  const int tid = get_tid(), wid = tid >> 6, lane = tid & 63, wr = wid >> 2, wc = wid & 3, fr = lane & 15, fq = lane >> 4;
  int sR[GL], sC[GL];
#pragma unroll
  for (int i = 0; i < GL; ++i) stage_rc2(wid * 1024 + i * 8192 + lane * 16, sR[i], sC[i]);
#define SA_(b) (shm + (b) * STAGE_B)
#define SB_(b) (shm + (b) * STAGE_B + TILE_B)
#define GLDS_STAGE(buf, Ab_, Bb_, kt) do { _Pragma("unroll") for (int i = 0; i < GL; ++i) { \
    if (i < GLA) __builtin_amdgcn_global_load_lds((const unsigned*)((Ab_) + (size_t)sR[i] * lda + (kt) * BK + sC[i]), (LAS unsigned*)(SA_(buf) + wid * 1024 + i * 8192), 16, 0, 0); \
    __builtin_amdgcn_global_load_lds((const unsigned*)((Bb_) + (size_t)sR[i] * ldb + (kt) * BK + sC[i]), (LAS unsigned*)(SB_(buf) + wid * 1024 + i * 8192), 16, 0, 0); } } while (0)
  int pm, pn;
  if (!unit_next(vb, 0, nM, nN, pm, pn)) return;
  const int nt = K / BK;
  GLDS_STAGE(0, A + (size_t)pm * BM * lda, Bt + (size_t)pn * 256 * ldb, 0);
#pragma unroll 1
  for (int ui = 0;; ++ui) {
    int npm = 0, npn = 0;
    const bool hn = unit_next(vb, ui + 1, nM, nN, npm, npn);
    f32x4 acc[MB][4];
#pragma unroll
    for (int m = 0; m < MB; ++m)
#pragma unroll
      for (int n = 0; n < 4; ++n) acc[m][n] = (f32x4){0.f, 0.f, 0.f, 0.f};
    WAIT_V0(); __syncthreads();
#pragma unroll 1
    for (int t = 0; t < nt; ++t) {
      const int cur = t & 1;
      {
        const bool last = t + 1 >= nt;
        if (!last || hn) {
          const bf16_t* Ab = A + (size_t)(last ? npm : pm) * BM * lda + (last ? 0 : (t + 1) * BK);
          const bf16_t* Bb = Bt + (size_t)(last ? npn : pn) * 256 * ldb + (last ? 0 : (t + 1) * BK);
          GLDS_STAGE(cur ^ 1, Ab, Bb, 0);
        }
      }
      if constexpr (BM == 192) {
        bf16x8 At[2][MB], Bf[2][4];
#pragma unroll
        for (int ks = 0; ks < 2; ++ks) {
#pragma unroll
          for (int n = 0; n < 4; ++n) Bf[ks][n] = *(const bf16x8*)(SB_(cur) + lds_byte2(wc * 64 + n * 16 + fr, ks * 32 + fq * 8));
#pragma unroll
          for (int m = 0; m < MB; ++m) At[ks][m] = *(const bf16x8*)(SA_(cur) + lds_byte2(wr * (BM / 2) + m * 16 + fr, ks * 32 + fq * 8));
          __builtin_amdgcn_sched_barrier(0);
        }
#pragma unroll
        for (int ks = 0; ks < 2; ++ks) {
#pragma unroll
          for (int m = 0; m < MB; ++m)
#pragma unroll
            for (int n = 0; n < 4; ++n) acc[m][n] = __builtin_amdgcn_mfma_f32_16x16x32_bf16(Bf[ks][n], At[ks][m], acc[m][n], 0, 0, 0);
          __builtin_amdgcn_sched_barrier(0);
        }
      } else {
#pragma unroll
        for (int ks = 0; ks < 2; ++ks) {
          bf16x8 At[MB], Bf[4];
#pragma unroll
          for (int n = 0; n < 4; ++n) Bf[n] = *(const bf16x8*)(SB_(cur) + lds_byte2(wc * 64 + n * 16 + fr, ks * 32 + fq * 8));
#pragma unroll
          for (int m = 0; m < MB; ++m) At[m] = *(const bf16x8*)(SA_(cur) + lds_byte2(wr * (BM / 2) + m * 16 + fr, ks * 32 + fq * 8));
          __builtin_amdgcn_sched_barrier(0);
#pragma unroll
          for (int m = 0; m < MB; ++m)
#pragma unroll
            for (int n = 0; n < 4; ++n) acc[m][n] = __builtin_amdgcn_mfma_f32_16x16x32_bf16(Bf[n], At[m], acc[m][n], 0, 0, 0);
          __builtin_amdgcn_sched_barrier(0);
        }
      }
      if (t + 1 < nt) { WAIT_V0(); __syncthreads(); }
    }
    const int brow = pm * BM, bcol = pn * 256;
    if constexpr (Epi::PRELOAD) {
      u32x2 xr[MB][4];
#pragma unroll
      for (int m = 0; m < MB; ++m)
#pragma unroll
        for (int n = 0; n < 4; ++n) xr[m][n] = epi.preload(brow + wr * (BM / 2) + m * 16 + fr, bcol + wc * 64 + n * 16 + fq * 4);
#pragma unroll
      for (int m = 0; m < MB; ++m)
#pragma unroll
        for (int n = 0; n < 4; ++n) epi(brow + wr * (BM / 2) + m * 16 + fr, bcol + wc * 64 + n * 16 + fq * 4, acc[m][n], xr[m][n]);
    } else {
#pragma unroll
      for (int m = 0; m < MB; ++m)
#pragma unroll
        for (int n = 0; n < 4; ++n) epi(brow + wr * (BM / 2) + m * 16 + fr, bcol + wc * 64 + n * 16 + fq * 4, acc[m][n]);
    }
    if (!hn) break;
    pm = npm; pn = npn;
  }
  __syncthreads();
#undef SA_
#undef SB_
#undef GLDS_STAGE
}

struct EpiInProj {
  static constexpr bool PRELOAD = false;
  bf16_t* proj; float* dt;
  DI void operator()(int m, int n, const f32x4& v) const {
    u32x2 o; o[0] = pk2(v[0], v[1]); o[1] = pk2(v[2], v[3]);
    *(u32x2*)(proj + (size_t)m * NPROJP + n) = o;
    if (n >= C_DT && n < NPROJ) *(f32x4*)(dt + (size_t)m * 16 + (n - C_DT)) = v;
  }
};
struct EpiResid {
  static constexpr bool PRELOAD = true;
  const float* xin_p; const float* xin_s;
  bf16_t* xb; float* xout_f;
  const float* gate;
  DI u32x2 preload(int m, int n) const { return xin_p ? (u32x2){0u, 0u} : *(const u32x2*)(xb + (size_t)m * D + n); }
  DI void operator()(int m, int n, const f32x4& v, const u32x2& r) const {
    const f32x4 g = *(const f32x4*)(gate + (size_t)modrow_of(m) * 6144 + n);
    f32x4 x0;
    if (xin_p) { const float* xi = (m < TP) ? xin_p + (size_t)m * D : xin_s + (size_t)(m - TP) * D; x0 = *(const f32x4*)(xi + n); }
    else x0 = (f32x4){bflo(r[0]), bfhi(r[0]), bflo(r[1]), bfhi(r[1])};
    const f32x4 x1 = x0 + g * v;
    if (xout_f) *(f32x4*)(xout_f + (size_t)m * D + n) = x1;
    else { u32x2 o; o[0] = pk2(x1[0], x1[1]); o[1] = pk2(x1[2], x1[3]); *(u32x2*)(xb + (size_t)m * D + n) = o; }
  }
};
struct EpiFF1 {
  static constexpr bool PRELOAD = false;
  bf16_t* u;
  DI void operator()(int m, int n, const f32x4& v) const {
    float r[4];
#pragma unroll
    for (int e = 0; e < 4; ++e) { const float t = v[e] > 0.f ? v[e] : 0.f; r[e] = t * t; }
    u32x2 o; o[0] = pk2(r[0], r[1]); o[1] = pk2(r[2], r[3]);
    *(u32x2*)(u + (size_t)m * DFF + n) = o;
  }
};

DI void rope_block(f32x16& v, const float* tab, int pos, int half) {
  const float* t = tab + (size_t)pos * 32;
#pragma unroll
  for (int q = 0; q < 2; ++q)
#pragma unroll
    for (int r = 0; r < 4; ++r) {
      const int fi = q * 8 + r + 4 * half;
      const float c = t[fi * 2], s = t[fi * 2 + 1];
      const float x1 = v[q * 8 + r], x2 = v[q * 8 + r + 4];
      v[q * 8 + r] = x1 * c - x2 * s;
      v[q * 8 + r + 4] = x2 * c + x1 * s;
    }
}
DI void store_block_bf16(bf16_t* dst, const f32x16& v, int half) {
#pragma unroll
  for (int q = 0; q < 4; ++q) {
    u32x2 wv; wv[0] = pk2(v[4 * q], v[4 * q + 1]); wv[1] = pk2(v[4 * q + 2], v[4 * q + 3]);
    *(u32x2*)(dst + 8 * q + 4 * half) = wv;
  }
}
DI f32x16 gain_block(const float* g, int half) {
  f32x16 o;
#pragma unroll
  for (int q = 0; q < 4; ++q) { const f32x4 v = *(const f32x4*)(g + 8 * q + 4 * half); o[4 * q] = v[0]; o[4 * q + 1] = v[1]; o[4 * q + 2] = v[2]; o[4 * q + 3] = v[3]; }
  return o;
}
DI float sumsq16(const f32x16& v) { float s = 0.f;
#pragma unroll
  for (int i = 0; i < 16; ++i) s += v[i] * v[i];
  return s; }

DI void mla_q_item(const Params& p, int l, int item4, char* lds) {
  const int item = item4 >> 2, head0 = item4 & 3;
  const int lane = get_tid() & 63, w = get_tid() >> 6, l32 = lane & 31, half = lane >> 5;
  {
    const bf16_t* Wg = (const bf16_t*)(p.ws + OFF_WUQ) + ((size_t)l * 384 + head0 * 96) * 256;
    u32x4 t[6];
#pragma unroll
    for (int i = 0; i < 6; ++i) { const int c = get_tid() + 512 * i; t[i] = *(const u32x4*)(Wg + (size_t)(c >> 5) * 256 + (c & 31) * 8); }
    __syncthreads();
#pragma unroll
    for (int i = 0; i < 6; ++i) { const int c = get_tid() + 512 * i; *(u32x4*)(lds + (c >> 5) * 528 + (c & 31) * 16) = t[i]; }
    if (get_tid() < 64) *(f32x4*)(lds + 50688 + get_tid() * 16) = *(const f32x4*)(p.in[15] + (size_t)l * 256 + get_tid() * 4);
  }
  const int tok = item * 256 + w * 32 + l32;
  const bf16_t* proj = (const bf16_t*)(p.ws + OFF_PROJ) + (size_t)tok * NPROJP + C_CQ;
  const float* gq = p.in[15] + (size_t)l * 256;
  float ss = 0.f;
  u32x4 raw[16];
#pragma unroll
  for (int s = 0; s < 16; ++s) raw[s] = *(const u32x4*)(proj + 16 * s + 8 * half);
#pragma unroll
  for (int s = 0; s < 16; ++s) {
#pragma unroll
    for (int e = 0; e < 4; ++e) { const float a = bflo(raw[s][e]), b = bfhi(raw[s][e]); ss += a * a + b * b; }
  }
  ss += xor32(ss);
  const float rstd = rsqrtf(ss * (1.f / 256.f) + EPS);
  __syncthreads();
  bf16x8 fr[16];
#pragma unroll
  for (int s = 0; s < 16; ++s) {
    const f32x4 g0 = *(const f32x4*)(lds + 50688 + (16 * s + 8 * half) * 4), g1 = *(const f32x4*)(lds + 50688 + (16 * s + 8 * half + 4) * 4);
    u32x4 o;
    o[0] = pk2(bflo(raw[s][0]) * rstd * g0[0], bfhi(raw[s][0]) * rstd * g0[1]);
    o[1] = pk2(bflo(raw[s][1]) * rstd * g0[2], bfhi(raw[s][1]) * rstd * g0[3]);
    o[2] = pk2(bflo(raw[s][2]) * rstd * g1[0], bfhi(raw[s][2]) * rstd * g1[1]);
    o[3] = pk2(bflo(raw[s][3]) * rstd * g1[2], bfhi(raw[s][3]) * rstd * g1[3]);
    fr[s] = __builtin_bit_cast(bf16x8, o);
  }
  const bf16_t* W = (const bf16_t*)(p.ws + OFF_WUQ) + (size_t)l * 384 * 256;
  const float* gqk = p.in[19] + (size_t)l * 96;
  const float* tab = (const float*)(p.ws + OFF_ROPE);
  const bool rope = tok >= TP;
  const int pos = rope ? ((tok - TP) & 2047) : 0;
  const float qscale = 0.10206207261596577f * 1.4426950408889634f;
  bf16_t* qa = (bf16_t*)(p.ws + OFF_QA) + (size_t)tok * 384;
#pragma unroll 1
  for (int head = head0; head < head0 + 1; ++head) {
    f32x16 acc[3];
#pragma unroll
    for (int db = 0; db < 3; ++db) acc[db] = zero16();
#pragma unroll
    for (int db = 0; db < 3; ++db) {
      bf16x8 a[16];
      const char* wrow = lds + (db * 32 + l32) * 528 + 16 * half;
#pragma unroll
      for (int s = 0; s < 16; ++s) a[s] = *(const bf16x8*)(wrow + 32 * s);
      __builtin_amdgcn_sched_barrier(0);
#pragma unroll
      for (int s = 0; s < 16; ++s) acc[db] = MFMA32(a[s], fr[s], acc[db]);
      __builtin_amdgcn_sched_barrier(0);
    }
    float s2 = sumsq16(acc[0]) + sumsq16(acc[1]) + sumsq16(acc[2]);
    s2 += xor32(s2);
    const float r2 = rsqrtf(s2 * (1.f / 96.f) + EPS);
#pragma unroll
    for (int db = 0; db < 3; ++db) {
      const f32x16 gb = gain_block(gqk + db * 32, half);
#pragma unroll
      for (int r = 0; r < 16; ++r) acc[db][r] *= r2 * gb[r];
    }
    if (rope) rope_block(acc[2], tab, pos, half);
#pragma unroll
    for (int db = 0; db < 3; ++db) {
#pragma unroll
      for (int r = 0; r < 16; ++r) acc[db][r] *= qscale;
      store_block_bf16(qa + head * 96 + db * 32, acc[db], half);
    }
  }
}

DI void mla_kv_item(const Params& p, int l, int item4, char* lds) {
  const int item = item4 >> 2, head0 = item4 & 3;
  const int lane = get_tid() & 63, w = get_tid() >> 6, l32 = lane & 31, half = lane >> 5;
  {
    const bf16_t* Wg = (const bf16_t*)(p.ws + OFF_WUKV) + ((size_t)l * 512 + head0 * 128) * 128;
    u32x4 t[4];
#pragma unroll
    for (int i = 0; i < 4; ++i) { const int c = get_tid() + 512 * i; t[i] = *(const u32x4*)(Wg + (size_t)(c >> 4) * 128 + (c & 15) * 8); }
    __syncthreads();
#pragma unroll
    for (int i = 0; i < 4; ++i) { const int c = get_tid() + 512 * i; *(u32x4*)(lds + (c >> 4) * PITCH128 + (c & 15) * 16) = t[i]; }
  }
  const int kr = item * 256 + w * 32 + l32;
  int tok = -1, b = 0, j = 0; bool cached = false, rope = false; int pos = 0;
  if (kr < TP) { tok = kr; }
  else { b = (kr - TP) / 2304; j = (kr - TP) % 2304; if (j < PAST) cached = true; else { tok = TP + b * 2048 + (j - PAST); rope = true; pos = j - PAST; } }
  bf16x8 fr[8];
  f32x16 krb;
  if (!cached) {
    const bf16_t* proj = (const bf16_t*)(p.ws + OFF_PROJ) + (size_t)tok * NPROJP;
    const float* gkv = p.in[16] + (size_t)l * 128;
    u32x4 raw[8]; float ss = 0.f;
    f32x4 gv0[8], gv1[8]; u32x2 rvv[4];
#pragma unroll
    for (int s = 0; s < 8; ++s) raw[s] = *(const u32x4*)(proj + C_CKV + 16 * s + 8 * half);
#pragma unroll
    for (int s = 0; s < 8; ++s) { gv0[s] = *(const f32x4*)(gkv + 16 * s + 8 * half); gv1[s] = *(const f32x4*)(gkv + 16 * s + 8 * half + 4); }
#pragma unroll
    for (int q = 0; q < 4; ++q) rvv[q] = *(const u32x2*)(proj + C_KR + 8 * q + 4 * half);
#pragma unroll
    for (int s = 0; s < 8; ++s) {
#pragma unroll
      for (int e = 0; e < 4; ++e) { const float a = bflo(raw[s][e]), bb = bfhi(raw[s][e]); ss += a * a + bb * bb; }
    }
    ss += xor32(ss);
    const float rstd = rsqrtf(ss * (1.f / 128.f) + EPS);
#pragma unroll
    for (int s = 0; s < 8; ++s) {
      const f32x4 g0 = gv0[s], g1 = gv1[s];
      f32x4 o0, o1;
      o0[0] = bflo(raw[s][0]) * rstd * g0[0]; o0[1] = bfhi(raw[s][0]) * rstd * g0[1]; o0[2] = bflo(raw[s][1]) * rstd * g0[2]; o0[3] = bfhi(raw[s][1]) * rstd * g0[3];
      o1[0] = bflo(raw[s][2]) * rstd * g1[0]; o1[1] = bfhi(raw[s][2]) * rstd * g1[1]; o1[2] = bflo(raw[s][3]) * rstd * g1[2]; o1[3] = bfhi(raw[s][3]) * rstd * g1[3];
      u32x4 o; o[0] = pk2(o0[0], o0[1]); o[1] = pk2(o0[2], o0[3]); o[2] = pk2(o1[0], o1[1]); o[3] = pk2(o1[2], o1[3]);
      fr[s] = __builtin_bit_cast(bf16x8, o);
      if (tok < TP && head0 == 0) {
        float* dst = p.out + O_CKV + (((size_t)(tok >> 8) * DEPTH + l) * 256 + (tok & 255)) * 128 + 16 * s + 8 * half;
        *(f32x4*)dst = o0; *(f32x4*)(dst + 4) = o1;
      }
    }
#pragma unroll
    for (int q = 0; q < 4; ++q) {
      const u32x2 rv = rvv[q];
      krb[4 * q] = bflo(rv[0]); krb[4 * q + 1] = bfhi(rv[0]); krb[4 * q + 2] = bflo(rv[1]); krb[4 * q + 3] = bfhi(rv[1]);
      if (tok < TP && head0 == 0) {
        float* dst = p.out + O_KROPE + (((size_t)(tok >> 8) * DEPTH + l) * 256 + (tok & 255)) * 32 + 8 * q + 4 * half;
        f32x4 o = {krb[4 * q], krb[4 * q + 1], krb[4 * q + 2], krb[4 * q + 3]};
        *(f32x4*)dst = o;
      }
    }
  } else {
    const float* src = p.in[2] + (((size_t)b * DEPTH + l) * PAST + j) * 128;
#pragma unroll
    for (int s = 0; s < 8; ++s) {
      const f32x4 v0 = *(const f32x4*)(src + 16 * s + 8 * half), v1 = *(const f32x4*)(src + 16 * s + 8 * half + 4);
      u32x4 o; o[0] = pk2(v0[0], v0[1]); o[1] = pk2(v0[2], v0[3]); o[2] = pk2(v1[0], v1[1]); o[3] = pk2(v1[2], v1[3]);
      fr[s] = __builtin_bit_cast(bf16x8, o);
    }
    const float* ks = p.in[3] + (((size_t)b * DEPTH + l) * PAST + j) * 32;
#pragma unroll
    for (int q = 0; q < 4; ++q) {
      const f32x4 v = *(const f32x4*)(ks + 8 * q + 4 * half);
      krb[4 * q] = v[0]; krb[4 * q + 1] = v[1]; krb[4 * q + 2] = v[2]; krb[4 * q + 3] = v[3];
    }
  }
  const bf16_t* W = (const bf16_t*)(p.ws + OFF_WUKV) + (size_t)l * 512 * 128;
  const float* gk = p.in[20] + (size_t)l * 96;
  const float* tab = (const float*)(p.ws + OFF_ROPE);
  bf16_t* ka = (bf16_t*)(p.ws + OFF_KA) + (size_t)kr * 384;
  bf16_t* vat = (bf16_t*)(p.ws + OFF_VAT);
  const float ssr = sumsq16(krb);
  __syncthreads();
#pragma unroll 1
  for (int head = head0; head < head0 + 1; ++head) {
    f32x16 acc[4];
#pragma unroll
    for (int db = 0; db < 4; ++db) acc[db] = zero16();
#pragma unroll
    for (int dp = 0; dp < 2; ++dp) {
      bf16x8 a[2][8];
#pragma unroll
      for (int d2 = 0; d2 < 2; ++d2)
#pragma unroll
        for (int s = 0; s < 8; ++s) a[d2][s] = *(const bf16x8*)(lds + ((dp * 2 + d2) * 32 + l32) * PITCH128 + 32 * s + 16 * half);
      __builtin_amdgcn_sched_barrier(0);
#pragma unroll
      for (int d2 = 0; d2 < 2; ++d2)
#pragma unroll
        for (int s = 0; s < 8; ++s) acc[dp * 2 + d2] = MFMA32(a[d2][s], fr[s], acc[dp * 2 + d2]);
      __builtin_amdgcn_sched_barrier(0);
    }
    float s2 = sumsq16(acc[0]) + sumsq16(acc[1]) + ssr;
    s2 += xor32(s2);
    const float r2 = rsqrtf(s2 * (1.f / 96.f) + EPS);
    f32x16 k2;
    {
      const f32x16 g0 = gain_block(gk, half), g1 = gain_block(gk + 32, half), g2 = gain_block(gk + 64, half);
#pragma unroll
      for (int r = 0; r < 16; ++r) { acc[0][r] *= r2 * g0[r]; acc[1][r] *= r2 * g1[r]; k2[r] = krb[r] * r2 * g2[r]; }
    }
    if (rope) rope_block(k2, tab, pos, half);
    store_block_bf16(ka + head * 96, acc[0], half);
    store_block_bf16(ka + head * 96 + 32, acc[1], half);
    store_block_bf16(ka + head * 96 + 64, k2, half);
#pragma unroll
    for (int db = 2; db < 4; ++db)
#pragma unroll
      for (int r = 0; r < 16; ++r)
        vat[((size_t)head * 64 + (db - 2) * 32 + crow(r, half)) * NKEY + kr] = f2bf(acc[db][r]);
  }
}

DI void diff_qk_thread(const Params& p, int l, int idx, bool isk) {
  const float* tab = (const float*)(p.ws + OFF_ROPE);
  const int hm = idx & 7, row = idx >> 3;
  float x[32];
  int tok = -1, pos = 0; bool rope = false, cached = false;
  if (!isk) { tok = row; if (tok >= TP) { rope = true; pos = (tok - TP) & 2047; } }
  else {
    if (row < TP) tok = row;
    else { const int b = (row - TP) / 2304, j = (row - TP) % 2304;
      if (j < PAST) { cached = true;
        const float* src = p.in[4] + ((((size_t)b * DEPTH + l) * PAST + j) * 8 + hm) * 32;
#pragma unroll
        for (int i = 0; i < 8; ++i) { const f32x4 v = *(const f32x4*)(src + 4 * i); x[4 * i] = v[0]; x[4 * i + 1] = v[1]; x[4 * i + 2] = v[2]; x[4 * i + 3] = v[3]; }
      } else { tok = TP + b * 2048 + (j - PAST); rope = true; pos = j - PAST; } }
  }
  if (!cached) {
    const bf16_t* src = (const bf16_t*)(p.ws + OFF_PROJ) + (size_t)tok * NPROJP + (isk ? C_DK : C_DQ) + hm * 32;
    float ss = 0.f;
#pragma unroll
    for (int i = 0; i < 4; ++i) {
      const u32x4 v = *(const u32x4*)(src + 8 * i);
#pragma unroll
      for (int e = 0; e < 4; ++e) { x[8 * i + 2 * e] = bflo(v[e]); x[8 * i + 2 * e + 1] = bfhi(v[e]); }
    }
#pragma unroll
    for (int i = 0; i < 32; ++i) ss += x[i] * x[i];
    const float rstd = rsqrtf(ss * (1.f / 32.f) + EPS);
    const float* g = p.in[isk ? 22 : 21] + (size_t)l * 32;
#pragma unroll
    for (int i = 0; i < 32; ++i) x[i] *= rstd * g[i];
    if (isk && tok < TP) {
      float* dst = p.out + O_DK + (((size_t)(tok >> 8) * DEPTH + l) * 256 + (tok & 255)) * 256 + hm * 32;
#pragma unroll
      for (int i = 0; i < 8; ++i) { f32x4 o = {x[4 * i], x[4 * i + 1], x[4 * i + 2], x[4 * i + 3]}; *(f32x4*)(dst + 4 * i) = o; }
    }
    if (rope) {
      const float* t = tab + (size_t)pos * 32;
#pragma unroll
      for (int q = 0; q < 2; ++q)
#pragma unroll
        for (int m = 0; m < 8; ++m) {
          const float c = t[(q * 8 + m) * 2], s = t[(q * 8 + m) * 2 + 1];
          const float x1 = x[q * 16 + m], x2 = x[q * 16 + 8 + m];
          x[q * 16 + m] = x1 * c - x2 * s; x[q * 16 + 8 + m] = x2 * c + x1 * s;
        }
    }
  }
  const float sc = isk ? 1.f : 0.17677669529663687f * 1.4426950408889634f;
  bf16_t* dst = (bf16_t*)(p.ws + (isk ? OFF_KD : OFF_QD)) + (size_t)row * 256 + hm * 32;
#pragma unroll
  for (int i = 0; i < 4; ++i) {
    u32x4 o;
#pragma unroll
    for (int e = 0; e < 4; ++e) o[e] = pk2(x[8 * i + 2 * e] * sc, x[8 * i + 2 * e + 1] * sc);
    *(u32x4*)(dst + 8 * i) = o;
  }
}
DI void diff_v_thread(const Params& p, int l, int idx) {
  const int head = idx / NKEY, kr = idx % NKEY;
  bf16_t* vdt = (bf16_t*)(p.ws + OFF_VDT) + (size_t)head * 64 * NKEY + kr;
  int tok = -1;
  if (kr < TP) tok = kr;
  else { const int b = (kr - TP) / 2304, j = (kr - TP) % 2304;
    if (j < PAST) {
      const float* src = p.in[5] + ((((size_t)b * DEPTH + l) * PAST + j) * 4 + head) * 64;
#pragma unroll
      for (int i = 0; i < 16; ++i) { const f32x4 v = *(const f32x4*)(src + 4 * i);
#pragma unroll
        for (int e = 0; e < 4; ++e) vdt[(size_t)(4 * i + e) * NKEY] = f2bf(v[e]); }
      return;
    }
    tok = TP + b * 2048 + (j - PAST);
  }
  const bf16_t* src = (const bf16_t*)(p.ws + OFF_PROJ) + (size_t)tok * NPROJP + C_DV + head * 64;
  float* od = (tok < TP) ? p.out + O_DV + (((size_t)(tok >> 8) * DEPTH + l) * 256 + (tok & 255)) * 256 + head * 64 : nullptr;
#pragma unroll
  for (int i = 0; i < 8; ++i) {
    const u32x4 v = *(const u32x4*)(src + 8 * i);
#pragma unroll
    for (int e = 0; e < 4; ++e) {
      vdt[(size_t)(8 * i + 2 * e) * NKEY] = (bf16_t)(v[e] & 0xffffu);
      vdt[(size_t)(8 * i + 2 * e + 1) * NKEY] = (bf16_t)(v[e] >> 16);
    }
    if (od) {
      f32x4 o0 = {bflo(v[0]), bfhi(v[0]), bflo(v[1]), bfhi(v[1])}, o1 = {bflo(v[2]), bfhi(v[2]), bflo(v[3]), bfhi(v[3])};
      *(f32x4*)(od + 8 * i) = o0; *(f32x4*)(od + 8 * i + 4) = o1;
    }
  }
}
template <int CU>
DI void conv_threads(const Params& p, int l, int idx0, int stride) {
  u32x4 v[CU][5]; f32x4 bia[CU][2];
  int tokv[CU], c0v[CU];
#pragma unroll
  for (int u = 0; u < CU; ++u) {
    const int idx = idx0 + u * stride;
    const int tok = idx / 96, c0 = (idx % 96) * 8;
    tokv[u] = tok; c0v[u] = c0;
    int pos, L;
    if (tok < TP) { pos = tok & 255; L = 256; } else { pos = (tok - TP) & 2047; L = 2048; }
    const bf16_t* src = (const bf16_t*)(p.ws + OFF_PROJ) + (size_t)tok * NPROJP + C_XBC + c0;
#pragma unroll
    for (int k = 0; k < 5; ++k) {
      const int pp = pos + k - 2;
      v[u][k] = (u32x4){0u, 0u, 0u, 0u};
      if (pp >= 0 && pp < L) v[u][k] = *(const u32x4*)(src + (ptrdiff_t)(k - 2) * NPROJP);
    }
    const float* cb = p.in[29] + (size_t)l * 768 + c0;
    bia[u][0] = *(const f32x4*)cb; bia[u][1] = *(const f32x4*)(cb + 4);
  }
#pragma unroll
  for (int u = 0; u < CU; ++u) {
    const float* cw = p.in[28] + (size_t)l * 5 * 768 + c0v[u];
    float acc[8] = {bia[u][0][0], bia[u][0][1], bia[u][0][2], bia[u][0][3], bia[u][1][0], bia[u][1][1], bia[u][1][2], bia[u][1][3]};
#pragma unroll
    for (int k = 0; k < 5; ++k) {
      const f32x4 w0 = *(const f32x4*)(cw + k * 768), w1 = *(const f32x4*)(cw + k * 768 + 4);
      const u32x4 x = v[u][k];
      acc[0] += w0[0] * bflo(x[0]); acc[1] += w0[1] * bfhi(x[0]); acc[2] += w0[2] * bflo(x[1]); acc[3] += w0[3] * bfhi(x[1]);
      acc[4] += w1[0] * bflo(x[2]); acc[5] += w1[1] * bfhi(x[2]); acc[6] += w1[2] * bflo(x[3]); acc[7] += w1[3] * bfhi(x[3]);
    }
#pragma unroll
    for (int e = 0; e < 8; ++e) acc[e] = acc[e] / (1.f + __expf(-acc[e]));
    u32x4 o; o[0] = pk2(acc[0], acc[1]); o[1] = pk2(acc[2], acc[3]); o[2] = pk2(acc[4], acc[5]); o[3] = pk2(acc[6], acc[7]);
    *(u32x4*)((bf16_t*)(p.ws + OFF_XBC) + (size_t)tokv[u] * 768 + c0v[u]) = o;
  }
}
DI void dt_thread(const Params& p, int l, int idx) {
  float* dt = (float*)(p.ws + OFF_DT);
  const float v = dt[idx] + p.in[31][(size_t)l * 16 + (idx & 15)];
  dt[idx] = fmaxf(v, 0.f) + log1pf(__expf(-fabsf(v)));
}

DI void prep_phase(const Params& p, int l, char* lds) {
  constexpr int N_Q = 48 * 4, N_KV = 52 * 4, N_DQ = T * 8 / 512, N_DKK = NKEY * 8 / 512, N_DV = NKEY * 4 / 512, N_CONV = T * 96 / 512 / 3, N_DTT = T * 16 / 512;
  constexpr int TOT = N_Q + N_KV + N_DQ + N_DKK + N_DV + N_CONV + N_DTT;
  for (int item = blockIdx.x; item < TOT; item += gridDim.x) {
    int it = item;
    if (it < N_Q) { mla_q_item(p, l, it, lds); continue; }
    it -= N_Q;
    if (it < N_KV) { mla_kv_item(p, l, it, lds); continue; }
    it -= N_KV;
    if (it < N_DQ) { diff_qk_thread(p, l, it * 512 + get_tid(), false); continue; }
    it -= N_DQ;
    if (it < N_DKK) { diff_qk_thread(p, l, it * 512 + get_tid(), true); continue; }
    it -= N_DKK;
    if (it < N_DV) { diff_v_thread(p, l, it * 512 + get_tid()); continue; }
    it -= N_DV;
    if (it < N_CONV) { conv_threads<3>(p, l, it * 512 + get_tid(), N_CONV * 512); continue; }
    it -= N_CONV;
    dt_thread(p, l, it * 512 + get_tid());
  }
}

DI void wave_scan2(float e0, float e1, float& o0, float& o1) {
  const int lane = get_tid() & 63;
  const float s = e0 + e1;
  float inc = s;
#pragma unroll
  for (int o = 1; o < 64; o <<= 1) { const float t = __shfl_up(inc, o); if (lane >= o) inc += t; }
  const float excl = inc - s;
  o0 = excl + e0; o1 = excl + s;
}
DI void ssd_dt_load(const Params& p, int cg_, int h, float& d0, float& d1) {
  const int lane = get_tid() & 63, w = get_tid4() >> 6;
  const float* dt = (const float*)(p.ws + OFF_DT) + (size_t)cg_ * 128 * 16;
  d0 = 0.f; d1 = 0.f;
  if (w == 0) { d0 = dt[(2 * lane) * 16 + h]; d1 = dt[(2 * lane + 1) * 16 + h]; }
  else if (w == 1) { d0 = dt[(127 - 2 * lane) * 16 + 8 + h]; d1 = dt[(126 - 2 * lane) * 16 + 8 + h]; }
}
DI void ssd_scalars_from(const Params& p, int l, int h, float d0, float d1, float* acf, float* sb, float* dtf, float* dtb) {
  const int lane = get_tid() & 63, w = get_tid4() >> 6;
  if (w == 0) {
    const float a = -__expf(p.in[30][(size_t)l * 16 + h]);
    float o0, o1; wave_scan2(d0 * a, d1 * a, o0, o1);
    acf[2 * lane] = o0; acf[2 * lane + 1] = o1; dtf[2 * lane] = d0; dtf[2 * lane + 1] = d1;
  } else if (w == 1) {
    const float a = -__expf(p.in[30][(size_t)l * 16 + 8 + h]);
    const int j0 = 127 - 2 * lane, j1 = 126 - 2 * lane;
    float o0, o1; wave_scan2(d0 * a, d1 * a, o0, o1);
    sb[j0] = o0; sb[j1] = o1; dtb[j0] = d0; dtb[j1] = d1;
  }
}
DI void ssd_scalars(const Params& p, int l, int cg_, int h, float* acf, float* sb, float* dtf, float* dtb) {
  const int lane = get_tid() & 63, w = get_tid4() >> 6;
  const float* dt = (const float*)(p.ws + OFF_DT) + (size_t)cg_ * 128 * 16;
  if (w == 0) {
    const float a = -__expf(p.in[30][(size_t)l * 16 + h]);
    const float d0 = dt[(2 * lane) * 16 + h], d1 = dt[(2 * lane + 1) * 16 + h];
    float o0, o1; wave_scan2(d0 * a, d1 * a, o0, o1);
    acf[2 * lane] = o0; acf[2 * lane + 1] = o1; dtf[2 * lane] = d0; dtf[2 * lane + 1] = d1;
  } else if (w == 1) {
    const float a = -__expf(p.in[30][(size_t)l * 16 + 8 + h]);
    const int j0 = 127 - 2 * lane, j1 = 126 - 2 * lane;
    const float d0 = dt[j0 * 16 + 8 + h], d1 = dt[j1 * 16 + 8 + h];
    float o0, o1; wave_scan2(d0 * a, d1 * a, o0, o1);
    sb[j0] = o0; sb[j1] = o1; dtb[j0] = d0; dtb[j1] = d1;
  }
}

DI void ssd_states_item(const Params& p, int l, int item, char* lds) {
  const int tid = get_tid4(), lane = tid & 63, w = tid >> 6, l32 = lane & 31, half = lane >> 5;
  const int cg_ = item >> 3, h = item & 7, g = h >> 2;
  char* XF = lds; char* XB = lds + 64 * PITCH128; char* BT = lds + 2 * 64 * PITCH128;
  float* sc = (float*)(lds + 3 * 64 * PITCH128);
  float* acf = sc, *sb = sc + 128, *dtf = sc + 256, *dtb = sc + 384;
  __syncthreads();
  ssd_scalars(p, l, cg_, h, acf, sb, dtf, dtb);
  __syncthreads();
  const bf16_t* xbc = (const bf16_t*)(p.ws + OFF_XBC) + (size_t)cg_ * 128 * 768;
  const float aL = acf[127], s0 = sb[0];
#pragma unroll
  for (int it = 0; it < 2; ++it) {
    const int t = tid + 256 * it, jp = t & 63, pc = t >> 6, j0 = 2 * jp;
    const u32x4 x0 = *(const u32x4*)(xbc + (size_t)j0 * 768 + h * 64 + pc * 8), x1 = *(const u32x4*)(xbc + (size_t)(j0 + 1) * 768 + h * 64 + pc * 8);
    const u32x4 b0 = *(const u32x4*)(xbc + (size_t)j0 * 768 + 512 + g * 64 + pc * 8), b1 = *(const u32x4*)(xbc + (size_t)(j0 + 1) * 768 + 512 + g * 64 + pc * 8);
    const float wf0 = __expf(aL - acf[j0]) * dtf[j0], wf1 = __expf(aL - acf[j0 + 1]) * dtf[j0 + 1];
    const float wb0 = __expf(s0 - sb[j0]) * dtb[j0], wb1 = __expf(s0 - sb[j0 + 1]) * dtb[j0 + 1];
#pragma unroll
    for (int e = 0; e < 4; ++e) {
      const float a0 = bflo(x0[e]), a1 = bfhi(x0[e]), c0 = bflo(x1[e]), c1 = bfhi(x1[e]);
      const int pr = pc * 8 + 2 * e;
      *(unsigned*)(XF + pr * PITCH128 + j0 * 2) = pk2(a0 * wf0, c0 * wf1);
      *(unsigned*)(XF + (pr + 1) * PITCH128 + j0 * 2) = pk2(a1 * wf0, c1 * wf1);
      *(unsigned*)(XB + pr * PITCH128 + j0 * 2) = pk2(a0 * wb0, c0 * wb1);
      *(unsigned*)(XB + (pr + 1) * PITCH128 + j0 * 2) = pk2(a1 * wb0, c1 * wb1);
      *(unsigned*)(BT + pr * PITCH128 + j0 * 2) = (b0[e] & 0xffffu) | (b1[e] << 16);
      *(unsigned*)(BT + (pr + 1) * PITCH128 + j0 * 2) = (b0[e] >> 16) | (b1[e] & 0xffff0000u);
    }
  }
  __syncthreads();
  const int dir = w >> 1, pb = w & 1;
  const char* Xs = (dir ? XB : XF) + (pb * 32 + l32) * PITCH128 + half * 16;
  const char* Bsrc = BT + l32 * PITCH128 + half * 16;
  f32x16 acc[2] = {zero16(), zero16()};
#pragma unroll
  for (int s = 0; s < 8; ++s) {
    const bf16x8 a = *(const bf16x8*)(Xs + s * 32);
    const bf16x8 b0 = *(const bf16x8*)(Bsrc + s * 32), b1 = *(const bf16x8*)(Bsrc + 32 * PITCH128 + s * 32);
    acc[0] = MFMA32(a, b0, acc[0]); acc[1] = MFMA32(a, b1, acc[1]);
  }
  float* ST = (float*)(p.ws + OFF_ST) + ((size_t)(cg_ * 8 + h) * 2 + dir) * 4096;
#pragma unroll
  for (int nb = 0; nb < 2; ++nb)
#pragma unroll
    for (int r = 0; r < 16; ++r) ST[(pb * 32 + crow(r, half)) * 64 + nb * 32 + l32] = acc[nb][r];
  if (tid == 0) { float* cd = (float*)(p.ws + OFF_CDEC) + (size_t)(cg_ * 8 + h) * 2; cd[0] = __expf(aL); cd[1] = __expf(s0); }
}

template <int NC>
DI void ssd_scan_thread(const Params& p, int l, int seq, int r, int cg0, f32x4 hs) {
  const float* ST = (const float*)(p.ws + OFF_ST);
  bf16_t* HP = (bf16_t*)(p.ws + OFF_HP);
  const float* CD = (const float*)(p.ws + OFF_CDEC);
  const int h = r >> 11, dir = (r >> 10) & 1, pn = r & 1023;
  f32x4 st[NC]; float dec[NC];
#pragma unroll
  for (int c = 0; c < NC; ++c) {
    const int cgi = cg0 + (dir ? NC - 1 - c : c);
    st[c] = *(const f32x4*)(ST + ((size_t)(cgi * 8 + h) * 2 + dir) * 4096 + pn * 4);
    dec[c] = CD[(size_t)(cgi * 8 + h) * 2 + dir];
  }
#pragma unroll
  for (int c = 0; c < NC; ++c) {
    const int cgi = cg0 + (dir ? NC - 1 - c : c);
    u32x2 hv; hv[0] = pk2(hs[0], hs[1]); hv[1] = pk2(hs[2], hs[3]);
    *(u32x2*)(HP + ((size_t)(cgi * 8 + h) * 2 + dir) * 4096 + pn * 4) = hv;
    hs = dec[c] * hs + st[c];
  }
  if (seq < 16) *(f32x4*)(p.out + O_SSM + ((((size_t)seq * DEPTH + l) * 2 + dir) * 8 + h) * 4096 + pn * 4) = hs;
}
DI void ssd_scan_phase(const Params& p, int l) {
  constexpr int PER_SEQ = 8 * 2 * 64 * 16;
  for (int item = blockIdx.x; item < 20 * PER_SEQ / 512; item += gridDim.x) {
    const int idx = item * 512 + get_tid();
    const int sq = idx / PER_SEQ; const int r = idx % PER_SEQ;
    const int seq = (sq < 4) ? 16 + sq : sq - 4;
    if (seq < 16) ssd_scan_thread<2>(p, l, seq, r, 2 * seq, (f32x4){0.f, 0.f, 0.f, 0.f});
    else {
      const int dir = (r >> 10) & 1, h = r >> 11, pn = r & 1023;
      const f32x4 h0 = *(const f32x4*)(p.in[6] + ((((size_t)(seq - 16) * DEPTH + l) * 2 + dir) * 8 + h) * 4096 + pn * 4);
      ssd_scan_thread<16>(p, l, seq, r, 32 + 16 * (seq - 16), h0);
    }
  }
}

DI void ssd_y_item(const Params& p, int l, int cg_, char* lds_blk) {
  const int tid = get_tid4(), lane = tid & 63, w = tid >> 6, l32 = lane & 31, half = lane >> 5;
  const int g = get_hb();
  char* lds = lds_blk + g * HALF_LDS;
  char* Bs = lds; char* Cs = lds + 128 * PITCH64; char* XT = lds + 2 * 128 * PITCH64;
  char* Hf = XT + 64 * PITCH128; char* Hb = Hf + 64 * PITCH64;
  float* sc = (float*)(Hb + 64 * PITCH64);
  float* acf = sc, *sb = sc + 128, *dtf = sc + 256, *dtb = sc + 384;
  const int tok0 = cg_ * 128;
  const int i = w * 32 + l32, tok = tok0 + i;
  const bf16_t* xbc = (const bf16_t*)(p.ws + OFF_XBC) + (size_t)tok0 * 768;
  const bf16_t* proj = (const bf16_t*)(p.ws + OFF_PROJ);
  bf16_t* mix = (bf16_t*)(p.ws + OFF_MIX);
  float ssq = 0.f;
  {
    __syncthreads();
#pragma unroll
    for (int it = 0; it < 4; ++it) {
      const int t = tid + 256 * it, r = t >> 3, c = (t & 7) * 8;
      *(u32x4*)(Bs + r * PITCH64 + c * 2) = *(const u32x4*)(xbc + (size_t)r * 768 + 512 + g * 64 + c);
      *(u32x4*)(Cs + r * PITCH64 + c * 2) = *(const u32x4*)(xbc + (size_t)r * 768 + 640 + g * 64 + c);
    }
    __syncthreads();
    u32x4 xr[2][2]; float dpre0, dpre1;
    auto head_loads = [&](int h) {
#pragma unroll
      for (int it = 0; it < 2; ++it) {
        const int t = tid + 256 * it, jp = t & 63, pc = t >> 6, j0 = 2 * jp;
        xr[it][0] = *(const u32x4*)(xbc + (size_t)j0 * 768 + h * 64 + pc * 8);
        xr[it][1] = *(const u32x4*)(xbc + (size_t)(j0 + 1) * 768 + h * 64 + pc * 8);
      }
      ssd_dt_load(p, cg_, h, dpre0, dpre1);
    };
    head_loads(g * 4);
#pragma unroll 1
    for (int hh = 0; hh < 4; ++hh) {
      const int h = g * 4 + hh;
      u32x4 hr[2][2];
      {
        const bf16_t* hp = (const bf16_t*)(p.ws + OFF_HP) + (size_t)(cg_ * 8 + h) * 2 * 4096;
#pragma unroll
        for (int it = 0; it < 2; ++it) { const int t = tid + 256 * it, r = t >> 3, c = (t & 7) * 8; hr[it][0] = *(const u32x4*)(hp + r * 64 + c); hr[it][1] = *(const u32x4*)(hp + 4096 + r * 64 + c); }
      }
      __syncthreads();
#pragma unroll
      for (int it = 0; it < 2; ++it) {
        const int t = tid + 256 * it, jp = t & 63, pc = t >> 6, j0 = 2 * jp;
        const u32x4 x0 = xr[it][0], x1 = xr[it][1];
#pragma unroll
        for (int e = 0; e < 4; ++e) {
          const int pr = pc * 8 + 2 * e;
          *(unsigned*)(XT + pr * PITCH128 + j0 * 2) = (x0[e] & 0xffffu) | (x1[e] << 16);
          *(unsigned*)(XT + (pr + 1) * PITCH128 + j0 * 2) = (x0[e] >> 16) | (x1[e] & 0xffff0000u);
        }
        const int r = t >> 3, c = (t & 7) * 8;
        *(u32x4*)(Hf + r * PITCH64 + c * 2) = hr[it][0];
        *(u32x4*)(Hb + r * PITCH64 + c * 2) = hr[it][1];
      }
      ssd_scalars_from(p, l, h, dpre0, dpre1, acf, sb, dtf, dtb);
      __syncthreads();
      if (hh < 3) head_loads(h + 1);
      const float aif = acf[i], aib = sb[i];
      f32x16 Y[2] = {zero16(), zero16()};
      int iv = i, hv = half;
      asm volatile("" : "+v"(iv), "+v"(hv));
      bf16x8 cfr[4];
#pragma unroll
      for (int s = 0; s < 4; ++s) cfr[s] = *(const bf16x8*)(Cs + i * PITCH64 + s * 32 + hv * 16);
      u32x2 xpre[8], zpre[8];
#pragma unroll
      for (int q8 = 0; q8 < 8; ++q8) {
        const int pc = (q8 >> 2) * 32 + 8 * (q8 & 3) + 4 * hv;
        xpre[q8] = *(const u32x2*)(xbc + (size_t)i * 768 + h * 64 + pc);
        zpre[q8] = *(const u32x2*)(proj + (size_t)tok * NPROJP + C_Z + h * 64 + pc);
      }
#pragma unroll 1
      for (int jb = 0; jb < 4; ++jb) {
        f32x16 G = zero16();
#pragma unroll
        for (int s = 0; s < 4; ++s) {
          const bf16x8 a = *(const bf16x8*)(Bs + (jb * 32 + l32) * PITCH64 + s * 32 + hv * 16);
          G = MFMA32(a, cfr[s], G);
        }
        f32x16 m;
#pragma unroll
        for (int q = 0; q < 4; ++q) {
          const int jq = jb * 32 + 8 * q + 4 * hv;
          const f32x4 af4 = *(const f32x4*)(acf + jq), sb4 = *(const f32x4*)(sb + jq), df4 = *(const f32x4*)(dtf + jq), db4 = *(const f32x4*)(dtb + jq);
#pragma unroll
          for (int e = 0; e < 4; ++e) {
            const int j = jq + e;
            const bool lo_ = j < iv;
            const float arg = lo_ ? (aif - af4[e]) : (aib - sb4[e]);
            const float dsel = lo_ ? df4[e] : db4[e];
            float wgt = __expf(arg) * dsel;
            wgt = (j == iv) ? (df4[e] + db4[e]) : wgt;
            m[4 * q + e] = G[4 * q + e] * wgt;
          }
        }
#pragma unroll
        for (int s = 0; s < 2; ++s) {
          u32x4 mf; mf[0] = pk2(m[8 * s], m[8 * s + 1]); mf[1] = pk2(m[8 * s + 2], m[8 * s + 3]); mf[2] = pk2(m[8 * s + 4], m[8 * s + 5]); mf[3] = pk2(m[8 * s + 6], m[8 * s + 7]);
          const bf16x8 mfr = __builtin_bit_cast(bf16x8, mf);
#pragma unroll
          for (int pb = 0; pb < 2; ++pb) {
            const char* xa = XT + (pb * 32 + l32) * PITCH128 + (jb * 32 + 16 * s + 4 * hv) * 2;
            u32x4 av; const u32x2 lo = *(const u32x2*)xa, hi = *(const u32x2*)(xa + 16);
            av[0] = lo[0]; av[1] = lo[1]; av[2] = hi[0]; av[3] = hi[1];
            Y[pb] = MFMA32(__builtin_bit_cast(bf16x8, av), mfr, Y[pb]);
          }
        }
      }
      {
        const float ef = __expf(aif), eb = __expf(aib);
#pragma unroll
        for (int pb = 0; pb < 2; ++pb) {
#pragma unroll
          for (int d = 0; d < 2; ++d) {
            f32x16 tf = zero16();
            const char* Hs = d ? Hb : Hf;
#pragma unroll
            for (int s = 0; s < 4; ++s) {
              const bf16x8 a = *(const bf16x8*)(Hs + (pb * 32 + l32) * PITCH64 + s * 32 + hv * 16);
              tf = MFMA32(a, cfr[s], tf);
            }
            const float ee = d ? eb : ef;
#pragma unroll
            for (int r = 0; r < 16; ++r) Y[pb][r] += ee * tf[r];
          }
        }
      }
      const float Dh = p.in[32][(size_t)l * 8 + h];
#pragma unroll
      for (int pb = 0; pb < 2; ++pb)
#pragma unroll
        for (int q = 0; q < 4; ++q) {
          const int pc = pb * 32 + 8 * q + 4 * half;
          const u32x2 xv = xpre[pb * 4 + q];
          const u32x2 zv = zpre[pb * 4 + q];
          float y[4] = {Y[pb][4 * q] + Dh * bflo(xv[0]), Y[pb][4 * q + 1] + Dh * bfhi(xv[0]), Y[pb][4 * q + 2] + Dh * bflo(xv[1]), Y[pb][4 * q + 3] + Dh * bfhi(xv[1])};
          const float z[4] = {bflo(zv[0]), bfhi(zv[0]), bflo(zv[1]), bfhi(zv[1])};
#pragma unroll
          for (int e = 0; e < 4; ++e) { y[e] *= z[e] / (1.f + __expf(-z[e])); ssq += y[e] * y[e]; }
          u32x2 o; o[0] = pk2(y[0], y[1]); o[1] = pk2(y[2], y[3]);
          *(u32x2*)(mix + (size_t)tok * 1024 + 512 + h * 64 + pc) = o;
        }
    }
  }
  ssq += xor32(ssq);
  sc[512 + i] = ssq;
  __syncthreads();
  ssq += ((const float*)(lds_blk + (1 - g) * HALF_LDS + (2 * 128 * PITCH64 + 64 * PITCH128 + 2 * 64 * PITCH64)))[512 + i];
  const float rstd = rsqrtf(ssq * (1.f / 512.f) + EPS);
  const float* gn = p.in[33] + (size_t)l * 512;
  u32x2 vv[32];
#pragma unroll
  for (int e = 0; e < 32; ++e) {
    const int ch = (g * 4 + (e >> 3)) * 64 + ((e >> 2) & 1) * 32 + 8 * (e & 3) + 4 * half;
    vv[e] = *(const u32x2*)(mix + (size_t)tok * 1024 + 512 + ch);
  }
#pragma unroll
  for (int hq = 0; hq < 4; ++hq) {
    f32x4 gg[8];
#pragma unroll
    for (int e = 0; e < 8; ++e) gg[e] = *(const f32x4*)(gn + (g * 4 + hq) * 64 + (e >> 2) * 32 + 8 * (e & 3) + 4 * half);
#pragma unroll
    for (int e = 0; e < 8; ++e) {
      const int ch = (g * 4 + hq) * 64 + (e >> 2) * 32 + 8 * (e & 3) + 4 * half;
      const u32x2 v = vv[hq * 8 + e];
      u32x2 o; o[0] = pk2(bflo(v[0]) * rstd * gg[e][0], bfhi(v[0]) * rstd * gg[e][1]); o[1] = pk2(bflo(v[1]) * rstd * gg[e][2], bfhi(v[1]) * rstd * gg[e][3]);
      *(u32x2*)(mix + (size_t)tok * 1024 + 512 + ch) = o;
    }
  }
}

struct SeqInfo { int tok0, L, kbase, nk; };
DI SeqInfo seq_info(int s) { SeqInfo r; if (s < 16) { r.tok0 = s * 256; r.L = 256; r.kbase = s * 256; r.nk = 256; } else { r.tok0 = TP + (s - 16) * 2048; r.L = 2048; r.kbase = TP + (s - 16) * 2304; r.nk = 2304; } return r; }

DI void attn_mla_item(const Params& p, int item, char* lds) {
  const int tid = get_tid4(), lane = tid & 63, w = tid >> 6, l32 = lane & 31, half = lane >> 5;
  int seq, head, qb;
  if (item < 256) { seq = 16 + (item >> 6); head = (item >> 4) & 3; qb = item & 15; }
  else { const int it = item - 256; seq = it >> 3; head = (it >> 1) & 3; qb = it & 1; }
  const SeqInfo si = seq_info(seq);
  const int tok = si.tok0 + qb * 128 + w * 32 + l32;
  const bf16_t* qa = (const bf16_t*)(p.ws + OFF_QA) + (size_t)tok * 384 + head * 96;
  bf16x8 qf[6];
#pragma unroll
  for (int s = 0; s < 6; ++s) qf[s] = *(const bf16x8*)(qa + 16 * s + 8 * half);
  constexpr int KT = 64 * PITCH96, VT = 64 * PITCH64;
  char* Ks = lds; char* Vs = lds + 2 * KT;
  const bf16_t* kg = (const bf16_t*)(p.ws + OFF_KA) + (size_t)si.kbase * 384 + head * 96;
  const bf16_t* vg = (const bf16_t*)(p.ws + OFF_VAT) + (size_t)head * 64 * NKEY + si.kbase;
  u32x4 rk[3], rv[2];
  auto gload = [&](int t0) {
#pragma unroll
    for (int i = 0; i < 3; ++i) { const int c = tid + 256 * i, r = c / 12, cc = c % 12; rk[i] = *(const u32x4*)(kg + (size_t)(t0 + r) * 384 + cc * 8); }
#pragma unroll
    for (int i = 0; i < 2; ++i) { const int c = tid + 256 * i, r = c >> 3, cc = c & 7; rv[i] = *(const u32x4*)(vg + (size_t)r * NKEY + t0 + cc * 8); }
  };
  auto lstore = [&](int buf) {
#pragma unroll
    for (int i = 0; i < 3; ++i) { const int c = tid + 256 * i, r = c / 12, cc = c % 12; *(u32x4*)(Ks + buf * KT + r * PITCH96 + cc * 16) = rk[i]; }
#pragma unroll
    for (int i = 0; i < 2; ++i) { const int c = tid + 256 * i, r = c >> 3, cc = c & 7; *(u32x4*)(Vs + buf * VT + r * PITCH64 + cc * 16) = rv[i]; }
  };
  f32x16 O[2] = {zero16(), zero16()};
  float mrun = -1e30f, lsum = 0.f;
  const int nt = si.nk / 64;
  __syncthreads();
  gload(0); lstore(0);
  __syncthreads();
#pragma unroll 1
  for (int t = 0; t < nt; ++t) {
    const int cur = t & 1;
    if (t + 1 < nt) gload((t + 1) * 64);
    f32x16 S[2];
#pragma unroll
    for (int kb = 0; kb < 2; ++kb) {
      S[kb] = zero16();
#pragma unroll
      for (int s = 0; s < 6; ++s) {
        const bf16x8 a = *(const bf16x8*)(Ks + cur * KT + (kb * 32 + l32) * PITCH96 + s * 32 + half * 16);
        S[kb] = MFMA32(a, qf[s], S[kb]);
      }
    }
    float mx = S[0][0];
#pragma unroll
    for (int r = 0; r < 16; ++r) { mx = fmaxf(mx, S[0][r]); mx = fmaxf(mx, S[1][r]); }
    mx = fmaxf(mx, xor32(mx));
    if (__any(mx > mrun + 8.f)) {
      const float mnew = fmaxf(mrun, mx);
      const float alpha = __builtin_amdgcn_exp2f(mrun - mnew);
      mrun = mnew;
      lsum *= alpha;
#pragma unroll
      for (int r = 0; r < 16; ++r) { O[0][r] *= alpha; O[1][r] *= alpha; }
    }
    float ps = 0.f;
#pragma unroll
    for (int kb = 0; kb < 2; ++kb)
#pragma unroll
      for (int r = 0; r < 16; ++r) { const float e = __builtin_amdgcn_exp2f(S[kb][r] - mrun); S[kb][r] = e; ps += e; }
    lsum += ps;
#pragma unroll
    for (int kb = 0; kb < 2; ++kb)
#pragma unroll
      for (int s = 0; s < 2; ++s) {
        u32x4 pf; pf[0] = pk2(S[kb][8 * s], S[kb][8 * s + 1]); pf[1] = pk2(S[kb][8 * s + 2], S[kb][8 * s + 3]); pf[2] = pk2(S[kb][8 * s + 4], S[kb][8 * s + 5]); pf[3] = pk2(S[kb][8 * s + 6], S[kb][8 * s + 7]);
        const bf16x8 pfr = __builtin_bit_cast(bf16x8, pf);
#pragma unroll
        for (int dvb = 0; dvb < 2; ++dvb) {
          const char* va = Vs + cur * VT + (dvb * 32 + l32) * PITCH64 + (kb * 32 + 16 * s + 4 * half) * 2;
          u32x4 av; const u32x2 lo = *(const u32x2*)va, hi = *(const u32x2*)(va + 16);
          av[0] = lo[0]; av[1] = lo[1]; av[2] = hi[0]; av[3] = hi[1];
          O[dvb] = MFMA32(__builtin_bit_cast(bf16x8, av), pfr, O[dvb]);
        }
      }
    if (t + 1 < nt) lstore(cur ^ 1);
    __syncthreads();
  }
  lsum += xor32(lsum);
  const float inv = 1.f / lsum;
  bf16_t* mix = (bf16_t*)(p.ws + OFF_MIX) + (size_t)tok * 1024 + head * 64;
#pragma unroll
  for (int dvb = 0; dvb < 2; ++dvb) {
#pragma unroll
    for (int r = 0; r < 16; ++r) O[dvb][r] *= inv;
    store_block_bf16(mix + dvb * 32, O[dvb], half);
  }
}

constexpr int PITCH32 = 80;
DI void attn_diff_item(const Params& p, int l, int item, char* lds_blk) {
  const int tid = get_tid4(), lane = tid & 63, w = tid >> 6, l32 = lane & 31, half = lane >> 5;
  const int hbk = get_hb();
  char* lds = lds_blk + hbk * HALF_LDS;
  int seq, head, qb;
  if (item < 256) { seq = 16 + (item >> 6); head = (item >> 4) & 3; qb = item & 15; }
  else { const int it = item - 256; seq = it >> 3; head = (it >> 1) & 3; qb = it & 1; }
  const SeqInfo si = seq_info(seq);
  const int tok = si.tok0 + qb * 128 + w * 32 + l32;
  constexpr int KT = 64 * PITCH32, VT = 64 * PITCH64;
  char* Ks = lds; char* Vs = lds + 2 * KT;
  const bf16_t* vg = (const bf16_t*)(p.ws + OFF_VDT) + (size_t)head * 64 * NKEY + si.kbase;
  const int nt = si.nk / 64;
  const float lam_init = ((const float*)(p.ws + OFF_LAM))[l * 2 + 1];
  const float lam = ((const float*)(p.ws + OFF_LAM))[l * 2];
  f32x16 R[2] = {zero16(), zero16()};
#pragma unroll 1
  for (int mp = hbk; mp < hbk + 1; ++mp) {
    const bf16_t* qd = (const bf16_t*)(p.ws + OFF_QD) + (size_t)tok * 256 + head * 64 + mp * 32;
    bf16x8 qf[2];
#pragma unroll
    for (int s = 0; s < 2; ++s) qf[s] = *(const bf16x8*)(qd + 16 * s + 8 * half);
    const bf16_t* kg = (const bf16_t*)(p.ws + OFF_KD) + (size_t)si.kbase * 256 + head * 64 + mp * 32;
    u32x4 rk, rv[2];
    auto gload = [&](int t0) {
      rk = *(const u32x4*)(kg + (size_t)(t0 + (tid >> 2)) * 256 + (tid & 3) * 8);
#pragma unroll
      for (int i = 0; i < 2; ++i) { const int c = tid + 256 * i, r = c >> 3, cc = c & 7; rv[i] = *(const u32x4*)(vg + (size_t)r * NKEY + t0 + cc * 8); }
    };
    auto lstore = [&](int buf) {
      *(u32x4*)(Ks + buf * KT + (tid >> 2) * PITCH32 + (tid & 3) * 16) = rk;
#pragma unroll
      for (int i = 0; i < 2; ++i) { const int c = tid + 256 * i, r = c >> 3, cc = c & 7; *(u32x4*)(Vs + buf * VT + r * PITCH64 + cc * 16) = rv[i]; }
    };
    f32x16 O[2] = {zero16(), zero16()};
    float mrun = -1e30f, lsum = 0.f;
    __syncthreads();
    gload(0); lstore(0);
    __syncthreads();
#pragma unroll 1
    for (int t = 0; t < nt; ++t) {
      const int cur = t & 1;
      if (t + 1 < nt) gload((t + 1) * 64);
      f32x16 S[2];
#pragma unroll
      for (int kb = 0; kb < 2; ++kb) {
        S[kb] = zero16();
#pragma unroll
        for (int s = 0; s < 2; ++s) {
          const bf16x8 a = *(const bf16x8*)(Ks + cur * KT + (kb * 32 + l32) * PITCH32 + s * 32 + half * 16);
          S[kb] = MFMA32(a, qf[s], S[kb]);
        }
      }
      float mx = S[0][0];
#pragma unroll
      for (int r = 0; r < 16; ++r) { mx = fmaxf(mx, S[0][r]); mx = fmaxf(mx, S[1][r]); }
      mx = fmaxf(mx, xor32(mx));
      if (__any(mx > mrun + 8.f)) {
        const float mnew = fmaxf(mrun, mx);
        const float alpha = __builtin_amdgcn_exp2f(mrun - mnew);
        mrun = mnew;
        lsum *= alpha;
#pragma unroll
        for (int r = 0; r < 16; ++r) { O[0][r] *= alpha; O[1][r] *= alpha; }
      }
      float ps = 0.f;
#pragma unroll
      for (int kb = 0; kb < 2; ++kb)
#pragma unroll
        for (int r = 0; r < 16; ++r) { const float e = __builtin_amdgcn_exp2f(S[kb][r] - mrun); S[kb][r] = e; ps += e; }
      lsum += ps;
#pragma unroll
      for (int kb = 0; kb < 2; ++kb)
#pragma unroll
        for (int s = 0; s < 2; ++s) {
          u32x4 pf; pf[0] = pk2(S[kb][8 * s], S[kb][8 * s + 1]); pf[1] = pk2(S[kb][8 * s + 2], S[kb][8 * s + 3]); pf[2] = pk2(S[kb][8 * s + 4], S[kb][8 * s + 5]); pf[3] = pk2(S[kb][8 * s + 6], S[kb][8 * s + 7]);
          const bf16x8 pfr = __builtin_bit_cast(bf16x8, pf);
#pragma unroll
          for (int dvb = 0; dvb < 2; ++dvb) {
            const char* va = Vs + cur * VT + (dvb * 32 + l32) * PITCH64 + (kb * 32 + 16 * s + 4 * half) * 2;
            u32x4 av; const u32x2 lo = *(const u32x2*)va, hi = *(const u32x2*)(va + 16);
            av[0] = lo[0]; av[1] = lo[1]; av[2] = hi[0]; av[3] = hi[1];
            O[dvb] = MFMA32(__builtin_bit_cast(bf16x8, av), pfr, O[dvb]);
          }
        }
      if (t + 1 < nt) lstore(cur ^ 1);
      __syncthreads();
    }
    lsum += xor32(lsum);
    const float coef = (mp == 0) ? 1.f / lsum : -lam / lsum;
#pragma unroll
    for (int dvb = 0; dvb < 2; ++dvb)
#pragma unroll
      for (int r = 0; r < 16; ++r) R[dvb][r] += O[dvb][r] * coef;
  }
  {
    constexpr int XO = 32768;
    float* xo = (float*)(lds + XO);
    if (hbk == 1) {
#pragma unroll
      for (int dvb = 0; dvb < 2; ++dvb)
#pragma unroll
        for (int r = 0; r < 16; ++r) xo[((w * 2 + dvb) * 16 + r) * 64 + lane] = R[dvb][r];
    }
    __syncthreads();
    if (hbk == 1) return;
    const float* xi = (const float*)(lds_blk + HALF_LDS + XO);
#pragma unroll
    for (int dvb = 0; dvb < 2; ++dvb)
#pragma unroll
      for (int r = 0; r < 16; ++r) R[dvb][r] += xi[((w * 2 + dvb) * 16 + r) * 64 + lane];
  }
  float ss = sumsq16(R[0]) + sumsq16(R[1]);
  ss += xor32(ss);
  const float rstd = rsqrtf(ss * (1.f / 64.f) + EPS) * (1.f - lam_init);
  const float* gs = p.in[27] + (size_t)l * 64;
  bf16_t* mix = (bf16_t*)(p.ws + OFF_MIX) + (size_t)tok * 1024 + 256 + head * 64;
#pragma unroll
  for (int dvb = 0; dvb < 2; ++dvb) {
    { const f32x16 gb = gain_block(gs + dvb * 32, half);
#pragma unroll
      for (int r = 0; r < 16; ++r) R[dvb][r] *= rstd * gb[r]; }
    store_block_bf16(mix + dvb * 32, R[dvb], half);
  }
}

DI void run_phase(const Params& p, int ph, char* lds, int* s_item, int vb) {
#ifdef ONLY_SUB
  const int l = (ph - 1) / 10, sub = ONLY_SUB;
  if (ONLY_SUB == 10) { setup_phase(p, lds); return; }
#else
  if (ph == 0) { setup_phase(p, lds); return; }
  const int l = (ph - 1) / 10, sub = (ph - 1) % 10;
#endif
  const float* modl = (const float*)(p.ws + OFF_MOD) + (size_t)l * 5 * 6144;
  switch (sub) {
    case 0: norm_phase(p, l, 0); break;
    case 1: {
      EpiInProj epi{(bf16_t*)(p.ws + OFF_PROJ), (float*)(p.ws + OFF_DT)};
      const bf16_t* A = (const bf16_t*)(p.ws + OFF_HBUF);
      const bf16_t* Bt = (const bf16_t*)(p.ws + OFF_WIN) + (size_t)l * NPROJP * 1024;
      gemm_phase<256>(A, 1024, Bt, 1024, 1024, 48, 10, lds, vb, epi);
    } break;
    case 2: prep_phase(p, l, lds); break;
    case 3: {
      const int hb = get_hb();
      for (int pair = blockIdx.x; pair < NCHUNK * 4; pair += gridDim.x) ssd_states_item(p, l, pair * 2 + hb, lds + hb * HALF_LDS);
    } break;
    case 4: ssd_scan_phase(p, l); break;
    case 5: {
      unsigned* ctr = (unsigned*)(p.ws + OFF_CTR) + l;
      const int hb = get_hb();
      for (;;) {
        __syncthreads();
        if (threadIdx.x == 0) *s_item = (int)atomicAdd(ctr, 1u);
        __syncthreads();
        const int it = *s_item;
        const int n_tail = (l + 1 < DEPTH) ? TR_PER_L / 2 : 0;
        if (it >= 672 + n_tail) break;
        if (it >= 672) { tr_item(p, (l + 1) * TR_PER_L + (it - 672) * 2 + hb, lds + hb * HALF_LDS); continue; }
        if (it < 96) ssd_y_item(p, l, it, lds);
        else if (it < 224) attn_mla_item(p, (it - 96) * 2 + hb, lds + hb * HALF_LDS);
        else if (it < 480) attn_diff_item(p, l, it - 224, lds);
        else if (it < 544) attn_mla_item(p, 256 + (it - 480) * 2 + hb, lds + hb * HALF_LDS);
        else attn_diff_item(p, l, 256 + (it - 544), lds);
      }
    } break;
    case 6: {
      EpiResid epi{l == 0 ? p.in[0] : nullptr, l == 0 ? p.in[1] : nullptr, (bf16_t*)(p.ws + OFF_XB), nullptr, modl + 2048};
      const bf16_t* A = (const bf16_t*)(p.ws + OFF_MIX);
      const bf16_t* Bt = (const bf16_t*)(p.ws + OFF_WOUT) + (size_t)l * 1024 * 1024;
      gemm_phase<192>(A, 1024, Bt, 1024, 1024, 64, 4, lds, vb, epi);
    } break;
    case 7: norm_phase(p, l, 1); break;
    case 8: {
      EpiFF1 epi{(bf16_t*)(p.ws + OFF_UBUF)};
      const bf16_t* A = (const bf16_t*)(p.ws + OFF_HBUF);
      const bf16_t* Bt = (const bf16_t*)(p.ws + OFF_WFF1) + (size_t)l * 4096 * 1024;
      gemm_phase<256>(A, 1024, Bt, 1024, 1024, 48, 16, lds, vb, epi);
    } break;
    case 9: {
      EpiResid epi{nullptr, nullptr, (bf16_t*)(p.ws + OFF_XB), l == DEPTH - 1 ? p.out : nullptr, modl + 5120};
      const bf16_t* A = (const bf16_t*)(p.ws + OFF_UBUF);
      const bf16_t* Bt = (const bf16_t*)(p.ws + OFF_WFF2) + (size_t)l * 1024 * 4096;
      gemm_phase<192>(A, 4096, Bt, 4096, 4096, 64, 4, lds, vb, epi);
    } break;
  }
}

constexpr int N_PHASES = 1 + 10 * DEPTH;

__global__ void __launch_bounds__(512, 2) fwd_megakernel(Params p) {
  __shared__ __attribute__((aligned(1024))) char lds[LDS_BYTES + 64];
  uint4& xb_words = *(uint4*)(lds + LDS_BYTES);
  int* s_item = (int*)(lds + LDS_BYTES + 16);
  if (p.ph_end - p.ph_begin == 1) { run_phase(p, p.ph_begin, lds, s_item, blockIdx.x); return; }
  if (p.ph_begin < 0) { cg::this_grid().sync(); return; }
  if (threadIdx.x == 0) xb_words = make_uint4(0u, 0u, 0u, 0u);
  __syncthreads();
  XcdBarrier b = xcd_barrier_post((unsigned*)(p.ws + OFF_BAR), (volatile LAS unsigned*)&xb_words);
  unsigned* xrank = (unsigned*)(p.ws + OFF_XRANK);
  if (threadIdx.x == 0) s_item[1] = (int)atomicAdd(&xrank[b.x], 1u);
  int vb = blockIdx.x;
  for (int ph = p.ph_begin; ph < p.ph_end; ++ph) {
    run_phase(p, ph, lds, s_item, vb);
    if (ph + 1 < p.ph_end) xcd_barrier(b);
    if (ph == p.ph_begin) {
      bool ok = (gridDim.x % 8) == 0;
      for (int j = 0; j < 16; ++j) { const unsigned c = xb_ld(&xrank[j]); ok = ok && (j < 8 ? c == gridDim.x / 8 : c == 0u); }
      vb = ok ? s_item[1] * 8 + (int)b.x : (int)blockIdx.x;
    }
  }
}

extern "C" void kernel_launch(void* const* d_in, const int* in_sizes, int n_in, void* d_out, int out_size, void* d_ws, size_t ws_size, hipStream_t stream) {
  static int grid_blocks = 0;
  if (!grid_blocks) {
    int dev = 0, cus = 0, per_cu = 0;
    (void)hipGetDevice(&dev);
    (void)hipDeviceGetAttribute(&cus, hipDeviceAttributeMultiprocessorCount, dev);
    (void)hipOccupancyMaxActiveBlocksPerMultiprocessor(&per_cu, fwd_megakernel, 512, 0);
    if (per_cu > 1) per_cu = 1;
    if (per_cu < 1) per_cu = 1;
    grid_blocks = cus * per_cu;
  }
  Params p{};
  for (int i = 0; i < 36; ++i) p.in[i] = (const float*)d_in[i];
  p.out = (float*)d_out;
  p.ws = (char*)d_ws;
  (void)hipMemsetAsync(d_ws, 0, 16384, stream);
#if MULTI_LAUNCH
  for (int ph = 0; ph < N_PHASES; ++ph) {
    p.ph_begin = ph; p.ph_end = ph + 1;
    hipLaunchKernelGGL(fwd_megakernel, dim3(grid_blocks), dim3(512), 0, stream, p);
  }
#else
  p.ph_begin = 0; p.ph_end = N_PHASES;
  void* args[] = {&p};
  hipError_t e = hipLaunchCooperativeKernel((void*)fwd_megakernel, dim3(grid_blocks), dim3(512), args, 0, stream);
  if (e != hipSuccess) fprintf(stderr, "cooperative launch failed: %s (grid %d)\n", hipGetErrorString(e), grid_blocks);
#endif
}
```

```cpp
#include <hip/hip_runtime.h>
#include <hip/hip_cooperative_groups.h>
#include <stdint.h>
#include <stdio.h>
namespace cg = cooperative_groups;

#ifndef MULTI_LAUNCH
#define MULTI_LAUNCH 0
#endif

#define DI __device__ __forceinline__
#define LAS __attribute__((address_space(3)))
typedef unsigned short bf16_t;
typedef short bf16x8 __attribute__((ext_vector_type(8)));
typedef short s16x4 __attribute__((ext_vector_type(4)));
typedef float f32x16 __attribute__((ext_vector_type(16)));
typedef float f32x4 __attribute__((ext_vector_type(4)));
typedef unsigned u32x4 __attribute__((ext_vector_type(4)));
typedef unsigned u32x2 __attribute__((ext_vector_type(2)));
#define MFMA32(a, b, c) __builtin_amdgcn_mfma_f32_32x32x16_bf16((a), (b), (c), 0, 0, 0)

constexpr int D = 1024, TP = 4096, TS = 8192, T = 12288, DEPTH = 4, PAST = 256;
constexpr int NPROJ = 2480, NPROJP = 2560, DFF = 4096;
constexpr int NKEY = 4096 + 4 * 2304;
constexpr int C_CQ = 0, C_CKV = 256, C_KR = 384, C_DQ = 416, C_DK = 672, C_DV = 928, C_Z = 1184, C_XBC = 1696, C_DT = 2464;
constexpr float EPS = 1e-6f;
constexpr int NCHUNK = 96;

constexpr size_t O_Y = 0, O_CKV = 12582912, O_KROPE = 14680064, O_DK = 15204352, O_DV = 19398656, O_SSM = 23592960;

constexpr size_t OFF_BAR = 0;
constexpr size_t OFF_XRANK = 14080;
constexpr size_t OFF_CTR = 14336;
constexpr size_t OFF_LAM = 15360;
constexpr size_t OFF_MOD = 16384;
constexpr size_t OFF_ROPE = OFF_MOD + 4ull * 5 * 6144 * 4;
constexpr size_t OFF_WIN = OFF_ROPE + 2048ull * 32 * 4;
constexpr size_t OFF_WOUT = OFF_WIN + 4ull * NPROJP * 1024 * 2;
constexpr size_t OFF_WFF1 = OFF_WOUT + 4ull * 1024 * 1024 * 2;
constexpr size_t OFF_WFF2 = OFF_WFF1 + 4ull * 4096 * 1024 * 2;
constexpr size_t OFF_WUQ = OFF_WFF2 + 4ull * 4096 * 1024 * 2;
constexpr size_t OFF_WUKV = OFF_WUQ + 4ull * 384 * 256 * 2;
constexpr size_t OFF_HBUF = OFF_WUKV + 4ull * 512 * 128 * 2;
constexpr size_t OFF_MIX = OFF_HBUF + (size_t)T * 1024 * 2;
constexpr size_t OFF_DT = OFF_MIX + (size_t)T * 1024 * 2;
constexpr size_t OFF_R = OFF_DT + (size_t)T * 16 * 4;
constexpr size_t OFF_UBUF = OFF_R;
constexpr size_t OFF_PROJ = OFF_R;
constexpr size_t OFF_QA = OFF_PROJ + (size_t)T * NPROJP * 2;
constexpr size_t OFF_KA = OFF_QA + (size_t)T * 384 * 2;
constexpr size_t OFF_VAT = OFF_KA + (size_t)NKEY * 384 * 2;
constexpr size_t OFF_QD = OFF_VAT + 256ull * NKEY * 2;
constexpr size_t OFF_KD = OFF_QD + (size_t)T * 256 * 2;
constexpr size_t OFF_VDT = OFF_KD + (size_t)NKEY * 256 * 2;
constexpr size_t OFF_XBC = OFF_VDT + 256ull * NKEY * 2;
constexpr size_t OFF_ST = OFF_XBC + (size_t)T * 768 * 2;
constexpr size_t OFF_HP = OFF_ST + 96ull * 8 * 2 * 4096 * 4;
constexpr size_t OFF_CDEC = OFF_HP + 96ull * 8 * 2 * 4096 * 2;
constexpr size_t OFF_XB = OFF_CDEC + 96ull * 16 * 4;
constexpr size_t WS_END = OFF_XB + (size_t)T * 1024 * 2;

struct Params {
  const float* in[36];
  float* out;
  char* ws;
  int ph_begin, ph_end;
};

DI unsigned pk2(float lo, float hi) { unsigned r; asm("v_cvt_pk_bf16_f32 %0, %1, %2" : "=v"(r) : "v"(lo), "v"(hi)); return r; }
DI float bflo(unsigned u) { return __uint_as_float(u << 16); }
DI float bfhi(unsigned u) { return __uint_as_float(u & 0xffff0000u); }
DI float bf1(bf16_t h) { return __uint_as_float(((unsigned)h) << 16); }
DI bf16_t f2bf(float x) { return (bf16_t)(pk2(x, 0.f) & 0xffffu); }
DI int crow(int r, int half) { return (r & 3) + 8 * (r >> 2) + 4 * half; }
DI float xor32(float v) { return __shfl_xor(v, 32); }
DI float wave_sum(float v) {
#pragma unroll
  for (int o = 32; o > 0; o >>= 1) v += __shfl_xor(v, o);
  return v;
}
DI f32x16 zero16() { f32x16 z; for (int i = 0; i < 16; ++i) z[i] = 0.f; return z; }
DI int get_tid() { int t = threadIdx.x; asm volatile("" : "+v"(t)); return t; }
DI int get_tid4() { return get_tid() & 255; }
DI int get_hb() { return get_tid() >> 8; }
DI int modrow_of(int m) { return m < TP ? 0 : 1 + ((m - TP) >> 11); }

#define XB_TMO      128
#define XB_XCNT(j)  (256  + 64 * (j))
#define XB_XSUB(j)  (1280 + 64 * (j))
#define XB_XGEN(j)  (2304 + 64 * (j))
#define XB_TOP      3328
#define XB_TOPGEN   3392
#define XCD_BAR_WORDS 3456
#define XB_SPIN_CAP (1u << 22)
DI unsigned xb_ld(unsigned* p) { return __hip_atomic_load(p, __ATOMIC_RELAXED, __HIP_MEMORY_SCOPE_AGENT); }
DI unsigned xb_add(unsigned* p, unsigned v) { return __hip_atomic_fetch_add(p, v, __ATOMIC_RELAXED, __HIP_MEMORY_SCOPE_AGENT); }
DI unsigned xb_xcc_id() { return (unsigned)__builtin_amdgcn_s_getreg((3 << 11) | 20) & 0xFu; }
#define XB_SPIN(cond, bar) do { unsigned _sp = 0; while (cond) { __builtin_amdgcn_s_sleep(1); \
    if ((++_sp & 255u) == 0u) { if (xb_ld(&(bar)[XB_TMO])) break; if (_sp > XB_SPIN_CAP) { atomicAdd(&(bar)[XB_TMO], 1u); break; } } } } while (0)
struct XcdBarrier { unsigned* bar; unsigned x; volatile LAS unsigned* st; };
DI XcdBarrier xcd_barrier_post(unsigned* bar, volatile LAS unsigned* st) {
  XcdBarrier b; b.bar = bar; b.x = xb_xcc_id(); b.st = st;
  if (threadIdx.x == 0) (void)xb_add(&bar[XB_XCNT(b.x)], 1u);
  return b;
}
DI void xcd_barrier_complete(unsigned* bar, unsigned x, unsigned& nloc, unsigned& nx) {
  const unsigned G = gridDim.x * gridDim.y * gridDim.z;
  unsigned sum, cnt, mine, sp = 0u;
  for (;;) {
    sum = 0u; cnt = 0u; mine = 0u;
#pragma unroll
    for (unsigned j = 0; j < 16; ++j) { const unsigned c = xb_ld(&bar[XB_XCNT(j)]); sum += c; cnt += (c > 0u) ? 1u : 0u; mine = (j == x) ? c : mine; }
    if (sum == G) break;
    __builtin_amdgcn_s_sleep(1);
    if ((++sp & 255u) == 0u) { if (xb_ld(&bar[XB_TMO])) break; if (sp > XB_SPIN_CAP) { atomicAdd(&bar[XB_TMO], 1u); break; } }
  }
  nloc = mine > 0u ? mine : 1u; nx = cnt > 0u ? cnt : 1u;
}
DI void xcd_barrier(const XcdBarrier& b) {
  asm volatile("s_waitcnt vmcnt(0)" ::: "memory");
  __syncthreads();
  if (threadIdx.x == 0) {
    unsigned* bar = b.bar;
    __builtin_amdgcn_s_waitcnt(0);
    unsigned nloc = b.st[0], nx = b.st[1];
    if (nloc == 0u) { xcd_barrier_complete(bar, b.x, nloc, nx); b.st[0] = nloc; b.st[1] = nx; }
    const unsigned old = xb_add(&bar[XB_XSUB(b.x)], 1u);
    const unsigned gen = old / nloc;
    if (old + 1u == (gen + 1u) * nloc) {
      __builtin_amdgcn_fence(__ATOMIC_RELEASE, "agent");
      asm volatile("s_waitcnt vmcnt(0)" ::: "memory");
      const unsigned og = xb_add(&bar[XB_TOP], 1u);
      const unsigned tg = og / nx;
      if (og + 1u == (tg + 1u) * nx) xb_add(&bar[XB_TOPGEN], 1u);
      else XB_SPIN(xb_ld(&bar[XB_TOPGEN]) == tg, bar);
      __builtin_amdgcn_fence(__ATOMIC_ACQUIRE, "agent");
      xb_add(&bar[XB_XGEN(b.x)], 1u);
      asm volatile("s_waitcnt vmcnt(0)" ::: "memory");
    } else {
      XB_SPIN(xb_ld(&bar[XB_XGEN(b.x)]) == gen, bar);
      __builtin_amdgcn_fence(__ATOMIC_ACQUIRE, "agent");
      asm volatile("s_waitcnt vmcnt(0)" ::: "memory");
    }
  }
  __syncthreads();
}

constexpr int HALF_LDS = 75776;
constexpr int LDS_BYTES = 2 * HALF_LDS;
constexpr int PITCH64 = 144;
constexpr int PITCH128 = 272;
constexpr int PITCH96 = 208;

DI void transpose_tile4(const float* src, int K, int N, bf16_t* dst, int t0, int ncols, char* lds) {
  float* tile = (float*)lds;
  const int tid = get_tid4();
  f32x4 v[4][4];
#pragma unroll
  for (int q = 0; q < 4; ++q) {
    const int k0 = ((t0 + q) / ncols) * 64, n0 = ((t0 + q) % ncols) * 64;
#pragma unroll
    for (int i = 0; i < 4; ++i) {
      const int r = (tid >> 4) + 16 * i, c4 = (tid & 15) * 4;
      v[q][i] = (f32x4){0.f, 0.f, 0.f, 0.f};
      if (n0 + c4 < N) v[q][i] = *(const f32x4*)(src + (size_t)(k0 + r) * N + n0 + c4);
    }
  }
  __syncthreads();
#pragma unroll
  for (int q = 0; q < 4; ++q)
#pragma unroll
    for (int i = 0; i < 4; ++i) {
      const int r = (tid >> 4) + 16 * i, c4 = (tid & 15) * 4;
      float* t = tile + q * (64 * 65) + r * 65 + c4;
      t[0] = v[q][i][0]; t[1] = v[q][i][1]; t[2] = v[q][i][2]; t[3] = v[q][i][3];
    }
  __syncthreads();
#pragma unroll
  for (int q = 0; q < 4; ++q) {
    const int k0 = ((t0 + q) / ncols) * 64, n0 = ((t0 + q) % ncols) * 64;
    const float* tq = tile + q * (64 * 65);
#pragma unroll
    for (int i = 0; i < 2; ++i) {
      const int n = (tid >> 3) + 32 * i, kc = (tid & 7) * 8;
      u32x4 w;
      w[0] = pk2(tq[(kc + 0) * 65 + n], tq[(kc + 1) * 65 + n]);
      w[1] = pk2(tq[(kc + 2) * 65 + n], tq[(kc + 3) * 65 + n]);
      w[2] = pk2(tq[(kc + 4) * 65 + n], tq[(kc + 5) * 65 + n]);
      w[3] = pk2(tq[(kc + 6) * 65 + n], tq[(kc + 7) * 65 + n]);
      *(u32x4*)(dst + (size_t)(n0 + n) * K + k0 + kc) = w;
    }
  }
}

DI void mod_item(const Params& p, int item, char* lds) {
  float* sc = (float*)lds;
  float* red = sc + 5 * 1024;
  const int tid = get_tid4(), lane = tid & 63, w = tid >> 6;
  const int l = item / 96, j0 = (item % 96) * 64;
  __syncthreads();
  for (int i = tid; i < 5 * 1024; i += 256) {
    const int r = i >> 10, k = i & 1023;
    const float v = (r == 0) ? p.in[8][k] : p.in[7][(r - 1) * 1024 + k];
    sc[i] = v / (1.f + __expf(-v));
  }
  __syncthreads();
  const float* W = p.in[11] + (size_t)l * 1024 * 6144 + j0 + lane;
  float a0 = 0.f, a1 = 0.f, a2 = 0.f, a3 = 0.f, a4 = 0.f;
  const int kb = w * 256;
#pragma unroll 32
  for (int k = 0; k < 256; ++k) {
    const float wv = W[(size_t)(kb + k) * 6144];
    a0 += sc[kb + k] * wv; a1 += sc[1024 + kb + k] * wv; a2 += sc[2048 + kb + k] * wv; a3 += sc[3072 + kb + k] * wv; a4 += sc[4096 + kb + k] * wv;
  }
  red[(w * 5 + 0) * 64 + lane] = a0; red[(w * 5 + 1) * 64 + lane] = a1; red[(w * 5 + 2) * 64 + lane] = a2;
  red[(w * 5 + 3) * 64 + lane] = a3; red[(w * 5 + 4) * 64 + lane] = a4;
  __syncthreads();
  for (int i = tid; i < 320; i += 256) {
    const int r = i / 64, c = i % 64;
    const float s = red[(0 * 5 + r) * 64 + c] + red[(1 * 5 + r) * 64 + c] + red[(2 * 5 + r) * 64 + c] + red[(3 * 5 + r) * 64 + c];
    float* mod = (float*)(p.ws + OFF_MOD);
    mod[((size_t)l * 5 + r) * 6144 + j0 + c] = s + p.in[12][(size_t)l * 6144 + j0 + c];
  }
}

DI void setup_phase(const Params& p, char* lds) {
  constexpr int N_IN = 16 * 40 / 4, N_OUT = 16 * 16 / 4, N_F1 = 16 * 64 / 4, N_F2 = 64 * 16 / 4, N_UQ = 4 * 6 / 4, N_UKV = 2 * 8 / 4;
  constexpr int PER_L = N_IN + N_OUT + N_F1 + N_F2 + N_UQ + N_UKV;
  constexpr int N_TR = PER_L * 4, N_MOD = 384, N_ROPE = 64;
  static_assert((N_MOD + N_TR) % 2 == 0, "pairing");
  if (blockIdx.x == 0 && get_tid() < 4) {
    const int l = get_tid();
    float d1 = 0.f, d2 = 0.f;
    for (int k = 0; k < 32; ++k) { d1 += p.in[23][l * 32 + k] * p.in[24][l * 32 + k]; d2 += p.in[25][l * 32 + k] * p.in[26][l * 32 + k]; }
    const float lam_init = 0.8f - 0.6f * expf(-0.3f * (float)l);
    float* lamp = (float*)(p.ws + OFF_LAM);
    lamp[l * 2] = expf(d1) - expf(d2) + lam_init; lamp[l * 2 + 1] = lam_init;
  }
  const int hb = get_hb();
  lds += hb * HALF_LDS;
  for (int pair = blockIdx.x; pair < (N_MOD + N_TR) / 2; pair += gridDim.x) {
    const int item = pair * 2 + hb;
    if (item < N_MOD) { mod_item(p, item, lds); continue; }
    int it = item - N_MOD;
    {
      const int l = it / PER_L; int r = it % PER_L;
      if (r < N_IN) { transpose_tile4(p.in[13] + (size_t)l * 1024 * NPROJ, 1024, NPROJ, (bf16_t*)(p.ws + OFF_WIN) + (size_t)l * NPROJP * 1024, r * 4, 40, lds); continue; }
      r -= N_IN;
      if (r < N_OUT) { transpose_tile4(p.in[14] + (size_t)l * 1024 * 1024, 1024, 1024, (bf16_t*)(p.ws + OFF_WOUT) + (size_t)l * 1024 * 1024, r * 4, 16, lds); continue; }
      r -= N_OUT;
      if (r < N_F1) { transpose_tile4(p.in[34] + (size_t)l * 1024 * 4096, 1024, 4096, (bf16_t*)(p.ws + OFF_WFF1) + (size_t)l * 4096 * 1024, r * 4, 64, lds); continue; }
      r -= N_F1;
      if (r < N_F2) { transpose_tile4(p.in[35] + (size_t)l * 4096 * 1024, 4096, 1024, (bf16_t*)(p.ws + OFF_WFF2) + (size_t)l * 1024 * 4096, r * 4, 16, lds); continue; }
      r -= N_F2;
      if (r < N_UQ) { transpose_tile4(p.in[17] + (size_t)l * 256 * 384, 256, 384, (bf16_t*)(p.ws + OFF_WUQ) + (size_t)l * 384 * 256, r * 4, 6, lds); continue; }
      r -= N_UQ;
      transpose_tile4(p.in[18] + (size_t)l * 128 * 512, 128, 512, (bf16_t*)(p.ws + OFF_WUKV) + (size_t)l * 512 * 128, r * 4, 8, lds);
    }
  }
  for (int it = blockIdx.x; it < N_ROPE; it += gridDim.x) {
    {
      const int idx = it * 512 + get_tid();
      const int pos = idx >> 4, j = idx & 15;
      const float fr = __builtin_amdgcn_exp2f(-(float)(j & 7) * (13.287712379549449f / 8.f));
      const float base = (j < 8) ? (float)(pos >> 6) : (float)(pos & 63);
      float rev = base * fr * 0.15915494309189535f;
      rev -= floorf(rev);
      float* tab = (float*)(p.ws + OFF_ROPE);
      tab[idx * 2 + 0] = __builtin_amdgcn_cosf(rev);
      tab[idx * 2 + 1] = __builtin_amdgcn_sinf(rev);
    }
  }
}

DI const float* x_row_in(const Params& p, int l, int m) {
  if (l == 0) return m < TP ? p.in[0] + (size_t)m * D : p.in[1] + (size_t)(m - TP) * D;
  return p.out + (size_t)m * D;
}
DI void norm_phase(const Params& p, int l, int which) {
  const int tid = get_tid(), lane = tid & 63, w = tid >> 6;
  const float* g = p.in[which == 0 ? 9 : 10] + (size_t)l * D;
  const float* modl = (const float*)(p.ws + OFF_MOD) + (size_t)l * 5 * 6144;
  bf16_t* hbuf = (bf16_t*)(p.ws + OFF_HBUF);
  constexpr int RW = 6;
  for (int item = blockIdx.x; item < T / (8 * RW); item += gridDim.x) {
    const int m0 = item * 8 * RW + w * RW;
    f32x4 v[RW][4];
#pragma unroll
    for (int rr = 0; rr < RW; ++rr) {
      if (which == 0 && l == 0) {
        const float* x = x_row_in(p, 0, m0 + rr);
#pragma unroll
        for (int i = 0; i < 4; ++i) v[rr][i] = *(const f32x4*)(x + i * 256 + lane * 4);
      } else {
        const bf16_t* x = (const bf16_t*)(p.ws + OFF_XB) + (size_t)(m0 + rr) * D;
#pragma unroll
        for (int i = 0; i < 4; ++i) { const u32x2 r = *(const u32x2*)(x + i * 256 + lane * 4); v[rr][i] = (f32x4){bflo(r[0]), bfhi(r[0]), bflo(r[1]), bfhi(r[1])}; }
      }
    }
    f32x4 gg[4];
#pragma unroll
    for (int i = 0; i < 4; ++i) gg[i] = *(const f32x4*)(g + i * 256 + lane * 4);
#pragma unroll
    for (int rr = 0; rr < RW; ++rr) {
      const int m = m0 + rr;
      const float* mod = modl + (size_t)modrow_of(m) * 6144 + (which == 0 ? 0 : 3072);
      float ss = 0.f;
#pragma unroll
      for (int i = 0; i < 4; ++i) ss += v[rr][i][0] * v[rr][i][0] + v[rr][i][1] * v[rr][i][1] + v[rr][i][2] * v[rr][i][2] + v[rr][i][3] * v[rr][i][3];
      ss = wave_sum(ss);
      const float rstd = rsqrtf(ss * (1.f / D) + EPS);
#pragma unroll
      for (int i = 0; i < 4; ++i) {
        const int c = i * 256 + lane * 4;
        const f32x4 sh = *(const f32x4*)(mod + c), scl = *(const f32x4*)(mod + 1024 + c);
        float o[4];
#pragma unroll
        for (int e = 0; e < 4; ++e) o[e] = v[rr][i][e] * rstd * gg[i][e] * (1.f + scl[e]) + sh[e];
        u32x2 wv; wv[0] = pk2(o[0], o[1]); wv[1] = pk2(o[2], o[3]);
        *(u32x2*)(hbuf + (size_t)m * D + c) = wv;
      }
    }
  }
}

DI int lds_byte2(int r, int c) { const int st = (r >> 4) * 2 + (c >> 5), ob = (r & 15) * 64 + (c & 31) * 2; return st * 1024 + (ob ^ (((ob >> 9) & 1) << 5)); }
DI void stage_rc2(int b, int& R, int& C) { const int st = b >> 10, sb = b & 1023, swz = sb ^ (((sb >> 9) & 1) << 5); R = (st >> 1) * 16 + swz / 64; C = (st & 1) * 32 + (swz % 64) / 2; }
#define WAIT_V0() asm volatile("s_waitcnt vmcnt(0)" ::: "memory")
DI bool unit_next(int vb, int i, int nM, int nN, int& pm, int& pn) {
  const int nwg = nM * nN;
  const long L = (long)i * gridDim.x + vb; if (L >= nwg) return false;
  int wgid = (int)L; { const int q = nwg / 8, r = nwg % 8, xcd = wgid % 8, off = wgid / 8; wgid = (xcd < r ? xcd * (q + 1) : r * (q + 1) + (xcd - r) * q) + off; }
  const int nig = 8 * nN, gid = wgid / nig, fm = gid * 8, gsz = (nM - fm) < 8 ? (nM - fm) : 8;
  pm = fm + ((wgid % nig) % gsz); pn = (wgid % nig) / gsz; return true;
}
template <int BM, class Epi>
DI void gemm_phase(const bf16_t* __restrict__ A, int lda, const bf16_t* __restrict__ Bt, int ldb, int K, int nM, int nN, char* shm, int vb, Epi epi) {
  constexpr int BK = 64, TILE_B = 256 * BK * 2, GL = 4, STAGE_B = 2 * TILE_B, GLA = BM / 64, MB = BM / 32;
  const int tid = get_tid(), wid = tid >> 6, lane = tid & 63, wr = wid >> 2, wc = wid & 3, fr = lane & 15, fq = lane >> 4;
  int sR[GL], sC[GL];
#pragma unroll
  for (int i = 0; i < GL; ++i) stage_rc2(wid * 1024 + i * 8192 + lane * 16, sR[i], sC[i]);
  const int lo_ = (fr * 64 + fq * 16) ^ ((fr >> 3) << 5);
  const int aoff = wr * (BM / 32) * 2048 + lo_, boff = TILE_B + wc * 8192 + lo_;
  int sRB[GL];
#pragma unroll
  for (int i = 0; i < GL; ++i) { const int rho = sR[i] & 31, nn = rho >> 4, ii = rho & 15; sRB[i] = (sR[i] & ~31) + 8 * (ii >> 2) + 4 * nn + (ii & 3); }
#define SA_(b) (shm + (b) * STAGE_B)
#define SB_(b) (shm + (b) * STAGE_B + TILE_B)
#define GLDS_STAGE(buf, Ab_, Bb_, kt) do { _Pragma("unroll") for (int i = 0; i < GL; ++i) { \
    if (i < GLA) __builtin_amdgcn_global_load_lds((const unsigned*)((Ab_) + (size_t)sR[i] * lda + (kt) * BK + sC[i]), (LAS unsigned*)(SA_(buf) + wid * 1024 + i * 8192), 16, 0, 0); \
    __builtin_amdgcn_global_load_lds((const unsigned*)((Bb_) + (size_t)sRB[i] * ldb + (kt) * BK + sC[i]), (LAS unsigned*)(SB_(buf) + wid * 1024 + i * 8192), 16, 0, 0); } } while (0)
  int pm, pn;
  if (!unit_next(vb, 0, nM, nN, pm, pn)) return;
  const int nt = K / BK;
  GLDS_STAGE(0, A + (size_t)pm * BM * lda, Bt + (size_t)pn * 256 * ldb, 0);
#pragma unroll 1
  for (int ui = 0;; ++ui) {
    int npm = 0, npn = 0;
    const bool hn = unit_next(vb, ui + 1, nM, nN, npm, npn);
    f32x4 acc[MB][4];
#pragma unroll
    for (int m = 0; m < MB; ++m)
#pragma unroll
      for (int n = 0; n < 4; ++n) acc[m][n] = (f32x4){0.f, 0.f, 0.f, 0.f};
    WAIT_V0(); __syncthreads();
#pragma unroll 1
    for (int t = 0; t < nt; ++t) {
      const int cur = t & 1;
      {
        const bool last = t + 1 >= nt;
        if (!last || hn) {
          const bf16_t* Ab = A + (size_t)(last ? npm : pm) * BM * lda + (last ? 0 : (t + 1) * BK);
          const bf16_t* Bb = Bt + (size_t)(last ? npn : pn) * 256 * ldb + (last ? 0 : (t + 1) * BK);
          GLDS_STAGE(cur ^ 1, Ab, Bb, 0);
        }
      }
      if constexpr (BM == 192) {
        bf16x8 At[2][MB], Bf[2][4];
#pragma unroll
        for (int ks = 0; ks < 2; ++ks) {
#pragma unroll
          for (int n = 0; n < 4; ++n) Bf[ks][n] = *(const bf16x8*)(shm + cur * STAGE_B + boff + (n * 2 + ks) * 1024);
#pragma unroll
          for (int m = 0; m < MB; ++m) At[ks][m] = *(const bf16x8*)(shm + cur * STAGE_B + aoff + (m * 2 + ks) * 1024);
          __builtin_amdgcn_sched_barrier(0);
        }
#pragma unroll
        for (int ks = 0; ks < 2; ++ks) {
#pragma unroll
          for (int m = 0; m < MB; ++m)
#pragma unroll
            for (int n = 0; n < 4; ++n) acc[m][n] = __builtin_amdgcn_mfma_f32_16x16x32_bf16(Bf[ks][n], At[ks][m], acc[m][n], 0, 0, 0);
          __builtin_amdgcn_sched_barrier(0);
        }
      } else {
#pragma unroll
        for (int ks = 0; ks < 2; ++ks) {
          bf16x8 At[MB], Bf[4];
#pragma unroll
          for (int n = 0; n < 4; ++n) Bf[n] = *(const bf16x8*)(shm + cur * STAGE_B + boff + (n * 2 + ks) * 1024);
#pragma unroll
          for (int m = 0; m < MB; ++m) At[m] = *(const bf16x8*)(shm + cur * STAGE_B + aoff + (m * 2 + ks) * 1024);
          __builtin_amdgcn_sched_barrier(0);
#pragma unroll
          for (int m = 0; m < MB; ++m)
#pragma unroll
            for (int n = 0; n < 4; ++n) acc[m][n] = __builtin_amdgcn_mfma_f32_16x16x32_bf16(Bf[n], At[m], acc[m][n], 0, 0, 0);
          __builtin_amdgcn_sched_barrier(0);
        }
      }
      if (t + 1 < nt) { WAIT_V0(); __syncthreads(); }
    }
    const int brow = pm * BM, bcol = pn * 256;
    if constexpr (Epi::PRELOAD) {
      u32x4 xr[MB][2];
#pragma unroll
      for (int m = 0; m < MB; ++m)
#pragma unroll
        for (int g2 = 0; g2 < 2; ++g2) xr[m][g2] = epi.preload(brow + wr * (BM / 2) + m * 16 + fr, bcol + wc * 64 + g2 * 32 + fq * 8);
#pragma unroll
      for (int m = 0; m < MB; ++m)
#pragma unroll
        for (int g2 = 0; g2 < 2; ++g2) epi(brow + wr * (BM / 2) + m * 16 + fr, bcol + wc * 64 + g2 * 32 + fq * 8, acc[m][2 * g2], acc[m][2 * g2 + 1], xr[m][g2]);
    } else {
#pragma unroll
      for (int m = 0; m < MB; ++m)
#pragma unroll
        for (int g2 = 0; g2 < 2; ++g2) epi(brow + wr * (BM / 2) + m * 16 + fr, bcol + wc * 64 + g2 * 32 + fq * 8, acc[m][2 * g2], acc[m][2 * g2 + 1]);
    }
    if (!hn) break;
    pm = npm; pn = npn;
  }
  __syncthreads();
#undef SA_
#undef SB_
#undef GLDS_STAGE
}

struct EpiInProj {
  static constexpr bool PRELOAD = false;
  bf16_t* proj; float* dt;
  DI void operator()(int m, int n, const f32x4& v0, const f32x4& v1) const {
    u32x4 o; o[0] = pk2(v0[0], v0[1]); o[1] = pk2(v0[2], v0[3]); o[2] = pk2(v1[0], v1[1]); o[3] = pk2(v1[2], v1[3]);
    *(u32x4*)(proj + (size_t)m * NPROJP + n) = o;
    if (n >= C_DT && n < NPROJ) { float* d = dt + (size_t)m * 16 + (n - C_DT); *(f32x4*)d = v0; *(f32x4*)(d + 4) = v1; }
  }
};
struct EpiResid {
  static constexpr bool PRELOAD = true;
  const float* xin_p; const float* xin_s;
  bf16_t* xb; float* xout_f;
  const float* gate;
  DI u32x4 preload(int m, int n) const { return xin_p ? (u32x4){0u, 0u, 0u, 0u} : *(const u32x4*)(xb + (size_t)m * D + n); }
  DI void operator()(int m, int n, const f32x4& v0, const f32x4& v1, const u32x4& r) const {
    const float* gp = gate + (size_t)modrow_of(m) * 6144 + n;
    const f32x4 g0 = *(const f32x4*)gp, g1 = *(const f32x4*)(gp + 4);
    f32x4 x0, x1;
    if (xin_p) { const float* xi = ((m < TP) ? xin_p + (size_t)m * D : xin_s + (size_t)(m - TP) * D) + n; x0 = *(const f32x4*)xi; x1 = *(const f32x4*)(xi + 4); }
    else { x0 = (f32x4){bflo(r[0]), bfhi(r[0]), bflo(r[1]), bfhi(r[1])}; x1 = (f32x4){bflo(r[2]), bfhi(r[2]), bflo(r[3]), bfhi(r[3])}; }
    const f32x4 y0 = x0 + g0 * v0, y1 = x1 + g1 * v1;
    if (xout_f) { float* o = xout_f + (size_t)m * D + n; *(f32x4*)o = y0; *(f32x4*)(o + 4) = y1; }
    else { u32x4 o; o[0] = pk2(y0[0], y0[1]); o[1] = pk2(y0[2], y0[3]); o[2] = pk2(y1[0], y1[1]); o[3] = pk2(y1[2], y1[3]); *(u32x4*)(xb + (size_t)m * D + n) = o; }
  }
};
struct EpiFF1 {
  static constexpr bool PRELOAD = false;
  bf16_t* u;
  DI void operator()(int m, int n, const f32x4& v0, const f32x4& v1) const {
    float r[8];
#pragma unroll
    for (int e = 0; e < 4; ++e) { const float t0 = v0[e] > 0.f ? v0[e] : 0.f, t1 = v1[e] > 0.f ? v1[e] : 0.f; r[e] = t0 * t0; r[4 + e] = t1 * t1; }
    u32x4 o; o[0] = pk2(r[0], r[1]); o[1] = pk2(r[2], r[3]); o[2] = pk2(r[4], r[5]); o[3] = pk2(r[6], r[7]);
    *(u32x4*)(u + (size_t)m * DFF + n) = o;
  }
};

DI void rope_block(f32x16& v, const float* tab, int pos, int half) {
  const float* t = tab + (size_t)pos * 32;
#pragma unroll
  for (int q = 0; q < 2; ++q)
#pragma unroll
    for (int r = 0; r < 4; ++r) {
      const int fi = q * 8 + r + 4 * half;
      const float c = t[fi * 2], s = t[fi * 2 + 1];
      const float x1 = v[q * 8 + r], x2 = v[q * 8 + r + 4];
      v[q * 8 + r] = x1 * c - x2 * s;
      v[q * 8 + r + 4] = x2 * c + x1 * s;
    }
}
DI void store_block_bf16(bf16_t* dst, const f32x16& v, int half) {
#pragma unroll
  for (int q = 0; q < 4; ++q) {
    u32x2 wv; wv[0] = pk2(v[4 * q], v[4 * q + 1]); wv[1] = pk2(v[4 * q + 2], v[4 * q + 3]);
    *(u32x2*)(dst + 8 * q + 4 * half) = wv;
  }
}
DI f32x16 gain_block(const float* g, int half) {
  f32x16 o;
#pragma unroll
  for (int q = 0; q < 4; ++q) { const f32x4 v = *(const f32x4*)(g + 8 * q + 4 * half); o[4 * q] = v[0]; o[4 * q + 1] = v[1]; o[4 * q + 2] = v[2]; o[4 * q + 3] = v[3]; }
  return o;
}
DI float sumsq16(const f32x16& v) { float s = 0.f;
#pragma unroll
  for (int i = 0; i < 16; ++i) s += v[i] * v[i];
  return s; }

DI void mla_q_item(const Params& p, int l, int item4, char* lds) {
  const int item = item4 >> 2, head0 = item4 & 3;
  const int lane = get_tid() & 63, w = get_tid() >> 6, l32 = lane & 31, half = lane >> 5;
  {
    const bf16_t* Wg = (const bf16_t*)(p.ws + OFF_WUQ) + ((size_t)l * 384 + head0 * 96) * 256;
    u32x4 t[6];
#pragma unroll
    for (int i = 0; i < 6; ++i) { const int c = get_tid() + 512 * i; t[i] = *(const u32x4*)(Wg + (size_t)(c >> 5) * 256 + (c & 31) * 8); }
    __syncthreads();
#pragma unroll
    for (int i = 0; i < 6; ++i) { const int c = get_tid() + 512 * i; *(u32x4*)(lds + (c >> 5) * 528 + (c & 31) * 16) = t[i]; }
    if (get_tid() < 64) *(f32x4*)(lds + 50688 + get_tid() * 16) = *(const f32x4*)(p.in[15] + (size_t)l * 256 + get_tid() * 4);
  }
  const int tok = item * 256 + w * 32 + l32;
  const bf16_t* proj = (const bf16_t*)(p.ws + OFF_PROJ) + (size_t)tok * NPROJP + C_CQ;
  const float* gq = p.in[15] + (size_t)l * 256;
  float ss = 0.f;
  u32x4 raw[16];
#pragma unroll
  for (int s = 0; s < 16; ++s) raw[s] = *(const u32x4*)(proj + 16 * s + 8 * half);
#pragma unroll
  for (int s = 0; s < 16; ++s) {
#pragma unroll
    for (int e = 0; e < 4; ++e) { const float a = bflo(raw[s][e]), b = bfhi(raw[s][e]); ss += a * a + b * b; }
  }
  ss += xor32(ss);
  const float rstd = rsqrtf(ss * (1.f / 256.f) + EPS);
  __syncthreads();
  bf16x8 fr[16];
#pragma unroll
  for (int s = 0; s < 16; ++s) {
    const f32x4 g0 = *(const f32x4*)(lds + 50688 + (16 * s + 8 * half) * 4), g1 = *(const f32x4*)(lds + 50688 + (16 * s + 8 * half + 4) * 4);
    u32x4 o;
    o[0] = pk2(bflo(raw[s][0]) * rstd * g0[0], bfhi(raw[s][0]) * rstd * g0[1]);
    o[1] = pk2(bflo(raw[s][1]) * rstd * g0[2], bfhi(raw[s][1]) * rstd * g0[3]);
    o[2] = pk2(bflo(raw[s][2]) * rstd * g1[0], bfhi(raw[s][2]) * rstd * g1[1]);
    o[3] = pk2(bflo(raw[s][3]) * rstd * g1[2], bfhi(raw[s][3]) * rstd * g1[3]);
    fr[s] = __builtin_bit_cast(bf16x8, o);
  }
  const bf16_t* W = (const bf16_t*)(p.ws + OFF_WUQ) + (size_t)l * 384 * 256;
  const float* gqk = p.in[19] + (size_t)l * 96;
  const float* tab = (const float*)(p.ws + OFF_ROPE);
  const bool rope = tok >= TP;
  const int pos = rope ? ((tok - TP) & 2047) : 0;
  const float qscale = 0.10206207261596577f * 1.4426950408889634f;
  bf16_t* qa = (bf16_t*)(p.ws + OFF_QA) + (size_t)tok * 384;
#pragma unroll 1
  for (int head = head0; head < head0 + 1; ++head) {
    f32x16 acc[3];
#pragma unroll
    for (int db = 0; db < 3; ++db) acc[db] = zero16();
#pragma unroll
    for (int db = 0; db < 3; ++db) {
      bf16x8 a[16];
      const char* wrow = lds + (db * 32 + l32) * 528 + 16 * half;
#pragma unroll
      for (int s = 0; s < 16; ++s) a[s] = *(const bf16x8*)(wrow + 32 * s);
      __builtin_amdgcn_sched_barrier(0);
#pragma unroll
      for (int s = 0; s < 16; ++s) acc[db] = MFMA32(a[s], fr[s], acc[db]);
      __builtin_amdgcn_sched_barrier(0);
    }
    float s2 = sumsq16(acc[0]) + sumsq16(acc[1]) + sumsq16(acc[2]);
    s2 += xor32(s2);
    const float r2 = rsqrtf(s2 * (1.f / 96.f) + EPS);
#pragma unroll
    for (int db = 0; db < 3; ++db) {
      const f32x16 gb = gain_block(gqk + db * 32, half);
#pragma unroll
      for (int r = 0; r < 16; ++r) acc[db][r] *= r2 * gb[r];
    }
    if (rope) rope_block(acc[2], tab, pos, half);
#pragma unroll
    for (int db = 0; db < 3; ++db) {
#pragma unroll
      for (int r = 0; r < 16; ++r) acc[db][r] *= qscale;
      store_block_bf16(qa + head * 96 + db * 32, acc[db], half);
    }
  }
}

DI void mla_kv_item(const Params& p, int l, int item4, char* lds) {
  const int item = item4 >> 2, head0 = item4 & 3;
  const int lane = get_tid() & 63, w = get_tid() >> 6, l32 = lane & 31, half = lane >> 5;
  {
    const bf16_t* Wg = (const bf16_t*)(p.ws + OFF_WUKV) + ((size_t)l * 512 + head0 * 128) * 128;
    u32x4 t[4];
#pragma unroll
    for (int i = 0; i < 4; ++i) { const int c = get_tid() + 512 * i; t[i] = *(const u32x4*)(Wg + (size_t)(c >> 4) * 128 + (c & 15) * 8); }
    __syncthreads();
#pragma unroll
    for (int i = 0; i < 4; ++i) { const int c = get_tid() + 512 * i; *(u32x4*)(lds + (c >> 4) * PITCH128 + (c & 15) * 16) = t[i]; }
  }
  const int kr = item * 256 + w * 32 + l32;
  int tok = -1, b = 0, j = 0; bool cached = false, rope = false; int pos = 0;
  if (kr < TP) { tok = kr; }
  else { b = (kr - TP) / 2304; j = (kr - TP) % 2304; if (j < PAST) cached = true; else { tok = TP + b * 2048 + (j - PAST); rope = true; pos = j - PAST; } }
  bf16x8 fr[8];
  f32x16 krb;
  if (!cached) {
    const bf16_t* proj = (const bf16_t*)(p.ws + OFF_PROJ) + (size_t)tok * NPROJP;
    const float* gkv = p.in[16] + (size_t)l * 128;
    u32x4 raw[8]; float ss = 0.f;
    f32x4 gv0[8], gv1[8]; u32x2 rvv[4];
#pragma unroll
    for (int s = 0; s < 8; ++s) raw[s] = *(const u32x4*)(proj + C_CKV + 16 * s + 8 * half);
#pragma unroll
    for (int s = 0; s < 8; ++s) { gv0[s] = *(const f32x4*)(gkv + 16 * s + 8 * half); gv1[s] = *(const f32x4*)(gkv + 16 * s + 8 * half + 4); }
#pragma unroll
    for (int q = 0; q < 4; ++q) rvv[q] = *(const u32x2*)(proj + C_KR + 8 * q + 4 * half);
#pragma unroll
    for (int s = 0; s < 8; ++s) {
#pragma unroll
      for (int e = 0; e < 4; ++e) { const float a = bflo(raw[s][e]), bb = bfhi(raw[s][e]); ss += a * a + bb * bb; }
    }
    ss += xor32(ss);
    const float rstd = rsqrtf(ss * (1.f / 128.f) + EPS);
#pragma unroll
    for (int s = 0; s < 8; ++s) {
      const f32x4 g0 = gv0[s], g1 = gv1[s];
      f32x4 o0, o1;
      o0[0] = bflo(raw[s][0]) * rstd * g0[0]; o0[1] = bfhi(raw[s][0]) * rstd * g0[1]; o0[2] = bflo(raw[s][1]) * rstd * g0[2]; o0[3] = bfhi(raw[s][1]) * rstd * g0[3];
      o1[0] = bflo(raw[s][2]) * rstd * g1[0]; o1[1] = bfhi(raw[s][2]) * rstd * g1[1]; o1[2] = bflo(raw[s][3]) * rstd * g1[2]; o1[3] = bfhi(raw[s][3]) * rstd * g1[3];
      u32x4 o; o[0] = pk2(o0[0], o0[1]); o[1] = pk2(o0[2], o0[3]); o[2] = pk2(o1[0], o1[1]); o[3] = pk2(o1[2], o1[3]);
      fr[s] = __builtin_bit_cast(bf16x8, o);
      if (tok < TP && head0 == 0) {
        float* dst = p.out + O_CKV + (((size_t)(tok >> 8) * DEPTH + l) * 256 + (tok & 255)) * 128 + 16 * s + 8 * half;
        *(f32x4*)dst = o0; *(f32x4*)(dst + 4) = o1;
      }
    }
#pragma unroll
    for (int q = 0; q < 4; ++q) {
      const u32x2 rv = rvv[q];
      krb[4 * q] = bflo(rv[0]); krb[4 * q + 1] = bfhi(rv[0]); krb[4 * q + 2] = bflo(rv[1]); krb[4 * q + 3] = bfhi(rv[1]);
      if (tok < TP && head0 == 0) {
        float* dst = p.out + O_KROPE + (((size_t)(tok >> 8) * DEPTH + l) * 256 + (tok & 255)) * 32 + 8 * q + 4 * half;
        f32x4 o = {krb[4 * q], krb[4 * q + 1], krb[4 * q + 2], krb[4 * q + 3]};
        *(f32x4*)dst = o;
      }
    }
  } else {
    const float* src = p.in[2] + (((size_t)b * DEPTH + l) * PAST + j) * 128;
#pragma unroll
    for (int s = 0; s < 8; ++s) {
      const f32x4 v0 = *(const f32x4*)(src + 16 * s + 8 * half), v1 = *(const f32x4*)(src + 16 * s + 8 * half + 4);
      u32x4 o; o[0] = pk2(v0[0], v0[1]); o[1] = pk2(v0[2], v0[3]); o[2] = pk2(v1[0], v1[1]); o[3] = pk2(v1[2], v1[3]);
      fr[s] = __builtin_bit_cast(bf16x8, o);
    }
    const float* ks = p.in[3] + (((size_t)b * DEPTH + l) * PAST + j) * 32;
#pragma unroll
    for (int q = 0; q < 4; ++q) {
      const f32x4 v = *(const f32x4*)(ks + 8 * q + 4 * half);
      krb[4 * q] = v[0]; krb[4 * q + 1] = v[1]; krb[4 * q + 2] = v[2]; krb[4 * q + 3] = v[3];
    }
  }
  const bf16_t* W = (const bf16_t*)(p.ws + OFF_WUKV) + (size_t)l * 512 * 128;
  const float* gk = p.in[20] + (size_t)l * 96;
  const float* tab = (const float*)(p.ws + OFF_ROPE);
  bf16_t* ka = (bf16_t*)(p.ws + OFF_KA) + (size_t)kr * 384;
  bf16_t* vat = (bf16_t*)(p.ws + OFF_VAT);
  const float ssr = sumsq16(krb);
  __syncthreads();
#pragma unroll 1
  for (int head = head0; head < head0 + 1; ++head) {
    f32x16 acc[4];
#pragma unroll
    for (int db = 0; db < 4; ++db) acc[db] = zero16();
#pragma unroll
    for (int dp = 0; dp < 2; ++dp) {
      bf16x8 a[2][8];
#pragma unroll
      for (int d2 = 0; d2 < 2; ++d2)
#pragma unroll
        for (int s = 0; s < 8; ++s) a[d2][s] = *(const bf16x8*)(lds + ((dp * 2 + d2) * 32 + l32) * PITCH128 + 32 * s + 16 * half);
      __builtin_amdgcn_sched_barrier(0);
#pragma unroll
      for (int d2 = 0; d2 < 2; ++d2)
#pragma unroll
        for (int s = 0; s < 8; ++s) acc[dp * 2 + d2] = MFMA32(a[d2][s], fr[s], acc[dp * 2 + d2]);
      __builtin_amdgcn_sched_barrier(0);
    }
    float s2 = sumsq16(acc[0]) + sumsq16(acc[1]) + ssr;
    s2 += xor32(s2);
    const float r2 = rsqrtf(s2 * (1.f / 96.f) + EPS);
    f32x16 k2;
    {
      const f32x16 g0 = gain_block(gk, half), g1 = gain_block(gk + 32, half), g2 = gain_block(gk + 64, half);
#pragma unroll
      for (int r = 0; r < 16; ++r) { acc[0][r] *= r2 * g0[r]; acc[1][r] *= r2 * g1[r]; k2[r] = krb[r] * r2 * g2[r]; }
    }
    if (rope) rope_block(k2, tab, pos, half);
    store_block_bf16(ka + head * 96, acc[0], half);
    store_block_bf16(ka + head * 96 + 32, acc[1], half);
    store_block_bf16(ka + head * 96 + 64, k2, half);
#pragma unroll
    for (int db = 2; db < 4; ++db)
#pragma unroll
      for (int r = 0; r < 16; ++r)
        vat[((size_t)head * 64 + (db - 2) * 32 + crow(r, half)) * NKEY + kr] = f2bf(acc[db][r]);
  }
}

DI void diff_qk_thread(const Params& p, int l, int idx, bool isk) {
  const float* tab = (const float*)(p.ws + OFF_ROPE);
  const int hm = idx & 7, row = idx >> 3;
  float x[32];
  int tok = -1, pos = 0; bool rope = false, cached = false;
  if (!isk) { tok = row; if (tok >= TP) { rope = true; pos = (tok - TP) & 2047; } }
  else {
    if (row < TP) tok = row;
    else { const int b = (row - TP) / 2304, j = (row - TP) % 2304;
      if (j < PAST) { cached = true;
        const float* src = p.in[4] + ((((size_t)b * DEPTH + l) * PAST + j) * 8 + hm) * 32;
#pragma unroll
        for (int i = 0; i < 8; ++i) { const f32x4 v = *(const f32x4*)(src + 4 * i); x[4 * i] = v[0]; x[4 * i + 1] = v[1]; x[4 * i + 2] = v[2]; x[4 * i + 3] = v[3]; }
      } else { tok = TP + b * 2048 + (j - PAST); rope = true; pos = j - PAST; } }
  }
  if (!cached) {
    const bf16_t* src = (const bf16_t*)(p.ws + OFF_PROJ) + (size_t)tok * NPROJP + (isk ? C_DK : C_DQ) + hm * 32;
    float ss = 0.f;
#pragma unroll
    for (int i = 0; i < 4; ++i) {
      const u32x4 v = *(const u32x4*)(src + 8 * i);
#pragma unroll
      for (int e = 0; e < 4; ++e) { x[8 * i + 2 * e] = bflo(v[e]); x[8 * i + 2 * e + 1] = bfhi(v[e]); }
    }
#pragma unroll
    for (int i = 0; i < 32; ++i) ss += x[i] * x[i];
    const float rstd = rsqrtf(ss * (1.f / 32.f) + EPS);
    const float* g = p.in[isk ? 22 : 21] + (size_t)l * 32;
#pragma unroll
    for (int i = 0; i < 32; ++i) x[i] *= rstd * g[i];
    if (isk && tok < TP) {
      float* dst = p.out + O_DK + (((size_t)(tok >> 8) * DEPTH + l) * 256 + (tok & 255)) * 256 + hm * 32;
#pragma unroll
      for (int i = 0; i < 8; ++i) { f32x4 o = {x[4 * i], x[4 * i + 1], x[4 * i + 2], x[4 * i + 3]}; *(f32x4*)(dst + 4 * i) = o; }
    }
    if (rope) {
      const float* t = tab + (size_t)pos * 32;
#pragma unroll
      for (int q = 0; q < 2; ++q)
#pragma unroll
        for (int m = 0; m < 8; ++m) {
          const float c = t[(q * 8 + m) * 2], s = t[(q * 8 + m) * 2 + 1];
          const float x1 = x[q * 16 + m], x2 = x[q * 16 + 8 + m];
          x[q * 16 + m] = x1 * c - x2 * s; x[q * 16 + 8 + m] = x2 * c + x1 * s;
        }
    }
  }
  const float sc = isk ? 1.f : 0.17677669529663687f * 1.4426950408889634f;
  bf16_t* dst = (bf16_t*)(p.ws + (isk ? OFF_KD : OFF_QD)) + (size_t)row * 256 + hm * 32;
#pragma unroll
  for (int i = 0; i < 4; ++i) {
    u32x4 o;
#pragma unroll
    for (int e = 0; e < 4; ++e) o[e] = pk2(x[8 * i + 2 * e] * sc, x[8 * i + 2 * e + 1] * sc);
    *(u32x4*)(dst + 8 * i) = o;
  }
}
DI void diff_v_thread(const Params& p, int l, int idx) {
  const int head = idx / NKEY, kr = idx % NKEY;
  bf16_t* vdt = (bf16_t*)(p.ws + OFF_VDT) + (size_t)head * 64 * NKEY + kr;
  int tok = -1;
  if (kr < TP) tok = kr;
  else { const int b = (kr - TP) / 2304, j = (kr - TP) % 2304;
    if (j < PAST) {
      const float* src = p.in[5] + ((((size_t)b * DEPTH + l) * PAST + j) * 4 + head) * 64;
#pragma unroll
      for (int i = 0; i < 16; ++i) { const f32x4 v = *(const f32x4*)(src + 4 * i);
#pragma unroll
        for (int e = 0; e < 4; ++e) vdt[(size_t)(4 * i + e) * NKEY] = f2bf(v[e]); }
      return;
    }
    tok = TP + b * 2048 + (j - PAST);
  }
  const bf16_t* src = (const bf16_t*)(p.ws + OFF_PROJ) + (size_t)tok * NPROJP + C_DV + head * 64;
  float* od = (tok < TP) ? p.out + O_DV + (((size_t)(tok >> 8) * DEPTH + l) * 256 + (tok & 255)) * 256 + head * 64 : nullptr;
#pragma unroll
  for (int i = 0; i < 8; ++i) {
    const u32x4 v = *(const u32x4*)(src + 8 * i);
#pragma unroll
    for (int e = 0; e < 4; ++e) {
      vdt[(size_t)(8 * i + 2 * e) * NKEY] = (bf16_t)(v[e] & 0xffffu);
      vdt[(size_t)(8 * i + 2 * e + 1) * NKEY] = (bf16_t)(v[e] >> 16);
    }
    if (od) {
      f32x4 o0 = {bflo(v[0]), bfhi(v[0]), bflo(v[1]), bfhi(v[1])}, o1 = {bflo(v[2]), bfhi(v[2]), bflo(v[3]), bfhi(v[3])};
      *(f32x4*)(od + 8 * i) = o0; *(f32x4*)(od + 8 * i + 4) = o1;
    }
  }
}
template <int CU>
DI void conv_threads(const Params& p, int l, int idx0, int stride) {
  u32x4 v[CU][5]; f32x4 bia[CU][2];
  int tokv[CU], c0v[CU];
#pragma unroll
  for (int u = 0; u < CU; ++u) {
    const int idx = idx0 + u * stride;
    const int tok = idx / 96, c0 = (idx % 96) * 8;
    tokv[u] = tok; c0v[u] = c0;
    int pos, L;
    if (tok < TP) { pos = tok & 255; L = 256; } else { pos = (tok - TP) & 2047; L = 2048; }
    const bf16_t* src = (const bf16_t*)(p.ws + OFF_PROJ) + (size_t)tok * NPROJP + C_XBC + c0;
#pragma unroll
    for (int k = 0; k < 5; ++k) {
      const int pp = pos + k - 2;
      v[u][k] = (u32x4){0u, 0u, 0u, 0u};
      if (pp >= 0 && pp < L) v[u][k] = *(const u32x4*)(src + (ptrdiff_t)(k - 2) * NPROJP);
    }
    const float* cb = p.in[29] + (size_t)l * 768 + c0;
    bia[u][0] = *(const f32x4*)cb; bia[u][1] = *(const f32x4*)(cb + 4);
  }
#pragma unroll
  for (int u = 0; u < CU; ++u) {
    const float* cw = p.in[28] + (size_t)l * 5 * 768 + c0v[u];
    float acc[8] = {bia[u][0][0], bia[u][0][1], bia[u][0][2], bia[u][0][3], bia[u][1][0], bia[u][1][1], bia[u][1][2], bia[u][1][3]};
#pragma unroll
    for (int k = 0; k < 5; ++k) {
      const f32x4 w0 = *(const f32x4*)(cw + k * 768), w1 = *(const f32x4*)(cw + k * 768 + 4);
      const u32x4 x = v[u][k];
      acc[0] += w0[0] * bflo(x[0]); acc[1] += w0[1] * bfhi(x[0]); acc[2] += w0[2] * bflo(x[1]); acc[3] += w0[3] * bfhi(x[1]);
      acc[4] += w1[0] * bflo(x[2]); acc[5] += w1[1] * bfhi(x[2]); acc[6] += w1[2] * bflo(x[3]); acc[7] += w1[3] * bfhi(x[3]);
    }
#pragma unroll
    for (int e = 0; e < 8; ++e) acc[e] = acc[e] / (1.f + __expf(-acc[e]));
    u32x4 o; o[0] = pk2(acc[0], acc[1]); o[1] = pk2(acc[2], acc[3]); o[2] = pk2(acc[4], acc[5]); o[3] = pk2(acc[6], acc[7]);
    *(u32x4*)((bf16_t*)(p.ws + OFF_XBC) + (size_t)tokv[u] * 768 + c0v[u]) = o;
  }
}
DI void dt_thread(const Params& p, int l, int idx) {
  float* dt = (float*)(p.ws + OFF_DT);
  const float v = dt[idx] + p.in[31][(size_t)l * 16 + (idx & 15)];
  dt[idx] = fmaxf(v, 0.f) + log1pf(__expf(-fabsf(v)));
}

DI void prep_phase(const Params& p, int l, char* lds) {
  constexpr int N_Q = 48 * 4, N_KV = 52 * 4, N_DQ = T * 8 / 512, N_DKK = NKEY * 8 / 512, N_DV = NKEY * 4 / 512, N_CONV = T * 96 / 512 / 3, N_DTT = T * 16 / 512;
  constexpr int TOT = N_Q + N_KV + N_DQ + N_DKK + N_DV + N_CONV + N_DTT;
  for (int item = blockIdx.x; item < TOT; item += gridDim.x) {
    int it = item;
    if (it < N_Q) { mla_q_item(p, l, it, lds); continue; }
    it -= N_Q;
    if (it < N_KV) { mla_kv_item(p, l, it, lds); continue; }
    it -= N_KV;
    if (it < N_DQ) { diff_qk_thread(p, l, it * 512 + get_tid(), false); continue; }
    it -= N_DQ;
    if (it < N_DKK) { diff_qk_thread(p, l, it * 512 + get_tid(), true); continue; }
    it -= N_DKK;
    if (it < N_DV) { diff_v_thread(p, l, it * 512 + get_tid()); continue; }
    it -= N_DV;
    if (it < N_CONV) { conv_threads<3>(p, l, it * 512 + get_tid(), N_CONV * 512); continue; }
    it -= N_CONV;
    dt_thread(p, l, it * 512 + get_tid());
  }
}

DI void wave_scan2(float e0, float e1, float& o0, float& o1) {
  const int lane = get_tid() & 63;
  const float s = e0 + e1;
  float inc = s;
#pragma unroll
  for (int o = 1; o < 64; o <<= 1) { const float t = __shfl_up(inc, o); if (lane >= o) inc += t; }
  const float excl = inc - s;
  o0 = excl + e0; o1 = excl + s;
}
DI void ssd_dt_load(const Params& p, int cg_, int h, float& d0, float& d1) {
  const int lane = get_tid() & 63, w = get_tid4() >> 6;
  const float* dt = (const float*)(p.ws + OFF_DT) + (size_t)cg_ * 128 * 16;
  d0 = 0.f; d1 = 0.f;
  if (w == 0) { d0 = dt[(2 * lane) * 16 + h]; d1 = dt[(2 * lane + 1) * 16 + h]; }
  else if (w == 1) { d0 = dt[(127 - 2 * lane) * 16 + 8 + h]; d1 = dt[(126 - 2 * lane) * 16 + 8 + h]; }
}
DI void ssd_scalars_from(const Params& p, int l, int h, float d0, float d1, float* acf, float* sb, float* dtf, float* dtb) {
  const int lane = get_tid() & 63, w = get_tid4() >> 6;
  if (w == 0) {
    const float a = -__expf(p.in[30][(size_t)l * 16 + h]);
    float o0, o1; wave_scan2(d0 * a, d1 * a, o0, o1);
    acf[2 * lane] = o0; acf[2 * lane + 1] = o1; dtf[2 * lane] = d0; dtf[2 * lane + 1] = d1;
  } else if (w == 1) {
    const float a = -__expf(p.in[30][(size_t)l * 16 + 8 + h]);
    const int j0 = 127 - 2 * lane, j1 = 126 - 2 * lane;
    float o0, o1; wave_scan2(d0 * a, d1 * a, o0, o1);
    sb[j0] = o0; sb[j1] = o1; dtb[j0] = d0; dtb[j1] = d1;
  }
}
DI void ssd_scalars(const Params& p, int l, int cg_, int h, float* acf, float* sb, float* dtf, float* dtb) {
  const int lane = get_tid() & 63, w = get_tid4() >> 6;
  const float* dt = (const float*)(p.ws + OFF_DT) + (size_t)cg_ * 128 * 16;
  if (w == 0) {
    const float a = -__expf(p.in[30][(size_t)l * 16 + h]);
    const float d0 = dt[(2 * lane) * 16 + h], d1 = dt[(2 * lane + 1) * 16 + h];
    float o0, o1; wave_scan2(d0 * a, d1 * a, o0, o1);
    acf[2 * lane] = o0; acf[2 * lane + 1] = o1; dtf[2 * lane] = d0; dtf[2 * lane + 1] = d1;
  } else if (w == 1) {
    const float a = -__expf(p.in[30][(size_t)l * 16 + 8 + h]);
    const int j0 = 127 - 2 * lane, j1 = 126 - 2 * lane;
    const float d0 = dt[j0 * 16 + 8 + h], d1 = dt[j1 * 16 + 8 + h];
    float o0, o1; wave_scan2(d0 * a, d1 * a, o0, o1);
    sb[j0] = o0; sb[j1] = o1; dtb[j0] = d0; dtb[j1] = d1;
  }
}

DI void ssd_states_item(const Params& p, int l, int item, char* lds) {
  const int tid = get_tid4(), lane = tid & 63, w = tid >> 6, l32 = lane & 31, half = lane >> 5;
  const int cg_ = item >> 3, h = item & 7, g = h >> 2;
  char* XF = lds; char* XB = lds + 64 * PITCH128; char* BT = lds + 2 * 64 * PITCH128;
  float* sc = (float*)(lds + 3 * 64 * PITCH128);
  float* acf = sc, *sb = sc + 128, *dtf = sc + 256, *dtb = sc + 384;
  __syncthreads();
  ssd_scalars(p, l, cg_, h, acf, sb, dtf, dtb);
  __syncthreads();
  const bf16_t* xbc = (const bf16_t*)(p.ws + OFF_XBC) + (size_t)cg_ * 128 * 768;
  const float aL = acf[127], s0 = sb[0];
#pragma unroll
  for (int it = 0; it < 2; ++it) {
    const int t = tid + 256 * it, jp = t & 63, pc = t >> 6, j0 = 2 * jp;
    const u32x4 x0 = *(const u32x4*)(xbc + (size_t)j0 * 768 + h * 64 + pc * 8), x1 = *(const u32x4*)(xbc + (size_t)(j0 + 1) * 768 + h * 64 + pc * 8);
    const u32x4 b0 = *(const u32x4*)(xbc + (size_t)j0 * 768 + 512 + g * 64 + pc * 8), b1 = *(const u32x4*)(xbc + (size_t)(j0 + 1) * 768 + 512 + g * 64 + pc * 8);
    const float wf0 = __expf(aL - acf[j0]) * dtf[j0], wf1 = __expf(aL - acf[j0 + 1]) * dtf[j0 + 1];
    const float wb0 = __expf(s0 - sb[j0]) * dtb[j0], wb1 = __expf(s0 - sb[j0 + 1]) * dtb[j0 + 1];
#pragma unroll
    for (int e = 0; e < 4; ++e) {
      const float a0 = bflo(x0[e]), a1 = bfhi(x0[e]), c0 = bflo(x1[e]), c1 = bfhi(x1[e]);
      const int pr = pc * 8 + 2 * e;
      *(unsigned*)(XF + pr * PITCH128 + j0 * 2) = pk2(a0 * wf0, c0 * wf1);
      *(unsigned*)(XF + (pr + 1) * PITCH128 + j0 * 2) = pk2(a1 * wf0, c1 * wf1);
      *(unsigned*)(XB + pr * PITCH128 + j0 * 2) = pk2(a0 * wb0, c0 * wb1);
      *(unsigned*)(XB + (pr + 1) * PITCH128 + j0 * 2) = pk2(a1 * wb0, c1 * wb1);
      *(unsigned*)(BT + pr * PITCH128 + j0 * 2) = (b0[e] & 0xffffu) | (b1[e] << 16);
      *(unsigned*)(BT + (pr + 1) * PITCH128 + j0 * 2) = (b0[e] >> 16) | (b1[e] & 0xffff0000u);
    }
  }
  __syncthreads();
  const int dir = w >> 1, pb = w & 1;
  const char* Xs = (dir ? XB : XF) + (pb * 32 + l32) * PITCH128 + half * 16;
  const char* Bsrc = BT + l32 * PITCH128 + half * 16;
  f32x16 acc[2] = {zero16(), zero16()};
#pragma unroll
  for (int s = 0; s < 8; ++s) {
    const bf16x8 a = *(const bf16x8*)(Xs + s * 32);
    const bf16x8 b0 = *(const bf16x8*)(Bsrc + s * 32), b1 = *(const bf16x8*)(Bsrc + 32 * PITCH128 + s * 32);
    acc[0] = MFMA32(a, b0, acc[0]); acc[1] = MFMA32(a, b1, acc[1]);
  }
  float* ST = (float*)(p.ws + OFF_ST) + ((size_t)(cg_ * 8 + h) * 2 + dir) * 4096;
#pragma unroll
  for (int nb = 0; nb < 2; ++nb)
#pragma unroll
    for (int r = 0; r < 16; ++r) ST[(pb * 32 + crow(r, half)) * 64 + nb * 32 + l32] = acc[nb][r];
  if (tid == 0) { float* cd = (float*)(p.ws + OFF_CDEC) + (size_t)(cg_ * 8 + h) * 2; cd[0] = __expf(aL); cd[1] = __expf(s0); }
}

template <int NC>
DI void ssd_scan_thread(const Params& p, int l, int seq, int r, int cg0, f32x4 hs) {
  const float* ST = (const float*)(p.ws + OFF_ST);
  bf16_t* HP = (bf16_t*)(p.ws + OFF_HP);
  const float* CD = (const float*)(p.ws + OFF_CDEC);
  const int h = r >> 11, dir = (r >> 10) & 1, pn = r & 1023;
  f32x4 st[NC]; float dec[NC];
#pragma unroll
  for (int c = 0; c < NC; ++c) {
    const int cgi = cg0 + (dir ? NC - 1 - c : c);
    st[c] = *(const f32x4*)(ST + ((size_t)(cgi * 8 + h) * 2 + dir) * 4096 + pn * 4);
    dec[c] = CD[(size_t)(cgi * 8 + h) * 2 + dir];
  }
#pragma unroll
  for (int c = 0; c < NC; ++c) {
    const int cgi = cg0 + (dir ? NC - 1 - c : c);
    u32x2 hv; hv[0] = pk2(hs[0], hs[1]); hv[1] = pk2(hs[2], hs[3]);
    *(u32x2*)(HP + ((size_t)(cgi * 8 + h) * 2 + dir) * 4096 + pn * 4) = hv;
    hs = dec[c] * hs + st[c];
  }
  if (seq < 16) *(f32x4*)(p.out + O_SSM + ((((size_t)seq * DEPTH + l) * 2 + dir) * 8 + h) * 4096 + pn * 4) = hs;
}
DI void ssd_scan_phase(const Params& p, int l) {
  constexpr int PER_SEQ = 8 * 2 * 64 * 16;
  for (int item = blockIdx.x; item < 20 * PER_SEQ / 512; item += gridDim.x) {
    const int idx = item * 512 + get_tid();
    const int sq = idx / PER_SEQ; const int r = idx % PER_SEQ;
    const int seq = (sq < 4) ? 16 + sq : sq - 4;
    if (seq < 16) ssd_scan_thread<2>(p, l, seq, r, 2 * seq, (f32x4){0.f, 0.f, 0.f, 0.f});
    else {
      const int dir = (r >> 10) & 1, h = r >> 11, pn = r & 1023;
      const f32x4 h0 = *(const f32x4*)(p.in[6] + ((((size_t)(seq - 16) * DEPTH + l) * 2 + dir) * 8 + h) * 4096 + pn * 4);
      ssd_scan_thread<16>(p, l, seq, r, 32 + 16 * (seq - 16), h0);
    }
  }
}

DI void ssd_y_item(const Params& p, int l, int cg_, char* lds_blk) {
  const int tid = get_tid4(), lane = tid & 63, w = tid >> 6, l32 = lane & 31, half = lane >> 5;
  const int g = get_hb();
  char* lds = lds_blk + g * HALF_LDS;
  char* Bs = lds; char* Cs = lds + 128 * PITCH64; char* XT = lds + 2 * 128 * PITCH64;
  char* Hf = XT + 64 * PITCH128; char* Hb = Hf + 64 * PITCH64;
  float* sc = (float*)(Hb + 64 * PITCH64);
  float* acf = sc, *sb = sc + 128, *dtf = sc + 256, *dtb = sc + 384;
  const int tok0 = cg_ * 128;
  const int i = w * 32 + l32, tok = tok0 + i;
  const bf16_t* xbc = (const bf16_t*)(p.ws + OFF_XBC) + (size_t)tok0 * 768;
  const bf16_t* proj = (const bf16_t*)(p.ws + OFF_PROJ);
  bf16_t* mix = (bf16_t*)(p.ws + OFF_MIX);
  float ssq = 0.f;
  {
    __syncthreads();
#pragma unroll
    for (int it = 0; it < 4; ++it) {
      const int t = tid + 256 * it, r = t >> 3, c = (t & 7) * 8;
      *(u32x4*)(Bs + r * PITCH64 + c * 2) = *(const u32x4*)(xbc + (size_t)r * 768 + 512 + g * 64 + c);
      *(u32x4*)(Cs + r * PITCH64 + c * 2) = *(const u32x4*)(xbc + (size_t)r * 768 + 640 + g * 64 + c);
    }
    __syncthreads();
    u32x4 xr[2][2]; float dpre0, dpre1;
    auto head_loads = [&](int h) {
#pragma unroll
      for (int it = 0; it < 2; ++it) {
        const int t = tid + 256 * it, jp = t & 63, pc = t >> 6, j0 = 2 * jp;
        xr[it][0] = *(const u32x4*)(xbc + (size_t)j0 * 768 + h * 64 + pc * 8);
        xr[it][1] = *(const u32x4*)(xbc + (size_t)(j0 + 1) * 768 + h * 64 + pc * 8);
      }
      ssd_dt_load(p, cg_, h, dpre0, dpre1);
    };
    head_loads(g * 4);
#pragma unroll 1
    for (int hh = 0; hh < 4; ++hh) {
      const int h = g * 4 + hh;
      u32x4 hr[2][2];
      {
        const bf16_t* hp = (const bf16_t*)(p.ws + OFF_HP) + (size_t)(cg_ * 8 + h) * 2 * 4096;
#pragma unroll
        for (int it = 0; it < 2; ++it) { const int t = tid + 256 * it, r = t >> 3, c = (t & 7) * 8; hr[it][0] = *(const u32x4*)(hp + r * 64 + c); hr[it][1] = *(const u32x4*)(hp + 4096 + r * 64 + c); }
      }
      __syncthreads();
#pragma unroll
      for (int it = 0; it < 2; ++it) {
        const int t = tid + 256 * it, jp = t & 63, pc = t >> 6, j0 = 2 * jp;
        const u32x4 x0 = xr[it][0], x1 = xr[it][1];
#pragma unroll
        for (int e = 0; e < 4; ++e) {
          const int pr = pc * 8 + 2 * e;
          *(unsigned*)(XT + pr * PITCH128 + j0 * 2) = (x0[e] & 0xffffu) | (x1[e] << 16);
          *(unsigned*)(XT + (pr + 1) * PITCH128 + j0 * 2) = (x0[e] >> 16) | (x1[e] & 0xffff0000u);
        }
        const int r = t >> 3, c = (t & 7) * 8;
        *(u32x4*)(Hf + r * PITCH64 + c * 2) = hr[it][0];
        *(u32x4*)(Hb + r * PITCH64 + c * 2) = hr[it][1];
      }
      ssd_scalars_from(p, l, h, dpre0, dpre1, acf, sb, dtf, dtb);
      __syncthreads();
      if (hh < 3) head_loads(h + 1);
      const float aif = acf[i], aib = sb[i];
      f32x16 Y[2] = {zero16(), zero16()};
      int iv = i, hv = half;
      asm volatile("" : "+v"(iv), "+v"(hv));
      bf16x8 cfr[4];
#pragma unroll
      for (int s = 0; s < 4; ++s) cfr[s] = *(const bf16x8*)(Cs + i * PITCH64 + s * 32 + hv * 16);
      u32x2 xpre[8], zpre[8];
#pragma unroll
      for (int q8 = 0; q8 < 8; ++q8) {
        const int pc = (q8 >> 2) * 32 + 8 * (q8 & 3) + 4 * hv;
        xpre[q8] = *(const u32x2*)(xbc + (size_t)i * 768 + h * 64 + pc);
        zpre[q8] = *(const u32x2*)(proj + (size_t)tok * NPROJP + C_Z + h * 64 + pc);
      }
#pragma unroll 1
      for (int jb = 0; jb < 4; ++jb) {
        f32x16 G = zero16();
#pragma unroll
        for (int s = 0; s < 4; ++s) {
          const bf16x8 a = *(const bf16x8*)(Bs + (jb * 32 + l32) * PITCH64 + s * 32 + hv * 16);
          G = MFMA32(a, cfr[s], G);
        }
        f32x16 m;
#pragma unroll
        for (int q = 0; q < 4; ++q) {
          const int jq = jb * 32 + 8 * q + 4 * hv;
          const f32x4 af4 = *(const f32x4*)(acf + jq), sb4 = *(const f32x4*)(sb + jq), df4 = *(const f32x4*)(dtf + jq), db4 = *(const f32x4*)(dtb + jq);
#pragma unroll
          for (int e = 0; e < 4; ++e) {
            const int j = jq + e;
            const bool lo_ = j < iv;
            const float arg = lo_ ? (aif - af4[e]) : (aib - sb4[e]);
            const float dsel = lo_ ? df4[e] : db4[e];
            float wgt = __expf(arg) * dsel;
            wgt = (j == iv) ? (df4[e] + db4[e]) : wgt;
            m[4 * q + e] = G[4 * q + e] * wgt;
          }
        }
#pragma unroll
        for (int s = 0; s < 2; ++s) {
          u32x4 mf; mf[0] = pk2(m[8 * s], m[8 * s + 1]); mf[1] = pk2(m[8 * s + 2], m[8 * s + 3]); mf[2] = pk2(m[8 * s + 4], m[8 * s + 5]); mf[3] = pk2(m[8 * s + 6], m[8 * s + 7]);
          const bf16x8 mfr = __builtin_bit_cast(bf16x8, mf);
#pragma unroll
          for (int pb = 0; pb < 2; ++pb) {
            const char* xa = XT + (pb * 32 + l32) * PITCH128 + (jb * 32 + 16 * s + 4 * hv) * 2;
            u32x4 av; const u32x2 lo = *(const u32x2*)xa, hi = *(const u32x2*)(xa + 16);
            av[0] = lo[0]; av[1] = lo[1]; av[2] = hi[0]; av[3] = hi[1];
            Y[pb] = MFMA32(__builtin_bit_cast(bf16x8, av), mfr, Y[pb]);
          }
        }
      }
      {
        const float ef = __expf(aif), eb = __expf(aib);
#pragma unroll
        for (int pb = 0; pb < 2; ++pb) {
#pragma unroll
          for (int d = 0; d < 2; ++d) {
            f32x16 tf = zero16();
            const char* Hs = d ? Hb : Hf;
#pragma unroll
            for (int s = 0; s < 4; ++s) {
              const bf16x8 a = *(const bf16x8*)(Hs + (pb * 32 + l32) * PITCH64 + s * 32 + hv * 16);
              tf = MFMA32(a, cfr[s], tf);
            }
            const float ee = d ? eb : ef;
#pragma unroll
            for (int r = 0; r < 16; ++r) Y[pb][r] += ee * tf[r];
          }
        }
      }
      const float Dh = p.in[32][(size_t)l * 8 + h];
#pragma unroll
      for (int pb = 0; pb < 2; ++pb)
#pragma unroll
        for (int q = 0; q < 4; ++q) {
          const int pc = pb * 32 + 8 * q + 4 * half;
          const u32x2 xv = xpre[pb * 4 + q];
          const u32x2 zv = zpre[pb * 4 + q];
          float y[4] = {Y[pb][4 * q] + Dh * bflo(xv[0]), Y[pb][4 * q + 1] + Dh * bfhi(xv[0]), Y[pb][4 * q + 2] + Dh * bflo(xv[1]), Y[pb][4 * q + 3] + Dh * bfhi(xv[1])};
          const float z[4] = {bflo(zv[0]), bfhi(zv[0]), bflo(zv[1]), bfhi(zv[1])};
#pragma unroll
          for (int e = 0; e < 4; ++e) { y[e] *= z[e] / (1.f + __expf(-z[e])); ssq += y[e] * y[e]; }
          u32x2 o; o[0] = pk2(y[0], y[1]); o[1] = pk2(y[2], y[3]);
          *(u32x2*)(mix + (size_t)tok * 1024 + 512 + h * 64 + pc) = o;
        }
    }
  }
  ssq += xor32(ssq);
  sc[512 + i] = ssq;
  __syncthreads();
  ssq += ((const float*)(lds_blk + (1 - g) * HALF_LDS + (2 * 128 * PITCH64 + 64 * PITCH128 + 2 * 64 * PITCH64)))[512 + i];
  const float rstd = rsqrtf(ssq * (1.f / 512.f) + EPS);
  const float* gn = p.in[33] + (size_t)l * 512;
  u32x2 vv[32];
#pragma unroll
  for (int e = 0; e < 32; ++e) {
    const int ch = (g * 4 + (e >> 3)) * 64 + ((e >> 2) & 1) * 32 + 8 * (e & 3) + 4 * half;
    vv[e] = *(const u32x2*)(mix + (size_t)tok * 1024 + 512 + ch);
  }
#pragma unroll
  for (int hq = 0; hq < 4; ++hq) {
    f32x4 gg[8];
#pragma unroll
    for (int e = 0; e < 8; ++e) gg[e] = *(const f32x4*)(gn + (g * 4 + hq) * 64 + (e >> 2) * 32 + 8 * (e & 3) + 4 * half);
#pragma unroll
    for (int e = 0; e < 8; ++e) {
      const int ch = (g * 4 + hq) * 64 + (e >> 2) * 32 + 8 * (e & 3) + 4 * half;
      const u32x2 v = vv[hq * 8 + e];
      u32x2 o; o[0] = pk2(bflo(v[0]) * rstd * gg[e][0], bfhi(v[0]) * rstd * gg[e][1]); o[1] = pk2(bflo(v[1]) * rstd * gg[e][2], bfhi(v[1]) * rstd * gg[e][3]);
      *(u32x2*)(mix + (size_t)tok * 1024 + 512 + ch) = o;
    }
  }
}

struct SeqInfo { int tok0, L, kbase, nk; };
DI SeqInfo seq_info(int s) { SeqInfo r; if (s < 16) { r.tok0 = s * 256; r.L = 256; r.kbase = s * 256; r.nk = 256; } else { r.tok0 = TP + (s - 16) * 2048; r.L = 2048; r.kbase = TP + (s - 16) * 2304; r.nk = 2304; } return r; }

DI void attn_mla_item(const Params& p, int item, char* lds) {
  const int tid = get_tid4(), lane = tid & 63, w = tid >> 6, l32 = lane & 31, half = lane >> 5;
  int seq, head, qb;
  if (item < 256) { seq = 16 + (item >> 6); head = (item >> 4) & 3; qb = item & 15; }
  else { const int it = item - 256; seq = it >> 3; head = (it >> 1) & 3; qb = it & 1; }
  const SeqInfo si = seq_info(seq);
  const int tok = si.tok0 + qb * 128 + w * 32 + l32;
  const bf16_t* qa = (const bf16_t*)(p.ws + OFF_QA) + (size_t)tok * 384 + head * 96;
  bf16x8 qf[6];
#pragma unroll
  for (int s = 0; s < 6; ++s) qf[s] = *(const bf16x8*)(qa + 16 * s + 8 * half);
  constexpr int KT = 64 * PITCH96, VT = 64 * PITCH64;
  char* Ks = lds; char* Vs = lds + 2 * KT;
  const bf16_t* kg = (const bf16_t*)(p.ws + OFF_KA) + (size_t)si.kbase * 384 + head * 96;
  const bf16_t* vg = (const bf16_t*)(p.ws + OFF_VAT) + (size_t)head * 64 * NKEY + si.kbase;
  u32x4 rk[3], rv[2];
  auto gload = [&](int t0) {
#pragma unroll
    for (int i = 0; i < 3; ++i) { const int c = tid + 256 * i, r = c / 12, cc = c % 12; rk[i] = *(const u32x4*)(kg + (size_t)(t0 + r) * 384 + cc * 8); }
#pragma unroll
    for (int i = 0; i < 2; ++i) { const int c = tid + 256 * i, r = c >> 3, cc = c & 7; rv[i] = *(const u32x4*)(vg + (size_t)r * NKEY + t0 + cc * 8); }
  };
  auto lstore = [&](int buf) {
#pragma unroll
    for (int i = 0; i < 3; ++i) { const int c = tid + 256 * i, r = c / 12, cc = c % 12; *(u32x4*)(Ks + buf * KT + r * PITCH96 + cc * 16) = rk[i]; }
#pragma unroll
    for (int i = 0; i < 2; ++i) { const int c = tid + 256 * i, r = c >> 3, cc = c & 7; *(u32x4*)(Vs + buf * VT + r * PITCH64 + cc * 16) = rv[i]; }
  };
  f32x16 O[2] = {zero16(), zero16()};
  float mrun = -1e30f, lsum = 0.f;
  const int nt = si.nk / 64;
  __syncthreads();
  gload(0); lstore(0);
  __syncthreads();
#pragma unroll 1
  for (int t = 0; t < nt; ++t) {
    const int cur = t & 1;
    if (t + 1 < nt) gload((t + 1) * 64);
    f32x16 S[2];
#pragma unroll
    for (int kb = 0; kb < 2; ++kb) {
      S[kb] = zero16();
#pragma unroll
      for (int s = 0; s < 6; ++s) {
        const bf16x8 a = *(const bf16x8*)(Ks + cur * KT + (kb * 32 + l32) * PITCH96 + s * 32 + half * 16);
        S[kb] = MFMA32(a, qf[s], S[kb]);
      }
    }
    float mx = S[0][0];
#pragma unroll
    for (int r = 0; r < 16; ++r) { mx = fmaxf(mx, S[0][r]); mx = fmaxf(mx, S[1][r]); }
    mx = fmaxf(mx, xor32(mx));
    if (__any(mx > mrun + 8.f)) {
      const float mnew = fmaxf(mrun, mx);
      const float alpha = __builtin_amdgcn_exp2f(mrun - mnew);
      mrun = mnew;
      lsum *= alpha;
#pragma unroll
      for (int r = 0; r < 16; ++r) { O[0][r] *= alpha; O[1][r] *= alpha; }
    }
    float ps = 0.f;
#pragma unroll
    for (int kb = 0; kb < 2; ++kb)
#pragma unroll
      for (int r = 0; r < 16; ++r) { const float e = __builtin_amdgcn_exp2f(S[kb][r] - mrun); S[kb][r] = e; ps += e; }
    lsum += ps;
#pragma unroll
    for (int kb = 0; kb < 2; ++kb)
#pragma unroll
      for (int s = 0; s < 2; ++s) {
        u32x4 pf; pf[0] = pk2(S[kb][8 * s], S[kb][8 * s + 1]); pf[1] = pk2(S[kb][8 * s + 2], S[kb][8 * s + 3]); pf[2] = pk2(S[kb][8 * s + 4], S[kb][8 * s + 5]); pf[3] = pk2(S[kb][8 * s + 6], S[kb][8 * s + 7]);
        const bf16x8 pfr = __builtin_bit_cast(bf16x8, pf);
#pragma unroll
        for (int dvb = 0; dvb < 2; ++dvb) {
          const char* va = Vs + cur * VT + (dvb * 32 + l32) * PITCH64 + (kb * 32 + 16 * s + 4 * half) * 2;
          u32x4 av; const u32x2 lo = *(const u32x2*)va, hi = *(const u32x2*)(va + 16);
          av[0] = lo[0]; av[1] = lo[1]; av[2] = hi[0]; av[3] = hi[1];
          O[dvb] = MFMA32(__builtin_bit_cast(bf16x8, av), pfr, O[dvb]);
        }
      }
    if (t + 1 < nt) lstore(cur ^ 1);
    __syncthreads();
  }
  lsum += xor32(lsum);
  const float inv = 1.f / lsum;
  bf16_t* mix = (bf16_t*)(p.ws + OFF_MIX) + (size_t)tok * 1024 + head * 64;
#pragma unroll
  for (int dvb = 0; dvb < 2; ++dvb) {
#pragma unroll
    for (int r = 0; r < 16; ++r) O[dvb][r] *= inv;
    store_block_bf16(mix + dvb * 32, O[dvb], half);
  }
}

constexpr int PITCH32 = 80;
DI void attn_diff_item(const Params& p, int l, int item, char* lds_blk) {
  const int tid = get_tid4(), lane = tid & 63, w = tid >> 6, l32 = lane & 31, half = lane >> 5;
  const int hbk = get_hb();
  char* lds = lds_blk + hbk * HALF_LDS;
  int seq, head, qb;
  if (item < 256) { seq = 16 + (item >> 6); head = (item >> 4) & 3; qb = item & 15; }
  else { const int it = item - 256; seq = it >> 3; head = (it >> 1) & 3; qb = it & 1; }
  const SeqInfo si = seq_info(seq);
  const int tok = si.tok0 + qb * 128 + w * 32 + l32;
  constexpr int KT = 64 * PITCH32, VT = 64 * PITCH64;
  char* Ks = lds; char* Vs = lds + 2 * KT;
  const bf16_t* vg = (const bf16_t*)(p.ws + OFF_VDT) + (size_t)head * 64 * NKEY + si.kbase;
  const int nt = si.nk / 64;
  const float lam_init = ((const float*)(p.ws + OFF_LAM))[l * 2 + 1];
  const float lam = ((const float*)(p.ws + OFF_LAM))[l * 2];
  f32x16 R[2] = {zero16(), zero16()};
#pragma unroll 1
  for (int mp = hbk; mp < hbk + 1; ++mp) {
    const bf16_t* qd = (const bf16_t*)(p.ws + OFF_QD) + (size_t)tok * 256 + head * 64 + mp * 32;
    bf16x8 qf[2];
#pragma unroll
    for (int s = 0; s < 2; ++s) qf[s] = *(const bf16x8*)(qd + 16 * s + 8 * half);
    const bf16_t* kg = (const bf16_t*)(p.ws + OFF_KD) + (size_t)si.kbase * 256 + head * 64 + mp * 32;
    u32x4 rk, rv[2];
    auto gload = [&](int t0) {
      rk = *(const u32x4*)(kg + (size_t)(t0 + (tid >> 2)) * 256 + (tid & 3) * 8);
#pragma unroll
      for (int i = 0; i < 2; ++i) { const int c = tid + 256 * i, r = c >> 3, cc = c & 7; rv[i] = *(const u32x4*)(vg + (size_t)r * NKEY + t0 + cc * 8); }
    };
    auto lstore = [&](int buf) {
      *(u32x4*)(Ks + buf * KT + (tid >> 2) * PITCH32 + (tid & 3) * 16) = rk;
#pragma unroll
      for (int i = 0; i < 2; ++i) { const int c = tid + 256 * i, r = c >> 3, cc = c & 7; *(u32x4*)(Vs + buf * VT + r * PITCH64 + cc * 16) = rv[i]; }
    };
    f32x16 O[2] = {zero16(), zero16()};
    float mrun = -1e30f, lsum = 0.f;
    __syncthreads();
    gload(0); lstore(0);
    __syncthreads();
#pragma unroll 1
    for (int t = 0; t < nt; ++t) {
      const int cur = t & 1;
      if (t + 1 < nt) gload((t + 1) * 64);
      f32x16 S[2];
#pragma unroll
      for (int kb = 0; kb < 2; ++kb) {
        S[kb] = zero16();
#pragma unroll
        for (int s = 0; s < 2; ++s) {
          const bf16x8 a = *(const bf16x8*)(Ks + cur * KT + (kb * 32 + l32) * PITCH32 + s * 32 + half * 16);
          S[kb] = MFMA32(a, qf[s], S[kb]);
        }
      }
      float mx = S[0][0];
#pragma unroll
      for (int r = 0; r < 16; ++r) { mx = fmaxf(mx, S[0][r]); mx = fmaxf(mx, S[1][r]); }
      mx = fmaxf(mx, xor32(mx));
      if (__any(mx > mrun + 8.f)) {
        const float mnew = fmaxf(mrun, mx);
        const float alpha = __builtin_amdgcn_exp2f(mrun - mnew);
        mrun = mnew;
        lsum *= alpha;
#pragma unroll
        for (int r = 0; r < 16; ++r) { O[0][r] *= alpha; O[1][r] *= alpha; }
      }
      float ps = 0.f;
#pragma unroll
      for (int kb = 0; kb < 2; ++kb)
#pragma unroll
        for (int r = 0; r < 16; ++r) { const float e = __builtin_amdgcn_exp2f(S[kb][r] - mrun); S[kb][r] = e; ps += e; }
      lsum += ps;
#pragma unroll
      for (int kb = 0; kb < 2; ++kb)
#pragma unroll
        for (int s = 0; s < 2; ++s) {
          u32x4 pf; pf[0] = pk2(S[kb][8 * s], S[kb][8 * s + 1]); pf[1] = pk2(S[kb][8 * s + 2], S[kb][8 * s + 3]); pf[2] = pk2(S[kb][8 * s + 4], S[kb][8 * s + 5]); pf[3] = pk2(S[kb][8 * s + 6], S[kb][8 * s + 7]);
          const bf16x8 pfr = __builtin_bit_cast(bf16x8, pf);
#pragma unroll
          for (int dvb = 0; dvb < 2; ++dvb) {
            const char* va = Vs + cur * VT + (dvb * 32 + l32) * PITCH64 + (kb * 32 + 16 * s + 4 * half) * 2;
            u32x4 av; const u32x2 lo = *(const u32x2*)va, hi = *(const u32x2*)(va + 16);
            av[0] = lo[0]; av[1] = lo[1]; av[2] = hi[0]; av[3] = hi[1];
            O[dvb] = MFMA32(__builtin_bit_cast(bf16x8, av), pfr, O[dvb]);
          }
        }
      if (t + 1 < nt) lstore(cur ^ 1);
      __syncthreads();
    }
    lsum += xor32(lsum);
    const float coef = (mp == 0) ? 1.f / lsum : -lam / lsum;
#pragma unroll
    for (int dvb = 0; dvb < 2; ++dvb)
#pragma unroll
      for (int r = 0; r < 16; ++r) R[dvb][r] += O[dvb][r] * coef;
  }
  {
    constexpr int XO = 32768;
    float* xo = (float*)(lds + XO);
    if (hbk == 1) {
#pragma unroll
      for (int dvb = 0; dvb < 2; ++dvb)
#pragma unroll
        for (int r = 0; r < 16; ++r) xo[((w * 2 + dvb) * 16 + r) * 64 + lane] = R[dvb][r];
    }
    __syncthreads();
    if (hbk == 1) return;
    const float* xi = (const float*)(lds_blk + HALF_LDS + XO);
#pragma unroll
    for (int dvb = 0; dvb < 2; ++dvb)
#pragma unroll
      for (int r = 0; r < 16; ++r) R[dvb][r] += xi[((w * 2 + dvb) * 16 + r) * 64 + lane];
  }
  float ss = sumsq16(R[0]) + sumsq16(R[1]);
  ss += xor32(ss);
  const float rstd = rsqrtf(ss * (1.f / 64.f) + EPS) * (1.f - lam_init);
  const float* gs = p.in[27] + (size_t)l * 64;
  bf16_t* mix = (bf16_t*)(p.ws + OFF_MIX) + (size_t)tok * 1024 + 256 + head * 64;
#pragma unroll
  for (int dvb = 0; dvb < 2; ++dvb) {
    { const f32x16 gb = gain_block(gs + dvb * 32, half);
#pragma unroll
      for (int r = 0; r < 16; ++r) R[dvb][r] *= rstd * gb[r]; }
    store_block_bf16(mix + dvb * 32, R[dvb], half);
  }
}

DI void run_phase(const Params& p, int ph, char* lds, int* s_item, int vb) {
#ifdef ONLY_SUB
  const int l = (ph - 1) / 10, sub = ONLY_SUB;
  if (ONLY_SUB == 10) { setup_phase(p, lds); return; }
#else
  if (ph == 0) { setup_phase(p, lds); return; }
  const int l = (ph - 1) / 10, sub = (ph - 1) % 10;
#endif
  const float* modl = (const float*)(p.ws + OFF_MOD) + (size_t)l * 5 * 6144;
  switch (sub) {
    case 0: norm_phase(p, l, 0); break;
    case 1: {
      EpiInProj epi{(bf16_t*)(p.ws + OFF_PROJ), (float*)(p.ws + OFF_DT)};
      const bf16_t* A = (const bf16_t*)(p.ws + OFF_HBUF);
      const bf16_t* Bt = (const bf16_t*)(p.ws + OFF_WIN) + (size_t)l * NPROJP * 1024;
      gemm_phase<256>(A, 1024, Bt, 1024, 1024, 48, 10, lds, vb, epi);
    } break;
    case 2: prep_phase(p, l, lds); break;
    case 3: {
      const int hb = get_hb();
      for (int pair = blockIdx.x; pair < NCHUNK * 4; pair += gridDim.x) ssd_states_item(p, l, pair * 2 + hb, lds + hb * HALF_LDS);
    } break;
    case 4: ssd_scan_phase(p, l); break;
    case 5: {
      unsigned* ctr = (unsigned*)(p.ws + OFF_CTR) + l;
      const int hb = get_hb();
      for (;;) {
        __syncthreads();
        if (threadIdx.x == 0) *s_item = (int)atomicAdd(ctr, 1u);
        __syncthreads();
        const int it = *s_item;
        if (it >= 672) break;
        if (it < 96) ssd_y_item(p, l, it, lds);
        else if (it < 224) attn_mla_item(p, (it - 96) * 2 + hb, lds + hb * HALF_LDS);
        else if (it < 480) attn_diff_item(p, l, it - 224, lds);
        else if (it < 544) attn_mla_item(p, 256 + (it - 480) * 2 + hb, lds + hb * HALF_LDS);
        else attn_diff_item(p, l, 256 + (it - 544), lds);
      }
    } break;
    case 6: {
      EpiResid epi{l == 0 ? p.in[0] : nullptr, l == 0 ? p.in[1] : nullptr, (bf16_t*)(p.ws + OFF_XB), nullptr, modl + 2048};
      const bf16_t* A = (const bf16_t*)(p.ws + OFF_MIX);
      const bf16_t* Bt = (const bf16_t*)(p.ws + OFF_WOUT) + (size_t)l * 1024 * 1024;
      gemm_phase<192>(A, 1024, Bt, 1024, 1024, 64, 4, lds, vb, epi);
    } break;
    case 7: norm_phase(p, l, 1); break;
    case 8: {
      EpiFF1 epi{(bf16_t*)(p.ws + OFF_UBUF)};
      const bf16_t* A = (const bf16_t*)(p.ws + OFF_HBUF);
      const bf16_t* Bt = (const bf16_t*)(p.ws + OFF_WFF1) + (size_t)l * 4096 * 1024;
      gemm_phase<256>(A, 1024, Bt, 1024, 1024, 48, 16, lds, vb, epi);
    } break;
    case 9: {
      EpiResid epi{nullptr, nullptr, (bf16_t*)(p.ws + OFF_XB), l == DEPTH - 1 ? p.out : nullptr, modl + 5120};
      const bf16_t* A = (const bf16_t*)(p.ws + OFF_UBUF);
      const bf16_t* Bt = (const bf16_t*)(p.ws + OFF_WFF2) + (size_t)l * 1024 * 4096;
      gemm_phase<192>(A, 4096, Bt, 4096, 4096, 64, 4, lds, vb, epi);
    } break;
  }
}

constexpr int N_PHASES = 1 + 10 * DEPTH;

__global__ void __launch_bounds__(512, 2) fwd_megakernel(Params p) {
  __shared__ __attribute__((aligned(1024))) char lds[LDS_BYTES + 64];
  uint4& xb_words = *(uint4*)(lds + LDS_BYTES);
  int* s_item = (int*)(lds + LDS_BYTES + 16);
  if (p.ph_end - p.ph_begin == 1) { run_phase(p, p.ph_begin, lds, s_item, blockIdx.x); return; }
  if (p.ph_begin < 0) { cg::this_grid().sync(); return; }
  if (threadIdx.x == 0) xb_words = make_uint4(0u, 0u, 0u, 0u);
  __syncthreads();
  XcdBarrier b = xcd_barrier_post((unsigned*)(p.ws + OFF_BAR), (volatile LAS unsigned*)&xb_words);
  unsigned* xrank = (unsigned*)(p.ws + OFF_XRANK);
  if (threadIdx.x == 0) s_item[1] = (int)atomicAdd(&xrank[b.x], 1u);
  int vb = blockIdx.x;
  for (int ph = p.ph_begin; ph < p.ph_end; ++ph) {
    run_phase(p, ph, lds, s_item, vb);
    if (ph + 1 < p.ph_end) xcd_barrier(b);
    if (ph == p.ph_begin) {
      bool ok = (gridDim.x % 8) == 0;
      for (int j = 0; j < 16; ++j) { const unsigned c = xb_ld(&xrank[j]); ok = ok && (j < 8 ? c == gridDim.x / 8 : c == 0u); }
      vb = ok ? s_item[1] * 8 + (int)b.x : (int)blockIdx.x;
    }
  }
}

extern "C" void kernel_launch(void* const* d_in, const int* in_sizes, int n_in, void* d_out, int out_size, void* d_ws, size_t ws_size, hipStream_t stream) {
  static int grid_blocks = 0;
  if (!grid_blocks) {
    int dev = 0, cus = 0, per_cu = 0;
    (void)hipGetDevice(&dev);
    (void)hipDeviceGetAttribute(&cus, hipDeviceAttributeMultiprocessorCount, dev);
    (void)hipOccupancyMaxActiveBlocksPerMultiprocessor(&per_cu, fwd_megakernel, 512, 0);
    if (per_cu > 1) per_cu = 1;
    if (per_cu < 1) per_cu = 1;
    grid_blocks = cus * per_cu;
  }
  Params p{};
  for (int i = 0; i < 36; ++i) p.in[i] = (const float*)d_in[i];
  p.out = (float*)d_out;
  p.ws = (char*)d_ws;
  (void)hipMemsetAsync(d_ws, 0, 16384, stream);
#if MULTI_LAUNCH
  for (int ph = 0; ph < N_PHASES; ++ph) {
    p.ph_begin = ph; p.ph_end = ph + 1;
    hipLaunchKernelGGL(fwd_megakernel, dim3(grid_blocks), dim3(512), 0, stream, p);
  }
#else
  p.ph_begin = 0; p.ph_end = N_PHASES;
  void* args[] = {&p};
  hipError_t e = hipLaunchCooperativeKernel((void*)fwd_megakernel, dim3(grid_blocks), dim3(512), args, 0, stream);
  if (e != hipSuccess) fprintf(stderr, "cooperative launch failed: %s (grid %d)\n", hipGetErrorString(e), grid_blocks);
#endif
}
```

```cpp
#include <hip/hip_runtime.h>
#include <hip/hip_cooperative_groups.h>
#include <stdint.h>
#include <stdio.h>
namespace cg = cooperative_groups;

#ifndef MULTI_LAUNCH
#define MULTI_LAUNCH 0
#endif

#define DI __device__ __forceinline__
#define LAS __attribute__((address_space(3)))
typedef unsigned short bf16_t;
typedef short bf16x8 __attribute__((ext_vector_type(8)));
typedef short s16x4 __attribute__((ext_vector_type(4)));
typedef float f32x16 __attribute__((ext_vector_type(16)));
typedef float f32x4 __attribute__((ext_vector_type(4)));
typedef unsigned u32x4 __attribute__((ext_vector_type(4)));
typedef unsigned u32x2 __attribute__((ext_vector_type(2)));
#define MFMA32(a, b, c) __builtin_amdgcn_mfma_f32_32x32x16_bf16((a), (b), (c), 0, 0, 0)

constexpr int D = 1024, TP = 4096, TS = 8192, T = 12288, DEPTH = 4, PAST = 256;
constexpr int NPROJ = 2480, NPROJP = 2560, DFF = 4096;
constexpr int NKEY = 4096 + 4 * 2304;
constexpr int C_CQ = 0, C_CKV = 256, C_KR = 384, C_DQ = 416, C_DK = 672, C_DV = 928, C_Z = 1184, C_XBC = 1696, C_DT = 2464;
constexpr float EPS = 1e-6f;
constexpr int NCHUNK = 96;

constexpr size_t O_Y = 0, O_CKV = 12582912, O_KROPE = 14680064, O_DK = 15204352, O_DV = 19398656, O_SSM = 23592960;

constexpr size_t OFF_BAR = 0;
constexpr size_t OFF_XRANK = 14080;
constexpr size_t OFF_CTR = 14336;
constexpr size_t OFF_LAM = 15360;
constexpr size_t OFF_MOD = 16384;
constexpr size_t OFF_ROPE = OFF_MOD + 4ull * 5 * 6144 * 4;
constexpr size_t OFF_WIN = OFF_ROPE + 2048ull * 32 * 4;
constexpr size_t OFF_WOUT = OFF_WIN + 4ull * NPROJP * 1024 * 2;
constexpr size_t OFF_WFF1 = OFF_WOUT + 4ull * 1024 * 1024 * 2;
constexpr size_t OFF_WFF2 = OFF_WFF1 + 4ull * 4096 * 1024 * 2;
constexpr size_t OFF_WUQ = OFF_WFF2 + 4ull * 4096 * 1024 * 2;
constexpr size_t OFF_WUKV = OFF_WUQ + 4ull * 384 * 256 * 2;
constexpr size_t OFF_HBUF = OFF_WUKV + 4ull * 512 * 128 * 2;
constexpr size_t OFF_MIX = OFF_HBUF + (size_t)T * 1024 * 2;
constexpr size_t OFF_DT = OFF_MIX + (size_t)T * 1024 * 2;
constexpr size_t OFF_R = OFF_DT + (size_t)T * 16 * 4;
constexpr size_t OFF_UBUF = OFF_R;
constexpr size_t OFF_PROJ = OFF_R;
constexpr size_t OFF_QA = OFF_PROJ + (size_t)T * NPROJP * 2;
constexpr size_t OFF_KA = OFF_QA + (size_t)T * 384 * 2;
constexpr size_t OFF_VAT = OFF_KA + (size_t)NKEY * 384 * 2;
constexpr size_t OFF_QD = OFF_VAT + 256ull * NKEY * 2;
constexpr size_t OFF_KD = OFF_QD + (size_t)T * 256 * 2;
constexpr size_t OFF_VDT = OFF_KD + (size_t)NKEY * 256 * 2;
constexpr size_t OFF_XBC = OFF_VDT + 256ull * NKEY * 2;
constexpr size_t OFF_ST = OFF_XBC + (size_t)T * 768 * 2;
constexpr size_t OFF_HP = OFF_ST + 96ull * 8 * 2 * 4096 * 4;
constexpr size_t OFF_CDEC = OFF_HP + 96ull * 8 * 2 * 4096 * 2;
constexpr size_t OFF_XB = OFF_CDEC + 96ull * 16 * 4;
constexpr size_t WS_END = OFF_XB + (size_t)T * 1024 * 2;

struct Params {
  const float* in[36];
  float* out;
  char* ws;
  int ph_begin, ph_end;
};

DI unsigned pk2(float lo, float hi) { unsigned r; asm("v_cvt_pk_bf16_f32 %0, %1, %2" : "=v"(r) : "v"(lo), "v"(hi)); return r; }
DI float bflo(unsigned u) { return __uint_as_float(u << 16); }
DI float bfhi(unsigned u) { return __uint_as_float(u & 0xffff0000u); }
DI float bf1(bf16_t h) { return __uint_as_float(((unsigned)h) << 16); }
DI bf16_t f2bf(float x) { return (bf16_t)(pk2(x, 0.f) & 0xffffu); }
DI int crow(int r, int half) { return (r & 3) + 8 * (r >> 2) + 4 * half; }
DI float xor32(float v) { return __shfl_xor(v, 32); }
DI float wave_sum(float v) {
#pragma unroll
  for (int o = 32; o > 0; o >>= 1) v += __shfl_xor(v, o);
  return v;
}
DI f32x16 zero16() { f32x16 z; for (int i = 0; i < 16; ++i) z[i] = 0.f; return z; }
DI int get_tid() { int t = threadIdx.x; asm volatile("" : "+v"(t)); return t; }
DI int get_tid4() { return get_tid() & 255; }
DI int get_hb() { return get_tid() >> 8; }
DI int modrow_of(int m) { return m < TP ? 0 : 1 + ((m - TP) >> 11); }

#define XB_TMO      128
#define XB_XCNT(j)  (256  + 64 * (j))
#define XB_XSUB(j)  (1280 + 64 * (j))
#define XB_XGEN(j)  (2304 + 64 * (j))
#define XB_TOP      3328
#define XB_TOPGEN   3392
#define XCD_BAR_WORDS 3456
#define XB_SPIN_CAP (1u << 22)
DI unsigned xb_ld(unsigned* p) { return __hip_atomic_load(p, __ATOMIC_RELAXED, __HIP_MEMORY_SCOPE_AGENT); }
DI unsigned xb_add(unsigned* p, unsigned v) { return __hip_atomic_fetch_add(p, v, __ATOMIC_RELAXED, __HIP_MEMORY_SCOPE_AGENT); }
DI unsigned xb_xcc_id() { return (unsigned)__builtin_amdgcn_s_getreg((3 << 11) | 20) & 0xFu; }
#define XB_SPIN(cond, bar) do { unsigned _sp = 0; while (cond) { __builtin_amdgcn_s_sleep(1); \
    if ((++_sp & 255u) == 0u) { if (xb_ld(&(bar)[XB_TMO])) break; if (_sp > XB_SPIN_CAP) { atomicAdd(&(bar)[XB_TMO], 1u); break; } } } } while (0)
struct XcdBarrier { unsigned* bar; unsigned x; volatile LAS unsigned* st; };
DI XcdBarrier xcd_barrier_post(unsigned* bar, volatile LAS unsigned* st) {
  XcdBarrier b; b.bar = bar; b.x = xb_xcc_id(); b.st = st;
  if (threadIdx.x == 0) (void)xb_add(&bar[XB_XCNT(b.x)], 1u);
  return b;
}
DI void xcd_barrier_complete(unsigned* bar, unsigned x, unsigned& nloc, unsigned& nx) {
  const unsigned G = gridDim.x * gridDim.y * gridDim.z;
  unsigned sum, cnt, mine, sp = 0u;
  for (;;) {
    sum = 0u; cnt = 0u; mine = 0u;
#pragma unroll
    for (unsigned j = 0; j < 16; ++j) { const unsigned c = xb_ld(&bar[XB_XCNT(j)]); sum += c; cnt += (c > 0u) ? 1u : 0u; mine = (j == x) ? c : mine; }
    if (sum == G) break;
    __builtin_amdgcn_s_sleep(1);
    if ((++sp & 255u) == 0u) { if (xb_ld(&bar[XB_TMO])) break; if (sp > XB_SPIN_CAP) { atomicAdd(&bar[XB_TMO], 1u); break; } }
  }
  nloc = mine > 0u ? mine : 1u; nx = cnt > 0u ? cnt : 1u;
}
DI void xcd_barrier(const XcdBarrier& b) {
  asm volatile("s_waitcnt vmcnt(0)" ::: "memory");
  __syncthreads();
  if (threadIdx.x == 0) {
    unsigned* bar = b.bar;
    __builtin_amdgcn_s_waitcnt(0);
    unsigned nloc = b.st[0], nx = b.st[1];
    if (nloc == 0u) { xcd_barrier_complete(bar, b.x, nloc, nx); b.st[0] = nloc; b.st[1] = nx; }
    const unsigned old = xb_add(&bar[XB_XSUB(b.x)], 1u);
    const unsigned gen = old / nloc;
    if (old + 1u == (gen + 1u) * nloc) {
      __builtin_amdgcn_fence(__ATOMIC_RELEASE, "agent");
      asm volatile("s_waitcnt vmcnt(0)" ::: "memory");
      const unsigned og = xb_add(&bar[XB_TOP], 1u);
      const unsigned tg = og / nx;
      if (og + 1u == (tg + 1u) * nx) xb_add(&bar[XB_TOPGEN], 1u);
      else XB_SPIN(xb_ld(&bar[XB_TOPGEN]) == tg, bar);
      __builtin_amdgcn_fence(__ATOMIC_ACQUIRE, "agent");
      xb_add(&bar[XB_XGEN(b.x)], 1u);
      asm volatile("s_waitcnt vmcnt(0)" ::: "memory");
    } else {
      XB_SPIN(xb_ld(&bar[XB_XGEN(b.x)]) == gen, bar);
      __builtin_amdgcn_fence(__ATOMIC_ACQUIRE, "agent");
      asm volatile("s_waitcnt vmcnt(0)" ::: "memory");
    }
  }
  __syncthreads();
}

constexpr int HALF_LDS = 75776;
constexpr int LDS_BYTES = 2 * HALF_LDS;
constexpr int PITCH64 = 144;
constexpr int PITCH128 = 272;
constexpr int PITCH96 = 208;

DI void transpose_tile4(const float* src, int K, int N, bf16_t* dst, int t0, int ncols, char* lds) {
  float* tile = (float*)lds;
  const int tid = get_tid4();
  f32x4 v[4][4];
#pragma unroll
  for (int q = 0; q < 4; ++q) {
    const int k0 = ((t0 + q) / ncols) * 64, n0 = ((t0 + q) % ncols) * 64;
#pragma unroll
    for (int i = 0; i < 4; ++i) {
      const int r = (tid >> 4) + 16 * i, c4 = (tid & 15) * 4;
      v[q][i] = (f32x4){0.f, 0.f, 0.f, 0.f};
      if (n0 + c4 < N) v[q][i] = *(const f32x4*)(src + (size_t)(k0 + r) * N + n0 + c4);
    }
  }
  __syncthreads();
#pragma unroll
  for (int q = 0; q < 4; ++q)
#pragma unroll
    for (int i = 0; i < 4; ++i) {
      const int r = (tid >> 4) + 16 * i, c4 = (tid & 15) * 4;
      float* t = tile + q * (64 * 65) + r * 65 + c4;
      t[0] = v[q][i][0]; t[1] = v[q][i][1]; t[2] = v[q][i][2]; t[3] = v[q][i][3];
    }
  __syncthreads();
#pragma unroll
  for (int q = 0; q < 4; ++q) {
    const int k0 = ((t0 + q) / ncols) * 64, n0 = ((t0 + q) % ncols) * 64;
    const float* tq = tile + q * (64 * 65);
#pragma unroll
    for (int i = 0; i < 2; ++i) {
      const int n = (tid >> 3) + 32 * i, kc = (tid & 7) * 8;
      u32x4 w;
      w[0] = pk2(tq[(kc + 0) * 65 + n], tq[(kc + 1) * 65 + n]);
      w[1] = pk2(tq[(kc + 2) * 65 + n], tq[(kc + 3) * 65 + n]);
      w[2] = pk2(tq[(kc + 4) * 65 + n], tq[(kc + 5) * 65 + n]);
      w[3] = pk2(tq[(kc + 6) * 65 + n], tq[(kc + 7) * 65 + n]);
      *(u32x4*)(dst + (size_t)(n0 + n) * K + k0 + kc) = w;
    }
  }
}

DI void mod_item(const Params& p, int item, char* lds) {
  float* sc = (float*)lds;
  float* red = sc + 5 * 1024;
  const int tid = get_tid4(), lane = tid & 63, w = tid >> 6;
  const int l = item / 96, j0 = (item % 96) * 64;
  __syncthreads();
  for (int i = tid; i < 5 * 1024; i += 256) {
    const int r = i >> 10, k = i & 1023;
    const float v = (r == 0) ? p.in[8][k] : p.in[7][(r - 1) * 1024 + k];
    sc[i] = v / (1.f + __expf(-v));
  }
  __syncthreads();
  const float* W = p.in[11] + (size_t)l * 1024 * 6144 + j0 + lane;
  float a0 = 0.f, a1 = 0.f, a2 = 0.f, a3 = 0.f, a4 = 0.f;
  const int kb = w * 256;
#pragma unroll 32
  for (int k = 0; k < 256; ++k) {
    const float wv = W[(size_t)(kb + k) * 6144];
    a0 += sc[kb + k] * wv; a1 += sc[1024 + kb + k] * wv; a2 += sc[2048 + kb + k] * wv; a3 += sc[3072 + kb + k] * wv; a4 += sc[4096 + kb + k] * wv;
  }
  red[(w * 5 + 0) * 64 + lane] = a0; red[(w * 5 + 1) * 64 + lane] = a1; red[(w * 5 + 2) * 64 + lane] = a2;
  red[(w * 5 + 3) * 64 + lane] = a3; red[(w * 5 + 4) * 64 + lane] = a4;
  __syncthreads();
  for (int i = tid; i < 320; i += 256) {
    const int r = i / 64, c = i % 64;
    const float s = red[(0 * 5 + r) * 64 + c] + red[(1 * 5 + r) * 64 + c] + red[(2 * 5 + r) * 64 + c] + red[(3 * 5 + r) * 64 + c];
    float* mod = (float*)(p.ws + OFF_MOD);
    mod[((size_t)l * 5 + r) * 6144 + j0 + c] = s + p.in[12][(size_t)l * 6144 + j0 + c];
  }
}

DI void setup_phase(const Params& p, char* lds) {
  constexpr int N_IN = 16 * 40 / 4, N_OUT = 16 * 16 / 4, N_F1 = 16 * 64 / 4, N_F2 = 64 * 16 / 4, N_UQ = 4 * 6 / 4, N_UKV = 2 * 8 / 4;
  constexpr int PER_L = N_IN + N_OUT + N_F1 + N_F2 + N_UQ + N_UKV;
  constexpr int N_TR = PER_L * 4, N_MOD = 384, N_ROPE = 64;
  static_assert((N_MOD + N_TR) % 2 == 0, "pairing");
  if (blockIdx.x == 0 && get_tid() < 4) {
    const int l = get_tid();
    float d1 = 0.f, d2 = 0.f;
    for (int k = 0; k < 32; ++k) { d1 += p.in[23][l * 32 + k] * p.in[24][l * 32 + k]; d2 += p.in[25][l * 32 + k] * p.in[26][l * 32 + k]; }
    const float lam_init = 0.8f - 0.6f * expf(-0.3f * (float)l);
    float* lamp = (float*)(p.ws + OFF_LAM);
    lamp[l * 2] = expf(d1) - expf(d2) + lam_init; lamp[l * 2 + 1] = lam_init;
  }
  const int hb = get_hb();
  lds += hb * HALF_LDS;
  for (int pair = blockIdx.x; pair < (N_MOD + N_TR) / 2; pair += gridDim.x) {
    const int item = pair * 2 + hb;
    if (item < N_MOD) { mod_item(p, item, lds); continue; }
    int it = item - N_MOD;
    {
      const int l = it / PER_L; int r = it % PER_L;
      if (r < N_IN) { transpose_tile4(p.in[13] + (size_t)l * 1024 * NPROJ, 1024, NPROJ, (bf16_t*)(p.ws + OFF_WIN) + (size_t)l * NPROJP * 1024, r * 4, 40, lds); continue; }
      r -= N_IN;
      if (r < N_OUT) { transpose_tile4(p.in[14] + (size_t)l * 1024 * 1024, 1024, 1024, (bf16_t*)(p.ws + OFF_WOUT) + (size_t)l * 1024 * 1024, r * 4, 16, lds); continue; }
      r -= N_OUT;
      if (r < N_F1) { transpose_tile4(p.in[34] + (size_t)l * 1024 * 4096, 1024, 4096, (bf16_t*)(p.ws + OFF_WFF1) + (size_t)l * 4096 * 1024, r * 4, 64, lds); continue; }
      r -= N_F1;
      if (r < N_F2) { transpose_tile4(p.in[35] + (size_t)l * 4096 * 1024, 4096, 1024, (bf16_t*)(p.ws + OFF_WFF2) + (size_t)l * 1024 * 4096, r * 4, 16, lds); continue; }
      r -= N_F2;
      if (r < N_UQ) { transpose_tile4(p.in[17] + (size_t)l * 256 * 384, 256, 384, (bf16_t*)(p.ws + OFF_WUQ) + (size_t)l * 384 * 256, r * 4, 6, lds); continue; }
      r -= N_UQ;
      transpose_tile4(p.in[18] + (size_t)l * 128 * 512, 128, 512, (bf16_t*)(p.ws + OFF_WUKV) + (size_t)l * 512 * 128, r * 4, 8, lds);
    }
  }
  for (int it = blockIdx.x; it < N_ROPE; it += gridDim.x) {
    {
      const int idx = it * 512 + get_tid();
      const int pos = idx >> 4, j = idx & 15;
      const float fr = __builtin_amdgcn_exp2f(-(float)(j & 7) * (13.287712379549449f / 8.f));
      const float base = (j < 8) ? (float)(pos >> 6) : (float)(pos & 63);
      float rev = base * fr * 0.15915494309189535f;
      rev -= floorf(rev);
      float* tab = (float*)(p.ws + OFF_ROPE);
      tab[idx * 2 + 0] = __builtin_amdgcn_cosf(rev);
      tab[idx * 2 + 1] = __builtin_amdgcn_sinf(rev);
    }
  }
}

DI const float* x_row_in(const Params& p, int l, int m) {
  if (l == 0) return m < TP ? p.in[0] + (size_t)m * D : p.in[1] + (size_t)(m - TP) * D;
  return p.out + (size_t)m * D;
}
DI void norm_phase(const Params& p, int l, int which) {
  const int tid = get_tid(), lane = tid & 63, w = tid >> 6;
  const float* g = p.in[which == 0 ? 9 : 10] + (size_t)l * D;
  const float* modl = (const float*)(p.ws + OFF_MOD) + (size_t)l * 5 * 6144;
  bf16_t* hbuf = (bf16_t*)(p.ws + OFF_HBUF);
  constexpr int RW = 6;
  for (int item = blockIdx.x; item < T / (8 * RW); item += gridDim.x) {
    const int m0 = item * 8 * RW + w * RW;
    f32x4 v[RW][4];
#pragma unroll
    for (int rr = 0; rr < RW; ++rr) {
      if (which == 0 && l == 0) {
        const float* x = x_row_in(p, 0, m0 + rr);
#pragma unroll
        for (int i = 0; i < 4; ++i) v[rr][i] = *(const f32x4*)(x + i * 256 + lane * 4);
      } else {
        const bf16_t* x = (const bf16_t*)(p.ws + OFF_XB) + (size_t)(m0 + rr) * D;
#pragma unroll
        for (int i = 0; i < 4; ++i) { const u32x2 r = *(const u32x2*)(x + i * 256 + lane * 4); v[rr][i] = (f32x4){bflo(r[0]), bfhi(r[0]), bflo(r[1]), bfhi(r[1])}; }
      }
    }
    f32x4 gg[4];
#pragma unroll
    for (int i = 0; i < 4; ++i) gg[i] = *(const f32x4*)(g + i * 256 + lane * 4);
#pragma unroll
    for (int rr = 0; rr < RW; ++rr) {
      const int m = m0 + rr;
      const float* mod = modl + (size_t)modrow_of(m) * 6144 + (which == 0 ? 0 : 3072);
      float ss = 0.f;
#pragma unroll
      for (int i = 0; i < 4; ++i) ss += v[rr][i][0] * v[rr][i][0] + v[rr][i][1] * v[rr][i][1] + v[rr][i][2] * v[rr][i][2] + v[rr][i][3] * v[rr][i][3];
      ss = wave_sum(ss);
      const float rstd = rsqrtf(ss * (1.f / D) + EPS);
#pragma unroll
      for (int i = 0; i < 4; ++i) {
        const int c = i * 256 + lane * 4;
        const f32x4 sh = *(const f32x4*)(mod + c), scl = *(const f32x4*)(mod + 1024 + c);
        float o[4];
#pragma unroll
        for (int e = 0; e < 4; ++e) o[e] = v[rr][i][e] * rstd * gg[i][e] * (1.f + scl[e]) + sh[e];
        u32x2 wv; wv[0] = pk2(o[0], o[1]); wv[1] = pk2(o[2], o[3]);
        *(u32x2*)(hbuf + (size_t)m * D + c) = wv;
      }
    }
  }
}

DI int lds_byte2(int r, int c) { const int st = (r >> 4) * 2 + (c >> 5), ob = (r & 15) * 64 + (c & 31) * 2; return st * 1024 + (ob ^ (((ob >> 9) & 1) << 5)); }
DI void stage_rc2(int b, int& R, int& C) { const int st = b >> 10, sb = b & 1023, swz = sb ^ (((sb >> 9) & 1) << 5); R = (st >> 1) * 16 + swz / 64; C = (st & 1) * 32 + (swz % 64) / 2; }
#define WAIT_V0() asm volatile("s_waitcnt vmcnt(0)" ::: "memory")
DI bool unit_next(int vb, int i, int nM, int nN, int& pm, int& pn) {
  const int nwg = nM * nN;
  const long L = (long)i * gridDim.x + vb; if (L >= nwg) return false;
  int wgid = (int)L; { const int q = nwg / 8, r = nwg % 8, xcd = wgid % 8, off = wgid / 8; wgid = (xcd < r ? xcd * (q + 1) : r * (q + 1) + (xcd - r) * q) + off; }
  const int nig = 8 * nN, gid = wgid / nig, fm = gid * 8, gsz = (nM - fm) < 8 ? (nM - fm) : 8;
  pm = fm + ((wgid % nig) % gsz); pn = (wgid % nig) / gsz; return true;
}
template <int BM, class Epi>
DI void gemm_phase(const bf16_t* __restrict__ A, int lda, const bf16_t* __restrict__ Bt, int ldb, int K, int nM, int nN, char* shm, int vb, Epi epi) {
  constexpr int BK = 64, TILE_B = 256 * BK * 2, GL = 4, STAGE_B = 2 * TILE_B, GLA = BM / 64, MB = BM / 32;
  const int tid = get_tid(), wid = tid >> 6, lane = tid & 63, wr = wid >> 2, wc = wid & 3, fr = lane & 15, fq = lane >> 4;
  int sR[GL], sC[GL];
#pragma unroll
  for (int i = 0; i < GL; ++i) stage_rc2(wid * 1024 + i * 8192 + lane * 16, sR[i], sC[i]);
  const int lo_ = (fr * 64 + fq * 16) ^ ((fr >> 3) << 5);
  const int aoff = wr * (BM / 32) * 2048 + lo_, boff = TILE_B + wc * 8192 + lo_;
  int sRB[GL];
#pragma unroll
  for (int i = 0; i < GL; ++i) { const int rho = sR[i] & 31, nn = rho >> 4, ii = rho & 15; sRB[i] = (sR[i] & ~31) + 8 * (ii >> 2) + 4 * nn + (ii & 3); }
#define SA_(b) (shm + (b) * STAGE_B)
#define SB_(b) (shm + (b) * STAGE_B + TILE_B)
#define GLDS_STAGE(buf, Ab_, Bb_, kt) do { _Pragma("unroll") for (int i = 0; i < GL; ++i) { \
    if (i < GLA) __builtin_amdgcn_global_load_lds((const unsigned*)((Ab_) + (size_t)sR[i] * lda + (kt) * BK + sC[i]), (LAS unsigned*)(SA_(buf) + wid * 1024 + i * 8192), 16, 0, 0); \
    __builtin_amdgcn_global_load_lds((const unsigned*)((Bb_) + (size_t)sRB[i] * ldb + (kt) * BK + sC[i]), (LAS unsigned*)(SB_(buf) + wid * 1024 + i * 8192), 16, 0, 0); } } while (0)
  int pm, pn;
  if (!unit_next(vb, 0, nM, nN, pm, pn)) return;
  const int nt = K / BK;
  GLDS_STAGE(0, A + (size_t)pm * BM * lda, Bt + (size_t)pn * 256 * ldb, 0);
#pragma unroll 1
  for (int ui = 0;; ++ui) {
    int npm = 0, npn = 0;
    const bool hn = unit_next(vb, ui + 1, nM, nN, npm, npn);
    f32x4 acc[MB][4];
#pragma unroll
    for (int m = 0; m < MB; ++m)
#pragma unroll
      for (int n = 0; n < 4; ++n) acc[m][n] = (f32x4){0.f, 0.f, 0.f, 0.f};
    WAIT_V0(); __syncthreads();
#pragma unroll 1
    for (int t = 0; t < nt; ++t) {
      const int cur = t & 1;
      {
        const bool last = t + 1 >= nt;
        if (!last || hn) {
          const bf16_t* Ab = A + (size_t)(last ? npm : pm) * BM * lda + (last ? 0 : (t + 1) * BK);
          const bf16_t* Bb = Bt + (size_t)(last ? npn : pn) * 256 * ldb + (last ? 0 : (t + 1) * BK);
          GLDS_STAGE(cur ^ 1, Ab, Bb, 0);
        }
      }
      if constexpr (BM == 192) {
        bf16x8 At[2][MB], Bf[2][4];
#pragma unroll
        for (int ks = 0; ks < 2; ++ks) {
#pragma unroll
          for (int n = 0; n < 4; ++n) Bf[ks][n] = *(const bf16x8*)(shm + cur * STAGE_B + boff + (n * 2 + ks) * 1024);
#pragma unroll
          for (int m = 0; m < MB; ++m) At[ks][m] = *(const bf16x8*)(shm + cur * STAGE_B + aoff + (m * 2 + ks) * 1024);
          __builtin_amdgcn_sched_barrier(0);
        }
#pragma unroll
        for (int ks = 0; ks < 2; ++ks) {
#pragma unroll
          for (int m = 0; m < MB; ++m)
#pragma unroll
            for (int n = 0; n < 4; ++n) acc[m][n] = __builtin_amdgcn_mfma_f32_16x16x32_bf16(Bf[ks][n], At[ks][m], acc[m][n], 0, 0, 0);
          __builtin_amdgcn_sched_barrier(0);
        }
      } else {
#pragma unroll
        for (int ks = 0; ks < 2; ++ks) {
          bf16x8 At[MB], Bf[4];
#pragma unroll
          for (int n = 0; n < 4; ++n) Bf[n] = *(const bf16x8*)(shm + cur * STAGE_B + boff + (n * 2 + ks) * 1024);
#pragma unroll
          for (int m = 0; m < MB; ++m) At[m] = *(const bf16x8*)(shm + cur * STAGE_B + aoff + (m * 2 + ks) * 1024);
          __builtin_amdgcn_sched_barrier(0);
#pragma unroll
          for (int m = 0; m < MB; ++m)
#pragma unroll
            for (int n = 0; n < 4; ++n) acc[m][n] = __builtin_amdgcn_mfma_f32_16x16x32_bf16(Bf[n], At[m], acc[m][n], 0, 0, 0);
          __builtin_amdgcn_sched_barrier(0);
        }
      }
      if (t + 1 < nt) { WAIT_V0(); __syncthreads(); }
    }
    const int brow = pm * BM, bcol = pn * 256;
    if constexpr (Epi::PRELOAD) {
      u32x4 xr[MB][2];
#pragma unroll
      for (int m = 0; m < MB; ++m)
#pragma unroll
        for (int g2 = 0; g2 < 2; ++g2) xr[m][g2] = epi.preload(brow + wr * (BM / 2) + m * 16 + fr, bcol + wc * 64 + g2 * 32 + fq * 8);
#pragma unroll
      for (int m = 0; m < MB; ++m)
#pragma unroll
        for (int g2 = 0; g2 < 2; ++g2) epi(brow + wr * (BM / 2) + m * 16 + fr, bcol + wc * 64 + g2 * 32 + fq * 8, acc[m][2 * g2], acc[m][2 * g2 + 1], xr[m][g2]);
    } else {
#pragma unroll
      for (int m = 0; m < MB; ++m)
#pragma unroll
        for (int g2 = 0; g2 < 2; ++g2) epi(brow + wr * (BM / 2) + m * 16 + fr, bcol + wc * 64 + g2 * 32 + fq * 8, acc[m][2 * g2], acc[m][2 * g2 + 1]);
    }
    if (!hn) break;
    pm = npm; pn = npn;
  }
  __syncthreads();
#undef SA_
#undef SB_
#undef GLDS_STAGE
}

struct EpiInProj {
  static constexpr bool PRELOAD = false;
  bf16_t* proj; float* dt;
  DI void operator()(int m, int n, const f32x4& v0, const f32x4& v1) const {
    u32x4 o; o[0] = pk2(v0[0], v0[1]); o[1] = pk2(v0[2], v0[3]); o[2] = pk2(v1[0], v1[1]); o[3] = pk2(v1[2], v1[3]);
    *(u32x4*)(proj + (size_t)m * NPROJP + n) = o;
    if (n >= C_DT && n < NPROJ) { float* d = dt + (size_t)m * 16 + (n - C_DT); *(f32x4*)d = v0; *(f32x4*)(d + 4) = v1; }
  }
};
struct EpiResid {
  static constexpr bool PRELOAD = true;
  const float* xin_p; const float* xin_s;
  bf16_t* xb; float* xout_f;
  const float* gate;
  DI u32x4 preload(int m, int n) const { return xin_p ? (u32x4){0u, 0u, 0u, 0u} : *(const u32x4*)(xb + (size_t)m * D + n); }
  DI void operator()(int m, int n, const f32x4& v0, const f32x4& v1, const u32x4& r) const {
    const float* gp = gate + (size_t)modrow_of(m) * 6144 + n;
    const f32x4 g0 = *(const f32x4*)gp, g1 = *(const f32x4*)(gp + 4);
    f32x4 x0, x1;
    if (xin_p) { const float* xi = ((m < TP) ? xin_p + (size_t)m * D : xin_s + (size_t)(m - TP) * D) + n; x0 = *(const f32x4*)xi; x1 = *(const f32x4*)(xi + 4); }
    else { x0 = (f32x4){bflo(r[0]), bfhi(r[0]), bflo(r[1]), bfhi(r[1])}; x1 = (f32x4){bflo(r[2]), bfhi(r[2]), bflo(r[3]), bfhi(r[3])}; }
    const f32x4 y0 = x0 + g0 * v0, y1 = x1 + g1 * v1;
    if (xout_f) { float* o = xout_f + (size_t)m * D + n; *(f32x4*)o = y0; *(f32x4*)(o + 4) = y1; }
    else { u32x4 o; o[0] = pk2(y0[0], y0[1]); o[1] = pk2(y0[2], y0[3]); o[2] = pk2(y1[0], y1[1]); o[3] = pk2(y1[2], y1[3]); *(u32x4*)(xb + (size_t)m * D + n) = o; }
  }
};
struct EpiFF1 {
  static constexpr bool PRELOAD = false;
  bf16_t* u;
  DI void operator()(int m, int n, const f32x4& v0, const f32x4& v1) const {
    float r[8];
#pragma unroll
    for (int e = 0; e < 4; ++e) { const float t0 = v0[e] > 0.f ? v0[e] : 0.f, t1 = v1[e] > 0.f ? v1[e] : 0.f; r[e] = t0 * t0; r[4 + e] = t1 * t1; }
    u32x4 o; o[0] = pk2(r[0], r[1]); o[1] = pk2(r[2], r[3]); o[2] = pk2(r[4], r[5]); o[3] = pk2(r[6], r[7]);
    *(u32x4*)(u + (size_t)m * DFF + n) = o;
  }
};

DI void rope_block(f32x16& v, const float* tab, int pos, int half) {
  const float* t = tab + (size_t)pos * 32;
#pragma unroll
  for (int q = 0; q < 2; ++q)
#pragma unroll
    for (int r = 0; r < 4; ++r) {
      const int fi = q * 8 + r + 4 * half;
      const float c = t[fi * 2], s = t[fi * 2 + 1];
      const float x1 = v[q * 8 + r], x2 = v[q * 8 + r + 4];
      v[q * 8 + r] = x1 * c - x2 * s;
      v[q * 8 + r + 4] = x2 * c + x1 * s;
    }
}
DI void store_block_bf16(bf16_t* dst, const f32x16& v, int half) {
#pragma unroll
  for (int q = 0; q < 4; q += 2) {
    unsigned ax = pk2(v[4 * q], v[4 * q + 1]), ay = pk2(v[4 * q + 2], v[4 * q + 3]);
    unsigned bx = pk2(v[4 * q + 4], v[4 * q + 5]), by = pk2(v[4 * q + 6], v[4 * q + 7]);
    { auto r = __builtin_amdgcn_permlane32_swap(ax, bx, false, false); ax = r[0]; bx = r[1]; }
    { auto r = __builtin_amdgcn_permlane32_swap(ay, by, false, false); ay = r[0]; by = r[1]; }
    u32x4 wv; wv[0] = ax; wv[1] = ay; wv[2] = bx; wv[3] = by;
    *(u32x4*)(dst + 8 * q + 8 * half) = wv;
  }
}
DI f32x16 gain_block(const float* g, int half) {
  f32x16 o;
#pragma unroll
  for (int q = 0; q < 4; ++q) { const f32x4 v = *(const f32x4*)(g + 8 * q + 4 * half); o[4 * q] = v[0]; o[4 * q + 1] = v[1]; o[4 * q + 2] = v[2]; o[4 * q + 3] = v[3]; }
  return o;
}
DI float sumsq16(const f32x16& v) { float s = 0.f;
#pragma unroll
  for (int i = 0; i < 16; ++i) s += v[i] * v[i];
  return s; }

DI void mla_q_item(const Params& p, int l, int item4, char* lds) {
  const int item = item4 >> 2, head0 = item4 & 3;
  const int lane = get_tid() & 63, w = get_tid() >> 6, l32 = lane & 31, half = lane >> 5;
  {
    const bf16_t* Wg = (const bf16_t*)(p.ws + OFF_WUQ) + ((size_t)l * 384 + head0 * 96) * 256;
    u32x4 t[6];
#pragma unroll
    for (int i = 0; i < 6; ++i) { const int c = get_tid() + 512 * i; t[i] = *(const u32x4*)(Wg + (size_t)(c >> 5) * 256 + (c & 31) * 8); }
    __syncthreads();
#pragma unroll
    for (int i = 0; i < 6; ++i) { const int c = get_tid() + 512 * i; *(u32x4*)(lds + (c >> 5) * 528 + (c & 31) * 16) = t[i]; }
    if (get_tid() < 64) *(f32x4*)(lds + 50688 + get_tid() * 16) = *(const f32x4*)(p.in[15] + (size_t)l * 256 + get_tid() * 4);
  }
  const int tok = item * 256 + w * 32 + l32;
  const bf16_t* proj = (const bf16_t*)(p.ws + OFF_PROJ) + (size_t)tok * NPROJP + C_CQ;
  const float* gq = p.in[15] + (size_t)l * 256;
  float ss = 0.f;
  u32x4 raw[16];
#pragma unroll
  for (int s = 0; s < 16; ++s) raw[s] = *(const u32x4*)(proj + 16 * s + 8 * half);
#pragma unroll
  for (int s = 0; s < 16; ++s) {
#pragma unroll
    for (int e = 0; e < 4; ++e) { const float a = bflo(raw[s][e]), b = bfhi(raw[s][e]); ss += a * a + b * b; }
  }
  ss += xor32(ss);
  const float rstd = rsqrtf(ss * (1.f / 256.f) + EPS);
  __syncthreads();
  bf16x8 fr[16];
#pragma unroll
  for (int s = 0; s < 16; ++s) {
    const f32x4 g0 = *(const f32x4*)(lds + 50688 + (16 * s + 8 * half) * 4), g1 = *(const f32x4*)(lds + 50688 + (16 * s + 8 * half + 4) * 4);
    u32x4 o;
    o[0] = pk2(bflo(raw[s][0]) * rstd * g0[0], bfhi(raw[s][0]) * rstd * g0[1]);
    o[1] = pk2(bflo(raw[s][1]) * rstd * g0[2], bfhi(raw[s][1]) * rstd * g0[3]);
    o[2] = pk2(bflo(raw[s][2]) * rstd * g1[0], bfhi(raw[s][2]) * rstd * g1[1]);
    o[3] = pk2(bflo(raw[s][3]) * rstd * g1[2], bfhi(raw[s][3]) * rstd * g1[3]);
    fr[s] = __builtin_bit_cast(bf16x8, o);
  }
  const bf16_t* W = (const bf16_t*)(p.ws + OFF_WUQ) + (size_t)l * 384 * 256;
  const float* gqk = p.in[19] + (size_t)l * 96;
  const float* tab = (const float*)(p.ws + OFF_ROPE);
  const bool rope = tok >= TP;
  const int pos = rope ? ((tok - TP) & 2047) : 0;
  const float qscale = 0.10206207261596577f * 1.4426950408889634f;
  bf16_t* qa = (bf16_t*)(p.ws + OFF_QA) + (size_t)tok * 384;
#pragma unroll 1
  for (int head = head0; head < head0 + 1; ++head) {
    f32x16 acc[3];
#pragma unroll
    for (int db = 0; db < 3; ++db) acc[db] = zero16();
#pragma unroll
    for (int db = 0; db < 3; ++db) {
      bf16x8 a[16];
      const char* wrow = lds + (db * 32 + l32) * 528 + 16 * half;
#pragma unroll
      for (int s = 0; s < 16; ++s) a[s] = *(const bf16x8*)(wrow + 32 * s);
      __builtin_amdgcn_sched_barrier(0);
#pragma unroll
      for (int s = 0; s < 16; ++s) acc[db] = MFMA32(a[s], fr[s], acc[db]);
      __builtin_amdgcn_sched_barrier(0);
    }
    float s2 = sumsq16(acc[0]) + sumsq16(acc[1]) + sumsq16(acc[2]);
    s2 += xor32(s2);
    const float r2 = rsqrtf(s2 * (1.f / 96.f) + EPS);
#pragma unroll
    for (int db = 0; db < 3; ++db) {
      const f32x16 gb = gain_block(gqk + db * 32, half);
#pragma unroll
      for (int r = 0; r < 16; ++r) acc[db][r] *= r2 * gb[r];
    }
    if (rope) rope_block(acc[2], tab, pos, half);
#pragma unroll
    for (int db = 0; db < 3; ++db) {
#pragma unroll
      for (int r = 0; r < 16; ++r) acc[db][r] *= qscale;
      store_block_bf16(qa + head * 96 + db * 32, acc[db], half);
    }
  }
}

DI void mla_kv_item(const Params& p, int l, int item4, char* lds) {
  const int item = item4 >> 2, head0 = item4 & 3;
  const int lane = get_tid() & 63, w = get_tid() >> 6, l32 = lane & 31, half = lane >> 5;
  {
    const bf16_t* Wg = (const bf16_t*)(p.ws + OFF_WUKV) + ((size_t)l * 512 + head0 * 128) * 128;
    u32x4 t[4];
#pragma unroll
    for (int i = 0; i < 4; ++i) { const int c = get_tid() + 512 * i; t[i] = *(const u32x4*)(Wg + (size_t)(c >> 4) * 128 + (c & 15) * 8); }
    __syncthreads();
#pragma unroll
    for (int i = 0; i < 4; ++i) { const int c = get_tid() + 512 * i; *(u32x4*)(lds + (c >> 4) * PITCH128 + (c & 15) * 16) = t[i]; }
  }
  const int kr = item * 256 + w * 32 + l32;
  int tok = -1, b = 0, j = 0; bool cached = false, rope = false; int pos = 0;
  if (kr < TP) { tok = kr; }
  else { b = (kr - TP) / 2304; j = (kr - TP) % 2304; if (j < PAST) cached = true; else { tok = TP + b * 2048 + (j - PAST); rope = true; pos = j - PAST; } }
  bf16x8 fr[8];
  f32x16 krb;
  if (!cached) {
    const bf16_t* proj = (const bf16_t*)(p.ws + OFF_PROJ) + (size_t)tok * NPROJP;
    const float* gkv = p.in[16] + (size_t)l * 128;
    u32x4 raw[8]; float ss = 0.f;
    f32x4 gv0[8], gv1[8]; u32x2 rvv[4];
#pragma unroll
    for (int s = 0; s < 8; ++s) raw[s] = *(const u32x4*)(proj + C_CKV + 16 * s + 8 * half);
#pragma unroll
    for (int s = 0; s < 8; ++s) { gv0[s] = *(const f32x4*)(gkv + 16 * s + 8 * half); gv1[s] = *(const f32x4*)(gkv + 16 * s + 8 * half + 4); }
#pragma unroll
    for (int q = 0; q < 4; ++q) rvv[q] = *(const u32x2*)(proj + C_KR + 8 * q + 4 * half);
#pragma unroll
    for (int s = 0; s < 8; ++s) {
#pragma unroll
      for (int e = 0; e < 4; ++e) { const float a = bflo(raw[s][e]), bb = bfhi(raw[s][e]); ss += a * a + bb * bb; }
    }
    ss += xor32(ss);
    const float rstd = rsqrtf(ss * (1.f / 128.f) + EPS);
#pragma unroll
    for (int s = 0; s < 8; ++s) {
      const f32x4 g0 = gv0[s], g1 = gv1[s];
      f32x4 o0, o1;
      o0[0] = bflo(raw[s][0]) * rstd * g0[0]; o0[1] = bfhi(raw[s][0]) * rstd * g0[1]; o0[2] = bflo(raw[s][1]) * rstd * g0[2]; o0[3] = bfhi(raw[s][1]) * rstd * g0[3];
      o1[0] = bflo(raw[s][2]) * rstd * g1[0]; o1[1] = bfhi(raw[s][2]) * rstd * g1[1]; o1[2] = bflo(raw[s][3]) * rstd * g1[2]; o1[3] = bfhi(raw[s][3]) * rstd * g1[3];
      u32x4 o; o[0] = pk2(o0[0], o0[1]); o[1] = pk2(o0[2], o0[3]); o[2] = pk2(o1[0], o1[1]); o[3] = pk2(o1[2], o1[3]);
      fr[s] = __builtin_bit_cast(bf16x8, o);
      if (tok < TP && head0 == 0) {
        float* dst = p.out + O_CKV + (((size_t)(tok >> 8) * DEPTH + l) * 256 + (tok & 255)) * 128 + 16 * s + 8 * half;
        *(f32x4*)dst = o0; *(f32x4*)(dst + 4) = o1;
      }
    }
#pragma unroll
    for (int q = 0; q < 4; ++q) {
      const u32x2 rv = rvv[q];
      krb[4 * q] = bflo(rv[0]); krb[4 * q + 1] = bfhi(rv[0]); krb[4 * q + 2] = bflo(rv[1]); krb[4 * q + 3] = bfhi(rv[1]);
      if (tok < TP && head0 == 0) {
        float* dst = p.out + O_KROPE + (((size_t)(tok >> 8) * DEPTH + l) * 256 + (tok & 255)) * 32 + 8 * q + 4 * half;
        f32x4 o = {krb[4 * q], krb[4 * q + 1], krb[4 * q + 2], krb[4 * q + 3]};
        *(f32x4*)dst = o;
      }
    }
  } else {
    const float* src = p.in[2] + (((size_t)b * DEPTH + l) * PAST + j) * 128;
#pragma unroll
    for (int s = 0; s < 8; ++s) {
      const f32x4 v0 = *(const f32x4*)(src + 16 * s + 8 * half), v1 = *(const f32x4*)(src + 16 * s + 8 * half + 4);
      u32x4 o; o[0] = pk2(v0[0], v0[1]); o[1] = pk2(v0[2], v0[3]); o[2] = pk2(v1[0], v1[1]); o[3] = pk2(v1[2], v1[3]);
      fr[s] = __builtin_bit_cast(bf16x8, o);
    }
    const float* ks = p.in[3] + (((size_t)b * DEPTH + l) * PAST + j) * 32;
#pragma unroll
    for (int q = 0; q < 4; ++q) {
      const f32x4 v = *(const f32x4*)(ks + 8 * q + 4 * half);
      krb[4 * q] = v[0]; krb[4 * q + 1] = v[1]; krb[4 * q + 2] = v[2]; krb[4 * q + 3] = v[3];
    }
  }
  const bf16_t* W = (const bf16_t*)(p.ws + OFF_WUKV) + (size_t)l * 512 * 128;
  const float* gk = p.in[20] + (size_t)l * 96;
  const float* tab = (const float*)(p.ws + OFF_ROPE);
  bf16_t* ka = (bf16_t*)(p.ws + OFF_KA) + (size_t)kr * 384;
  bf16_t* vat = (bf16_t*)(p.ws + OFF_VAT);
  const float ssr = sumsq16(krb);
  __syncthreads();
#pragma unroll 1
  for (int head = head0; head < head0 + 1; ++head) {
    f32x16 acc[4];
#pragma unroll
    for (int db = 0; db < 4; ++db) acc[db] = zero16();
#pragma unroll
    for (int dp = 0; dp < 2; ++dp) {
      bf16x8 a[2][8];
#pragma unroll
      for (int d2 = 0; d2 < 2; ++d2)
#pragma unroll
        for (int s = 0; s < 8; ++s) a[d2][s] = *(const bf16x8*)(lds + ((dp * 2 + d2) * 32 + l32) * PITCH128 + 32 * s + 16 * half);
      __builtin_amdgcn_sched_barrier(0);
#pragma unroll
      for (int d2 = 0; d2 < 2; ++d2)
#pragma unroll
        for (int s = 0; s < 8; ++s) acc[dp * 2 + d2] = MFMA32(a[d2][s], fr[s], acc[dp * 2 + d2]);
      __builtin_amdgcn_sched_barrier(0);
    }
    float s2 = sumsq16(acc[0]) + sumsq16(acc[1]) + ssr;
    s2 += xor32(s2);
    const float r2 = rsqrtf(s2 * (1.f / 96.f) + EPS);
    f32x16 k2;
    {
      const f32x16 g0 = gain_block(gk, half), g1 = gain_block(gk + 32, half), g2 = gain_block(gk + 64, half);
#pragma unroll
      for (int r = 0; r < 16; ++r) { acc[0][r] *= r2 * g0[r]; acc[1][r] *= r2 * g1[r]; k2[r] = krb[r] * r2 * g2[r]; }
    }
    if (rope) rope_block(k2, tab, pos, half);
    store_block_bf16(ka + head * 96, acc[0], half);
    store_block_bf16(ka + head * 96 + 32, acc[1], half);
    store_block_bf16(ka + head * 96 + 64, k2, half);
#pragma unroll
    for (int db = 2; db < 4; ++db)
#pragma unroll
      for (int r = 0; r < 16; ++r)
        vat[((size_t)head * 64 + (db - 2) * 32 + crow(r, half)) * NKEY + kr] = f2bf(acc[db][r]);
  }
}

DI void diff_qk_thread(const Params& p, int l, int idx, bool isk) {
  const float* tab = (const float*)(p.ws + OFF_ROPE);
  const int hm = idx & 7, row = idx >> 3;
  float x[32];
  int tok = -1, pos = 0; bool rope = false, cached = false;
  if (!isk) { tok = row; if (tok >= TP) { rope = true; pos = (tok - TP) & 2047; } }
  else {
    if (row < TP) tok = row;
    else { const int b = (row - TP) / 2304, j = (row - TP) % 2304;
      if (j < PAST) { cached = true;
        const float* src = p.in[4] + ((((size_t)b * DEPTH + l) * PAST + j) * 8 + hm) * 32;
#pragma unroll
        for (int i = 0; i < 8; ++i) { const f32x4 v = *(const f32x4*)(src + 4 * i); x[4 * i] = v[0]; x[4 * i + 1] = v[1]; x[4 * i + 2] = v[2]; x[4 * i + 3] = v[3]; }
      } else { tok = TP + b * 2048 + (j - PAST); rope = true; pos = j - PAST; } }
  }
  if (!cached) {
    const bf16_t* src = (const bf16_t*)(p.ws + OFF_PROJ) + (size_t)tok * NPROJP + (isk ? C_DK : C_DQ) + hm * 32;
    float ss = 0.f;
#pragma unroll
    for (int i = 0; i < 4; ++i) {
      const u32x4 v = *(const u32x4*)(src + 8 * i);
#pragma unroll
      for (int e = 0; e < 4; ++e) { x[8 * i + 2 * e] = bflo(v[e]); x[8 * i + 2 * e + 1] = bfhi(v[e]); }
    }
#pragma unroll
    for (int i = 0; i < 32; ++i) ss += x[i] * x[i];
    const float rstd = rsqrtf(ss * (1.f / 32.f) + EPS);
    const float* g = p.in[isk ? 22 : 21] + (size_t)l * 32;
#pragma unroll
    for (int i = 0; i < 32; ++i) x[i] *= rstd * g[i];
    if (isk && tok < TP) {
      float* dst = p.out + O_DK + (((size_t)(tok >> 8) * DEPTH + l) * 256 + (tok & 255)) * 256 + hm * 32;
#pragma unroll
      for (int i = 0; i < 8; ++i) { f32x4 o = {x[4 * i], x[4 * i + 1], x[4 * i + 2], x[4 * i + 3]}; *(f32x4*)(dst + 4 * i) = o; }
    }
    if (rope) {
      const float* t = tab + (size_t)pos * 32;
#pragma unroll
      for (int q = 0; q < 2; ++q)
#pragma unroll
        for (int m = 0; m < 8; ++m) {
          const float c = t[(q * 8 + m) * 2], s = t[(q * 8 + m) * 2 + 1];
          const float x1 = x[q * 16 + m], x2 = x[q * 16 + 8 + m];
          x[q * 16 + m] = x1 * c - x2 * s; x[q * 16 + 8 + m] = x2 * c + x1 * s;
        }
    }
  }
  const float sc = isk ? 1.f : 0.17677669529663687f * 1.4426950408889634f;
  bf16_t* dst = (bf16_t*)(p.ws + (isk ? OFF_KD : OFF_QD)) + (size_t)row * 256 + hm * 32;
#pragma unroll
  for (int i = 0; i < 4; ++i) {
    u32x4 o;
#pragma unroll
    for (int e = 0; e < 4; ++e) o[e] = pk2(x[8 * i + 2 * e] * sc, x[8 * i + 2 * e + 1] * sc);
    *(u32x4*)(dst + 8 * i) = o;
  }
}
DI void diff_v_thread(const Params& p, int l, int idx) {
  const int head = idx / NKEY, kr = idx % NKEY;
  bf16_t* vdt = (bf16_t*)(p.ws + OFF_VDT) + (size_t)head * 64 * NKEY + kr;
  int tok = -1;
  if (kr < TP) tok = kr;
  else { const int b = (kr - TP) / 2304, j = (kr - TP) % 2304;
    if (j < PAST) {
      const float* src = p.in[5] + ((((size_t)b * DEPTH + l) * PAST + j) * 4 + head) * 64;
#pragma unroll
      for (int i = 0; i < 16; ++i) { const f32x4 v = *(const f32x4*)(src + 4 * i);
#pragma unroll
        for (int e = 0; e < 4; ++e) vdt[(size_t)(4 * i + e) * NKEY] = f2bf(v[e]); }
      return;
    }
    tok = TP + b * 2048 + (j - PAST);
  }
  const bf16_t* src = (const bf16_t*)(p.ws + OFF_PROJ) + (size_t)tok * NPROJP + C_DV + head * 64;
  float* od = (tok < TP) ? p.out + O_DV + (((size_t)(tok >> 8) * DEPTH + l) * 256 + (tok & 255)) * 256 + head * 64 : nullptr;
#pragma unroll
  for (int i = 0; i < 8; ++i) {
    const u32x4 v = *(const u32x4*)(src + 8 * i);
#pragma unroll
    for (int e = 0; e < 4; ++e) {
      vdt[(size_t)(8 * i + 2 * e) * NKEY] = (bf16_t)(v[e] & 0xffffu);
      vdt[(size_t)(8 * i + 2 * e + 1) * NKEY] = (bf16_t)(v[e] >> 16);
    }
    if (od) {
      f32x4 o0 = {bflo(v[0]), bfhi(v[0]), bflo(v[1]), bfhi(v[1])}, o1 = {bflo(v[2]), bfhi(v[2]), bflo(v[3]), bfhi(v[3])};
      *(f32x4*)(od + 8 * i) = o0; *(f32x4*)(od + 8 * i + 4) = o1;
    }
  }
}
template <int CU>
DI void conv_threads(const Params& p, int l, int idx0, int stride) {
  u32x4 v[CU][5]; f32x4 bia[CU][2];
  int tokv[CU], c0v[CU];
#pragma unroll
  for (int u = 0; u < CU; ++u) {
    const int idx = idx0 + u * stride;
    const int tok = idx / 96, c0 = (idx % 96) * 8;
    tokv[u] = tok; c0v[u] = c0;
    int pos, L;
    if (tok < TP) { pos = tok & 255; L = 256; } else { pos = (tok - TP) & 2047; L = 2048; }
    const bf16_t* src = (const bf16_t*)(p.ws + OFF_PROJ) + (size_t)tok * NPROJP + C_XBC + c0;
#pragma unroll
    for (int k = 0; k < 5; ++k) {
      const int pp = pos + k - 2;
      v[u][k] = (u32x4){0u, 0u, 0u, 0u};
      if (pp >= 0 && pp < L) v[u][k] = *(const u32x4*)(src + (ptrdiff_t)(k - 2) * NPROJP);
    }
    const float* cb = p.in[29] + (size_t)l * 768 + c0;
    bia[u][0] = *(const f32x4*)cb; bia[u][1] = *(const f32x4*)(cb + 4);
  }
#pragma unroll
  for (int u = 0; u < CU; ++u) {
    const float* cw = p.in[28] + (size_t)l * 5 * 768 + c0v[u];
    float acc[8] = {bia[u][0][0], bia[u][0][1], bia[u][0][2], bia[u][0][3], bia[u][1][0], bia[u][1][1], bia[u][1][2], bia[u][1][3]};
#pragma unroll
    for (int k = 0; k < 5; ++k) {
      const f32x4 w0 = *(const f32x4*)(cw + k * 768), w1 = *(const f32x4*)(cw + k * 768 + 4);
      const u32x4 x = v[u][k];
      acc[0] += w0[0] * bflo(x[0]); acc[1] += w0[1] * bfhi(x[0]); acc[2] += w0[2] * bflo(x[1]); acc[3] += w0[3] * bfhi(x[1]);
      acc[4] += w1[0] * bflo(x[2]); acc[5] += w1[1] * bfhi(x[2]); acc[6] += w1[2] * bflo(x[3]); acc[7] += w1[3] * bfhi(x[3]);
    }
#pragma unroll
    for (int e = 0; e < 8; ++e) acc[e] = acc[e] / (1.f + __expf(-acc[e]));
    u32x4 o; o[0] = pk2(acc[0], acc[1]); o[1] = pk2(acc[2], acc[3]); o[2] = pk2(acc[4], acc[5]); o[3] = pk2(acc[6], acc[7]);
    *(u32x4*)((bf16_t*)(p.ws + OFF_XBC) + (size_t)tokv[u] * 768 + c0v[u]) = o;
  }
}
DI void dt_thread(const Params& p, int l, int idx) {
  float* dt = (float*)(p.ws + OFF_DT);
  const float v = dt[idx] + p.in[31][(size_t)l * 16 + (idx & 15)];
  dt[idx] = fmaxf(v, 0.f) + log1pf(__expf(-fabsf(v)));
}

DI void prep_phase(const Params& p, int l, char* lds) {
  constexpr int N_Q = 48 * 4, N_KV = 52 * 4, N_DQ = T * 8 / 512, N_DKK = NKEY * 8 / 512, N_DV = NKEY * 4 / 512, N_CONV = T * 96 / 512 / 3, N_DTT = T * 16 / 512;
  constexpr int TOT = N_Q + N_KV + N_DQ + N_DKK + N_DV + N_CONV + N_DTT;
  for (int item = blockIdx.x; item < TOT; item += gridDim.x) {
    int it = item;
    if (it < N_Q) { mla_q_item(p, l, it, lds); continue; }
    it -= N_Q;
    if (it < N_KV) { mla_kv_item(p, l, it, lds); continue; }
    it -= N_KV;
    if (it < N_DQ) { diff_qk_thread(p, l, it * 512 + get_tid(), false); continue; }
    it -= N_DQ;
    if (it < N_DKK) { diff_qk_thread(p, l, it * 512 + get_tid(), true); continue; }
    it -= N_DKK;
    if (it < N_DV) { diff_v_thread(p, l, it * 512 + get_tid()); continue; }
    it -= N_DV;
    if (it < N_CONV) { conv_threads<3>(p, l, it * 512 + get_tid(), N_CONV * 512); continue; }
    it -= N_CONV;
    dt_thread(p, l, it * 512 + get_tid());
  }
}

DI void wave_scan2(float e0, float e1, float& o0, float& o1) {
  const int lane = get_tid() & 63;
  const float s = e0 + e1;
  float inc = s;
#pragma unroll
  for (int o = 1; o < 64; o <<= 1) { const float t = __shfl_up(inc, o); if (lane >= o) inc += t; }
  const float excl = inc - s;
  o0 = excl + e0; o1 = excl + s;
}
DI void ssd_dt_load(const Params& p, int cg_, int h, float& d0, float& d1) {
  const int lane = get_tid() & 63, w = get_tid4() >> 6;
  const float* dt = (const float*)(p.ws + OFF_DT) + (size_t)cg_ * 128 * 16;
  d0 = 0.f; d1 = 0.f;
  if (w == 0) { d0 = dt[(2 * lane) * 16 + h]; d1 = dt[(2 * lane + 1) * 16 + h]; }
  else if (w == 1) { d0 = dt[(127 - 2 * lane) * 16 + 8 + h]; d1 = dt[(126 - 2 * lane) * 16 + 8 + h]; }
}
DI void ssd_scalars_from(const Params& p, int l, int h, float d0, float d1, float* acf, float* sb, float* dtf, float* dtb) {
  const int lane = get_tid() & 63, w = get_tid4() >> 6;
  if (w == 0) {
    const float a = -__expf(p.in[30][(size_t)l * 16 + h]);
    float o0, o1; wave_scan2(d0 * a, d1 * a, o0, o1);
    acf[2 * lane] = o0; acf[2 * lane + 1] = o1; dtf[2 * lane] = d0; dtf[2 * lane + 1] = d1;
  } else if (w == 1) {
    const float a = -__expf(p.in[30][(size_t)l * 16 + 8 + h]);
    const int j0 = 127 - 2 * lane, j1 = 126 - 2 * lane;
    float o0, o1; wave_scan2(d0 * a, d1 * a, o0, o1);
    sb[j0] = o0; sb[j1] = o1; dtb[j0] = d0; dtb[j1] = d1;
  }
}
DI void ssd_scalars(const Params& p, int l, int cg_, int h, float* acf, float* sb, float* dtf, float* dtb) {
  const int lane = get_tid() & 63, w = get_tid4() >> 6;
  const float* dt = (const float*)(p.ws + OFF_DT) + (size_t)cg_ * 128 * 16;
  if (w == 0) {
    const float a = -__expf(p.in[30][(size_t)l * 16 + h]);
    const float d0 = dt[(2 * lane) * 16 + h], d1 = dt[(2 * lane + 1) * 16 + h];
    float o0, o1; wave_scan2(d0 * a, d1 * a, o0, o1);
    acf[2 * lane] = o0; acf[2 * lane + 1] = o1; dtf[2 * lane] = d0; dtf[2 * lane + 1] = d1;
  } else if (w == 1) {
    const float a = -__expf(p.in[30][(size_t)l * 16 + 8 + h]);
    const int j0 = 127 - 2 * lane, j1 = 126 - 2 * lane;
    const float d0 = dt[j0 * 16 + 8 + h], d1 = dt[j1 * 16 + 8 + h];
    float o0, o1; wave_scan2(d0 * a, d1 * a, o0, o1);
    sb[j0] = o0; sb[j1] = o1; dtb[j0] = d0; dtb[j1] = d1;
  }
}

DI void ssd_states_item(const Params& p, int l, int item, char* lds) {
  const int tid = get_tid4(), lane = tid & 63, w = tid >> 6, l32 = lane & 31, half = lane >> 5;
  const int cg_ = item >> 3, h = item & 7, g = h >> 2;
  char* XF = lds; char* XB = lds + 64 * PITCH128; char* BT = lds + 2 * 64 * PITCH128;
  float* sc = (float*)(lds + 3 * 64 * PITCH128);
  float* acf = sc, *sb = sc + 128, *dtf = sc + 256, *dtb = sc + 384;
  __syncthreads();
  ssd_scalars(p, l, cg_, h, acf, sb, dtf, dtb);
  __syncthreads();
  const bf16_t* xbc = (const bf16_t*)(p.ws + OFF_XBC) + (size_t)cg_ * 128 * 768;
  const float aL = acf[127], s0 = sb[0];
#pragma unroll
  for (int it = 0; it < 2; ++it) {
    const int t = tid + 256 * it, jp = t & 63, pc = t >> 6, j0 = 2 * jp;
    const u32x4 x0 = *(const u32x4*)(xbc + (size_t)j0 * 768 + h * 64 + pc * 8), x1 = *(const u32x4*)(xbc + (size_t)(j0 + 1) * 768 + h * 64 + pc * 8);
    const u32x4 b0 = *(const u32x4*)(xbc + (size_t)j0 * 768 + 512 + g * 64 + pc * 8), b1 = *(const u32x4*)(xbc + (size_t)(j0 + 1) * 768 + 512 + g * 64 + pc * 8);
    const float wf0 = __expf(aL - acf[j0]) * dtf[j0], wf1 = __expf(aL - acf[j0 + 1]) * dtf[j0 + 1];
    const float wb0 = __expf(s0 - sb[j0]) * dtb[j0], wb1 = __expf(s0 - sb[j0 + 1]) * dtb[j0 + 1];
#pragma unroll
    for (int e = 0; e < 4; ++e) {
      const float a0 = bflo(x0[e]), a1 = bfhi(x0[e]), c0 = bflo(x1[e]), c1 = bfhi(x1[e]);
      const int pr = pc * 8 + 2 * e;
      *(unsigned*)(XF + pr * PITCH128 + j0 * 2) = pk2(a0 * wf0, c0 * wf1);
      *(unsigned*)(XF + (pr + 1) * PITCH128 + j0 * 2) = pk2(a1 * wf0, c1 * wf1);
      *(unsigned*)(XB + pr * PITCH128 + j0 * 2) = pk2(a0 * wb0, c0 * wb1);
      *(unsigned*)(XB + (pr + 1) * PITCH128 + j0 * 2) = pk2(a1 * wb0, c1 * wb1);
      *(unsigned*)(BT + pr * PITCH128 + j0 * 2) = (b0[e] & 0xffffu) | (b1[e] << 16);
      *(unsigned*)(BT + (pr + 1) * PITCH128 + j0 * 2) = (b0[e] >> 16) | (b1[e] & 0xffff0000u);
    }
  }
  __syncthreads();
  const int dir = w >> 1, pb = w & 1;
  const char* Xs = (dir ? XB : XF) + (pb * 32 + l32) * PITCH128 + half * 16;
  const char* Bsrc = BT + l32 * PITCH128 + half * 16;
  f32x16 acc[2] = {zero16(), zero16()};
#pragma unroll
  for (int s = 0; s < 8; ++s) {
    const bf16x8 a = *(const bf16x8*)(Xs + s * 32);
    const bf16x8 b0 = *(const bf16x8*)(Bsrc + s * 32), b1 = *(const bf16x8*)(Bsrc + 32 * PITCH128 + s * 32);
    acc[0] = MFMA32(a, b0, acc[0]); acc[1] = MFMA32(a, b1, acc[1]);
  }
  float* ST = (float*)(p.ws + OFF_ST) + ((size_t)(cg_ * 8 + h) * 2 + dir) * 4096;
#pragma unroll
  for (int nb = 0; nb < 2; ++nb)
#pragma unroll
    for (int r = 0; r < 16; ++r) ST[(pb * 32 + crow(r, half)) * 64 + nb * 32 + l32] = acc[nb][r];
  if (tid == 0) { float* cd = (float*)(p.ws + OFF_CDEC) + (size_t)(cg_ * 8 + h) * 2; cd[0] = __expf(aL); cd[1] = __expf(s0); }
}

template <int NC>
DI void ssd_scan_thread(const Params& p, int l, int seq, int r, int cg0, f32x4 hs) {
  const float* ST = (const float*)(p.ws + OFF_ST);
  bf16_t* HP = (bf16_t*)(p.ws + OFF_HP);
  const float* CD = (const float*)(p.ws + OFF_CDEC);
  const int h = r >> 11, dir = (r >> 10) & 1, pn = r & 1023;
  f32x4 st[NC]; float dec[NC];
#pragma unroll
  for (int c = 0; c < NC; ++c) {
    const int cgi = cg0 + (dir ? NC - 1 - c : c);
    st[c] = *(const f32x4*)(ST + ((size_t)(cgi * 8 + h) * 2 + dir) * 4096 + pn * 4);
    dec[c] = CD[(size_t)(cgi * 8 + h) * 2 + dir];
  }
#pragma unroll
  for (int c = 0; c < NC; ++c) {
    const int cgi = cg0 + (dir ? NC - 1 - c : c);
    u32x2 hv; hv[0] = pk2(hs[0], hs[1]); hv[1] = pk2(hs[2], hs[3]);
    *(u32x2*)(HP + ((size_t)(cgi * 8 + h) * 2 + dir) * 4096 + pn * 4) = hv;
    hs = dec[c] * hs + st[c];
  }
  if (seq < 16) *(f32x4*)(p.out + O_SSM + ((((size_t)seq * DEPTH + l) * 2 + dir) * 8 + h) * 4096 + pn * 4) = hs;
}
DI void ssd_scan_phase(const Params& p, int l) {
  constexpr int PER_SEQ = 8 * 2 * 64 * 16;
  for (int item = blockIdx.x; item < 20 * PER_SEQ / 512; item += gridDim.x) {
    const int idx = item * 512 + get_tid();
    const int sq = idx / PER_SEQ; const int r = idx % PER_SEQ;
    const int seq = (sq < 4) ? 16 + sq : sq - 4;
    if (seq < 16) ssd_scan_thread<2>(p, l, seq, r, 2 * seq, (f32x4){0.f, 0.f, 0.f, 0.f});
    else {
      const int dir = (r >> 10) & 1, h = r >> 11, pn = r & 1023;
      const f32x4 h0 = *(const f32x4*)(p.in[6] + ((((size_t)(seq - 16) * DEPTH + l) * 2 + dir) * 8 + h) * 4096 + pn * 4);
      ssd_scan_thread<16>(p, l, seq, r, 32 + 16 * (seq - 16), h0);
    }
  }
}

DI void ssd_y_item(const Params& p, int l, int cg_, char* lds_blk) {
  const int tid = get_tid4(), lane = tid & 63, w = tid >> 6, l32 = lane & 31, half = lane >> 5;
  const int g = get_hb();
  char* lds = lds_blk + g * HALF_LDS;
  char* Bs = lds; char* Cs = lds + 128 * PITCH64; char* XT = lds + 2 * 128 * PITCH64;
  char* Hf = XT + 64 * PITCH128; char* Hb = Hf + 64 * PITCH64;
  float* sc = (float*)(Hb + 64 * PITCH64);
  float* acf = sc, *sb = sc + 128, *dtf = sc + 256, *dtb = sc + 384;
  const int tok0 = cg_ * 128;
  const int i = w * 32 + l32, tok = tok0 + i;
  const bf16_t* xbc = (const bf16_t*)(p.ws + OFF_XBC) + (size_t)tok0 * 768;
  const bf16_t* proj = (const bf16_t*)(p.ws + OFF_PROJ);
  bf16_t* mix = (bf16_t*)(p.ws + OFF_MIX);
  float ssq = 0.f;
  {
    __syncthreads();
#pragma unroll
    for (int it = 0; it < 4; ++it) {
      const int t = tid + 256 * it, r = t >> 3, c = (t & 7) * 8;
      *(u32x4*)(Bs + r * PITCH64 + c * 2) = *(const u32x4*)(xbc + (size_t)r * 768 + 512 + g * 64 + c);
      *(u32x4*)(Cs + r * PITCH64 + c * 2) = *(const u32x4*)(xbc + (size_t)r * 768 + 640 + g * 64 + c);
    }
    __syncthreads();
    u32x4 xr[2][2]; float dpre0, dpre1;
    auto head_loads = [&](int h) {
#pragma unroll
      for (int it = 0; it < 2; ++it) {
        const int t = tid + 256 * it, jp = t & 63, pc = t >> 6, j0 = 2 * jp;
        xr[it][0] = *(const u32x4*)(xbc + (size_t)j0 * 768 + h * 64 + pc * 8);
        xr[it][1] = *(const u32x4*)(xbc + (size_t)(j0 + 1) * 768 + h * 64 + pc * 8);
      }
      ssd_dt_load(p, cg_, h, dpre0, dpre1);
    };
    head_loads(g * 4);
#pragma unroll 1
    for (int hh = 0; hh < 4; ++hh) {
      const int h = g * 4 + hh;
      u32x4 hr[2][2];
      {
        const bf16_t* hp = (const bf16_t*)(p.ws + OFF_HP) + (size_t)(cg_ * 8 + h) * 2 * 4096;
#pragma unroll
        for (int it = 0; it < 2; ++it) { const int t = tid + 256 * it, r = t >> 3, c = (t & 7) * 8; hr[it][0] = *(const u32x4*)(hp + r * 64 + c); hr[it][1] = *(const u32x4*)(hp + 4096 + r * 64 + c); }
      }
      __syncthreads();
#pragma unroll
      for (int it = 0; it < 2; ++it) {
        const int t = tid + 256 * it, jp = t & 63, pc = t >> 6, j0 = 2 * jp;
        const u32x4 x0 = xr[it][0], x1 = xr[it][1];
#pragma unroll
        for (int e = 0; e < 4; ++e) {
          const int pr = pc * 8 + 2 * e;
          *(unsigned*)(XT + pr * PITCH128 + j0 * 2) = (x0[e] & 0xffffu) | (x1[e] << 16);
          *(unsigned*)(XT + (pr + 1) * PITCH128 + j0 * 2) = (x0[e] >> 16) | (x1[e] & 0xffff0000u);
        }
        const int r = t >> 3, c = (t & 7) * 8;
        *(u32x4*)(Hf + r * PITCH64 + c * 2) = hr[it][0];
        *(u32x4*)(Hb + r * PITCH64 + c * 2) = hr[it][1];
      }
      ssd_scalars_from(p, l, h, dpre0, dpre1, acf, sb, dtf, dtb);
      __syncthreads();
      if (hh < 3) head_loads(h + 1);
      const float aif = acf[i], aib = sb[i];
      f32x16 Y[2] = {zero16(), zero16()};
      int iv = i, hv = half;
      asm volatile("" : "+v"(iv), "+v"(hv));
      bf16x8 cfr[4];
#pragma unroll
      for (int s = 0; s < 4; ++s) cfr[s] = *(const bf16x8*)(Cs + i * PITCH64 + s * 32 + hv * 16);
      u32x2 xpre[8], zpre[8];
#pragma unroll
      for (int q8 = 0; q8 < 8; ++q8) {
        const int pc = (q8 >> 2) * 32 + 8 * (q8 & 3) + 4 * hv;
        xpre[q8] = *(const u32x2*)(xbc + (size_t)i * 768 + h * 64 + pc);
        zpre[q8] = *(const u32x2*)(proj + (size_t)tok * NPROJP + C_Z + h * 64 + pc);
      }
#pragma unroll 1
      for (int jb = 0; jb < 4; ++jb) {
        f32x16 G = zero16();
#pragma unroll
        for (int s = 0; s < 4; ++s) {
          const bf16x8 a = *(const bf16x8*)(Bs + (jb * 32 + l32) * PITCH64 + s * 32 + hv * 16);
          G = MFMA32(a, cfr[s], G);
        }
        f32x16 m;
#pragma unroll
        for (int q = 0; q < 4; ++q) {
          const int jq = jb * 32 + 8 * q + 4 * hv;
          const f32x4 af4 = *(const f32x4*)(acf + jq), sb4 = *(const f32x4*)(sb + jq), df4 = *(const f32x4*)(dtf + jq), db4 = *(const f32x4*)(dtb + jq);
#pragma unroll
          for (int e = 0; e < 4; ++e) {
            const int j = jq + e;
            const bool lo_ = j < iv;
            const float arg = lo_ ? (aif - af4[e]) : (aib - sb4[e]);
            const float dsel = lo_ ? df4[e] : db4[e];
            float wgt = __expf(arg) * dsel;
            wgt = (j == iv) ? (df4[e] + db4[e]) : wgt;
            m[4 * q + e] = G[4 * q + e] * wgt;
          }
        }
#pragma unroll
        for (int s = 0; s < 2; ++s) {
          u32x4 mf; mf[0] = pk2(m[8 * s], m[8 * s + 1]); mf[1] = pk2(m[8 * s + 2], m[8 * s + 3]); mf[2] = pk2(m[8 * s + 4], m[8 * s + 5]); mf[3] = pk2(m[8 * s + 6], m[8 * s + 7]);
          const bf16x8 mfr = __builtin_bit_cast(bf16x8, mf);
#pragma unroll
          for (int pb = 0; pb < 2; ++pb) {
            const char* xa = XT + (pb * 32 + l32) * PITCH128 + (jb * 32 + 16 * s + 4 * hv) * 2;
            u32x4 av; const u32x2 lo = *(const u32x2*)xa, hi = *(const u32x2*)(xa + 16);
            av[0] = lo[0]; av[1] = lo[1]; av[2] = hi[0]; av[3] = hi[1];
            Y[pb] = MFMA32(__builtin_bit_cast(bf16x8, av), mfr, Y[pb]);
          }
        }
      }
      {
        const float ef = __expf(aif), eb = __expf(aib);
#pragma unroll
        for (int pb = 0; pb < 2; ++pb) {
#pragma unroll
          for (int d = 0; d < 2; ++d) {
            f32x16 tf = zero16();
            const char* Hs = d ? Hb : Hf;
#pragma unroll
            for (int s = 0; s < 4; ++s) {
              const bf16x8 a = *(const bf16x8*)(Hs + (pb * 32 + l32) * PITCH64 + s * 32 + hv * 16);
              tf = MFMA32(a, cfr[s], tf);
            }
            const float ee = d ? eb : ef;
#pragma unroll
            for (int r = 0; r < 16; ++r) Y[pb][r] += ee * tf[r];
          }
        }
      }
      const float Dh = p.in[32][(size_t)l * 8 + h];
#pragma unroll
      for (int pb = 0; pb < 2; ++pb)
#pragma unroll
        for (int q = 0; q < 4; ++q) {
          const int pc = pb * 32 + 8 * q + 4 * half;
          const u32x2 xv = xpre[pb * 4 + q];
          const u32x2 zv = zpre[pb * 4 + q];
          float y[4] = {Y[pb][4 * q] + Dh * bflo(xv[0]), Y[pb][4 * q + 1] + Dh * bfhi(xv[0]), Y[pb][4 * q + 2] + Dh * bflo(xv[1]), Y[pb][4 * q + 3] + Dh * bfhi(xv[1])};
          const float z[4] = {bflo(zv[0]), bfhi(zv[0]), bflo(zv[1]), bfhi(zv[1])};
#pragma unroll
          for (int e = 0; e < 4; ++e) { y[e] *= z[e] / (1.f + __expf(-z[e])); ssq += y[e] * y[e]; }
          u32x2 o; o[0] = pk2(y[0], y[1]); o[1] = pk2(y[2], y[3]);
          *(u32x2*)(mix + (size_t)tok * 1024 + 512 + h * 64 + pc) = o;
        }
    }
  }
  ssq += xor32(ssq);
  sc[512 + i] = ssq;
  __syncthreads();
  ssq += ((const float*)(lds_blk + (1 - g) * HALF_LDS + (2 * 128 * PITCH64 + 64 * PITCH128 + 2 * 64 * PITCH64)))[512 + i];
  const float rstd = rsqrtf(ssq * (1.f / 512.f) + EPS);
  const float* gn = p.in[33] + (size_t)l * 512;
  u32x2 vv[32];
#pragma unroll
  for (int e = 0; e < 32; ++e) {
    const int ch = (g * 4 + (e >> 3)) * 64 + ((e >> 2) & 1) * 32 + 8 * (e & 3) + 4 * half;
    vv[e] = *(const u32x2*)(mix + (size_t)tok * 1024 + 512 + ch);
  }
#pragma unroll
  for (int hq = 0; hq < 4; ++hq) {
    f32x4 gg[8];
#pragma unroll
    for (int e = 0; e < 8; ++e) gg[e] = *(const f32x4*)(gn + (g * 4 + hq) * 64 + (e >> 2) * 32 + 8 * (e & 3) + 4 * half);
#pragma unroll
    for (int e = 0; e < 8; ++e) {
      const int ch = (g * 4 + hq) * 64 + (e >> 2) * 32 + 8 * (e & 3) + 4 * half;
      const u32x2 v = vv[hq * 8 + e];
      u32x2 o; o[0] = pk2(bflo(v[0]) * rstd * gg[e][0], bfhi(v[0]) * rstd * gg[e][1]); o[1] = pk2(bflo(v[1]) * rstd * gg[e][2], bfhi(v[1]) * rstd * gg[e][3]);
      *(u32x2*)(mix + (size_t)tok * 1024 + 512 + ch) = o;
    }
  }
}

struct SeqInfo { int tok0, L, kbase, nk; };
DI SeqInfo seq_info(int s) { SeqInfo r; if (s < 16) { r.tok0 = s * 256; r.L = 256; r.kbase = s * 256; r.nk = 256; } else { r.tok0 = TP + (s - 16) * 2048; r.L = 2048; r.kbase = TP + (s - 16) * 2304; r.nk = 2304; } return r; }

DI void attn_mla_item(const Params& p, int item, char* lds) {
  const int tid = get_tid4(), lane = tid & 63, w = tid >> 6, l32 = lane & 31, half = lane >> 5;
  int seq, head, qb;
  if (item < 256) { seq = 16 + (item >> 6); head = (item >> 4) & 3; qb = item & 15; }
  else { const int it = item - 256; seq = it >> 3; head = (it >> 1) & 3; qb = it & 1; }
  const SeqInfo si = seq_info(seq);
  const int tok = si.tok0 + qb * 128 + w * 32 + l32;
  const bf16_t* qa = (const bf16_t*)(p.ws + OFF_QA) + (size_t)tok * 384 + head * 96;
  bf16x8 qf[6];
#pragma unroll
  for (int s = 0; s < 6; ++s) qf[s] = *(const bf16x8*)(qa + 16 * s + 8 * half);
  constexpr int KT = 64 * PITCH96, VT = 64 * PITCH64;
  char* Ks = lds; char* Vs = lds + 2 * KT;
  const bf16_t* kg = (const bf16_t*)(p.ws + OFF_KA) + (size_t)si.kbase * 384 + head * 96;
  const bf16_t* vg = (const bf16_t*)(p.ws + OFF_VAT) + (size_t)head * 64 * NKEY + si.kbase;
  u32x4 rk[3], rv[2];
  auto gload = [&](int t0) {
#pragma unroll
    for (int i = 0; i < 3; ++i) { const int c = tid + 256 * i, r = c / 12, cc = c % 12; rk[i] = *(const u32x4*)(kg + (size_t)(t0 + r) * 384 + cc * 8); }
#pragma unroll
    for (int i = 0; i < 2; ++i) { const int c = tid + 256 * i, r = c >> 3, cc = c & 7; rv[i] = *(const u32x4*)(vg + (size_t)r * NKEY + t0 + cc * 8); }
  };
  auto lstore = [&](int buf) {
#pragma unroll
    for (int i = 0; i < 3; ++i) { const int c = tid + 256 * i, r = c / 12, cc = c % 12; *(u32x4*)(Ks + buf * KT + r * PITCH96 + cc * 16) = rk[i]; }
#pragma unroll
    for (int i = 0; i < 2; ++i) { const int c = tid + 256 * i, r = c >> 3, cc = c & 7; *(u32x4*)(Vs + buf * VT + r * PITCH64 + cc * 16) = rv[i]; }
  };
  f32x16 O[2] = {zero16(), zero16()};
  float mrun = -1e30f, lsum = 0.f;
  const int nt = si.nk / 64;
  __syncthreads();
  gload(0); lstore(0);
  __syncthreads();
#pragma unroll 1
  for (int t = 0; t < nt; ++t) {
    const int cur = t & 1;
    if (t + 1 < nt) gload((t + 1) * 64);
    f32x16 S[2];
#pragma unroll
    for (int kb = 0; kb < 2; ++kb) {
      S[kb] = zero16();
#pragma unroll
      for (int s = 0; s < 6; ++s) {
        const bf16x8 a = *(const bf16x8*)(Ks + cur * KT + (kb * 32 + l32) * PITCH96 + s * 32 + half * 16);
        S[kb] = MFMA32(a, qf[s], S[kb]);
      }
    }
    float mx = S[0][0];
#pragma unroll
    for (int r = 0; r < 16; ++r) { mx = fmaxf(mx, S[0][r]); mx = fmaxf(mx, S[1][r]); }
    mx = fmaxf(mx, xor32(mx));
    if (__any(mx > mrun + 8.f)) {
      const float mnew = fmaxf(mrun, mx);
      const float alpha = __builtin_amdgcn_exp2f(mrun - mnew);
      mrun = mnew;
      lsum *= alpha;
#pragma unroll
      for (int r = 0; r < 16; ++r) { O[0][r] *= alpha; O[1][r] *= alpha; }
    }
    float ps = 0.f;
#pragma unroll
    for (int kb = 0; kb < 2; ++kb)
#pragma unroll
      for (int r = 0; r < 16; ++r) { const float e = __builtin_amdgcn_exp2f(S[kb][r] - mrun); S[kb][r] = e; ps += e; }
    lsum += ps;
#pragma unroll
    for (int kb = 0; kb < 2; ++kb)
#pragma unroll
      for (int s = 0; s < 2; ++s) {
        u32x4 pf; pf[0] = pk2(S[kb][8 * s], S[kb][8 * s + 1]); pf[1] = pk2(S[kb][8 * s + 2], S[kb][8 * s + 3]); pf[2] = pk2(S[kb][8 * s + 4], S[kb][8 * s + 5]); pf[3] = pk2(S[kb][8 * s + 6], S[kb][8 * s + 7]);
        const bf16x8 pfr = __builtin_bit_cast(bf16x8, pf);
#pragma unroll
        for (int dvb = 0; dvb < 2; ++dvb) {
          const char* va = Vs + cur * VT + (dvb * 32 + l32) * PITCH64 + (kb * 32 + 16 * s + 4 * half) * 2;
          u32x4 av; const u32x2 lo = *(const u32x2*)va, hi = *(const u32x2*)(va + 16);
          av[0] = lo[0]; av[1] = lo[1]; av[2] = hi[0]; av[3] = hi[1];
          O[dvb] = MFMA32(__builtin_bit_cast(bf16x8, av), pfr, O[dvb]);
        }
      }
    if (t + 1 < nt) lstore(cur ^ 1);
    __syncthreads();
  }
  lsum += xor32(lsum);
  const float inv = 1.f / lsum;
  bf16_t* mix = (bf16_t*)(p.ws + OFF_MIX) + (size_t)tok * 1024 + head * 64;
#pragma unroll
  for (int dvb = 0; dvb < 2; ++dvb) {
#pragma unroll
    for (int r = 0; r < 16; ++r) O[dvb][r] *= inv;
    store_block_bf16(mix + dvb * 32, O[dvb], half);
  }
}

constexpr int PITCH32 = 80;
DI void attn_diff_item(const Params& p, int l, int item, char* lds_blk) {
  const int tid = get_tid4(), lane = tid & 63, w = tid >> 6, l32 = lane & 31, half = lane >> 5;
  const int hbk = get_hb();
  char* lds = lds_blk + hbk * HALF_LDS;
  int seq, head, qb;
  if (item < 256) { seq = 16 + (item >> 6); head = (item >> 4) & 3; qb = item & 15; }
  else { const int it = item - 256; seq = it >> 3; head = (it >> 1) & 3; qb = it & 1; }
  const SeqInfo si = seq_info(seq);
  const int tok = si.tok0 + qb * 128 + w * 32 + l32;
  constexpr int KT = 64 * PITCH32, VT = 64 * PITCH64;
  char* Ks = lds; char* Vs = lds + 2 * KT;
  const bf16_t* vg = (const bf16_t*)(p.ws + OFF_VDT) + (size_t)head * 64 * NKEY + si.kbase;
  const int nt = si.nk / 64;
  const float lam_init = ((const float*)(p.ws + OFF_LAM))[l * 2 + 1];
  const float lam = ((const float*)(p.ws + OFF_LAM))[l * 2];
  f32x16 R[2] = {zero16(), zero16()};
#pragma unroll 1
  for (int mp = hbk; mp < hbk + 1; ++mp) {
    const bf16_t* qd = (const bf16_t*)(p.ws + OFF_QD) + (size_t)tok * 256 + head * 64 + mp * 32;
    bf16x8 qf[2];
#pragma unroll
    for (int s = 0; s < 2; ++s) qf[s] = *(const bf16x8*)(qd + 16 * s + 8 * half);
    const bf16_t* kg = (const bf16_t*)(p.ws + OFF_KD) + (size_t)si.kbase * 256 + head * 64 + mp * 32;
    u32x4 rk, rv[2];
    auto gload = [&](int t0) {
      rk = *(const u32x4*)(kg + (size_t)(t0 + (tid >> 2)) * 256 + (tid & 3) * 8);
#pragma unroll
      for (int i = 0; i < 2; ++i) { const int c = tid + 256 * i, r = c >> 3, cc = c & 7; rv[i] = *(const u32x4*)(vg + (size_t)r * NKEY + t0 + cc * 8); }
    };
    auto lstore = [&](int buf) {
      *(u32x4*)(Ks + buf * KT + (tid >> 2) * PITCH32 + (tid & 3) * 16) = rk;
#pragma unroll
      for (int i = 0; i < 2; ++i) { const int c = tid + 256 * i, r = c >> 3, cc = c & 7; *(u32x4*)(Vs + buf * VT + r * PITCH64 + cc * 16) = rv[i]; }
    };
    f32x16 O[2] = {zero16(), zero16()};
    float mrun = -1e30f, lsum = 0.f;
    __syncthreads();
    gload(0); lstore(0);
    __syncthreads();
#pragma unroll 1
    for (int t = 0; t < nt; ++t) {
      const int cur = t & 1;
      if (t + 1 < nt) gload((t + 1) * 64);
      f32x16 S[2];
#pragma unroll
      for (int kb = 0; kb < 2; ++kb) {
        S[kb] = zero16();
#pragma unroll
        for (int s = 0; s < 2; ++s) {
          const bf16x8 a = *(const bf16x8*)(Ks + cur * KT + (kb * 32 + l32) * PITCH32 + s * 32 + half * 16);
          S[kb] = MFMA32(a, qf[s], S[kb]);
        }
      }
      float mx = S[0][0];
#pragma unroll
      for (int r = 0; r < 16; ++r) { mx = fmaxf(mx, S[0][r]); mx = fmaxf(mx, S[1][r]); }
      mx = fmaxf(mx, xor32(mx));
      if (__any(mx > mrun + 8.f)) {
        const float mnew = fmaxf(mrun, mx);
        const float alpha = __builtin_amdgcn_exp2f(mrun - mnew);
        mrun = mnew;
        lsum *= alpha;
#pragma unroll
        for (int r = 0; r < 16; ++r) { O[0][r] *= alpha; O[1][r] *= alpha; }
      }
      float ps = 0.f;
#pragma unroll
      for (int kb = 0; kb < 2; ++kb)
#pragma unroll
        for (int r = 0; r < 16; ++r) { const float e = __builtin_amdgcn_exp2f(S[kb][r] - mrun); S[kb][r] = e; ps += e; }
      lsum += ps;
#pragma unroll
      for (int kb = 0; kb < 2; ++kb)
#pragma unroll
        for (int s = 0; s < 2; ++s) {
          u32x4 pf; pf[0] = pk2(S[kb][8 * s], S[kb][8 * s + 1]); pf[1] = pk2(S[kb][8 * s + 2], S[kb][8 * s + 3]); pf[2] = pk2(S[kb][8 * s + 4], S[kb][8 * s + 5]); pf[3] = pk2(S[kb][8 * s + 6], S[kb][8 * s + 7]);
          const bf16x8 pfr = __builtin_bit_cast(bf16x8, pf);
#pragma unroll
          for (int dvb = 0; dvb < 2; ++dvb) {
            const char* va = Vs + cur * VT + (dvb * 32 + l32) * PITCH64 + (kb * 32 + 16 * s + 4 * half) * 2;
            u32x4 av; const u32x2 lo = *(const u32x2*)va, hi = *(const u32x2*)(va + 16);
            av[0] = lo[0]; av[1] = lo[1]; av[2] = hi[0]; av[3] = hi[1];
            O[dvb] = MFMA32(__builtin_bit_cast(bf16x8, av), pfr, O[dvb]);
          }
        }
      if (t + 1 < nt) lstore(cur ^ 1);
      __syncthreads();
    }
    lsum += xor32(lsum);
    const float coef = (mp == 0) ? 1.f / lsum : -lam / lsum;
#pragma unroll
    for (int dvb = 0; dvb < 2; ++dvb)
#pragma unroll
      for (int r = 0; r < 16; ++r) R[dvb][r] += O[dvb][r] * coef;
  }
  {
    constexpr int XO = 32768;
    float* xo = (float*)(lds + XO);
    if (hbk == 1) {
#pragma unroll
      for (int dvb = 0; dvb < 2; ++dvb)
#pragma unroll
        for (int r = 0; r < 16; ++r) xo[((w * 2 + dvb) * 16 + r) * 64 + lane] = R[dvb][r];
    }
    __syncthreads();
    if (hbk == 1) return;
    const float* xi = (const float*)(lds_blk + HALF_LDS + XO);
#pragma unroll
    for (int dvb = 0; dvb < 2; ++dvb)
#pragma unroll
      for (int r = 0; r < 16; ++r) R[dvb][r] += xi[((w * 2 + dvb) * 16 + r) * 64 + lane];
  }
  float ss = sumsq16(R[0]) + sumsq16(R[1]);
  ss += xor32(ss);
  const float rstd = rsqrtf(ss * (1.f / 64.f) + EPS) * (1.f - lam_init);
  const float* gs = p.in[27] + (size_t)l * 64;
  bf16_t* mix = (bf16_t*)(p.ws + OFF_MIX) + (size_t)tok * 1024 + 256 + head * 64;
#pragma unroll
  for (int dvb = 0; dvb < 2; ++dvb) {
    { const f32x16 gb = gain_block(gs + dvb * 32, half);
#pragma unroll
      for (int r = 0; r < 16; ++r) R[dvb][r] *= rstd * gb[r]; }
    store_block_bf16(mix + dvb * 32, R[dvb], half);
  }
}

DI void run_phase(const Params& p, int ph, char* lds, int* s_item, int vb) {
#ifdef ONLY_SUB
  const int l = (ph - 1) / 10, sub = ONLY_SUB;
  if (ONLY_SUB == 10) { setup_phase(p, lds); return; }
#else
  if (ph == 0) { setup_phase(p, lds); return; }
  const int l = (ph - 1) / 10, sub = (ph - 1) % 10;
#endif
  const float* modl = (const float*)(p.ws + OFF_MOD) + (size_t)l * 5 * 6144;
  switch (sub) {
    case 0: norm_phase(p, l, 0); break;
    case 1: {
      EpiInProj epi{(bf16_t*)(p.ws + OFF_PROJ), (float*)(p.ws + OFF_DT)};
      const bf16_t* A = (const bf16_t*)(p.ws + OFF_HBUF);
      const bf16_t* Bt = (const bf16_t*)(p.ws + OFF_WIN) + (size_t)l * NPROJP * 1024;
      gemm_phase<256>(A, 1024, Bt, 1024, 1024, 48, 10, lds, vb, epi);
    } break;
    case 2: prep_phase(p, l, lds); break;
    case 3: {
      const int hb = get_hb();
      for (int pair = blockIdx.x; pair < NCHUNK * 4; pair += gridDim.x) ssd_states_item(p, l, pair * 2 + hb, lds + hb * HALF_LDS);
    } break;
    case 4: ssd_scan_phase(p, l); break;
    case 5: {
      unsigned* ctr = (unsigned*)(p.ws + OFF_CTR) + l;
      const int hb = get_hb();
      for (;;) {
        __syncthreads();
        if (threadIdx.x == 0) *s_item = (int)atomicAdd(ctr, 1u);
        __syncthreads();
        const int it = *s_item;
        if (it >= 672) break;
        if (it < 96) ssd_y_item(p, l, it, lds);
        else if (it < 224) attn_mla_item(p, (it - 96) * 2 + hb, lds + hb * HALF_LDS);
        else if (it < 480) attn_diff_item(p, l, it - 224, lds);
        else if (it < 544) attn_mla_item(p, 256 + (it - 480) * 2 + hb, lds + hb * HALF_LDS);
        else attn_diff_item(p, l, 256 + (it - 544), lds);
      }
    } break;
    case 6: {
      EpiResid epi{l == 0 ? p.in[0] : nullptr, l == 0 ? p.in[1] : nullptr, (bf16_t*)(p.ws + OFF_XB), nullptr, modl + 2048};
      const bf16_t* A = (const bf16_t*)(p.ws + OFF_MIX);
      const bf16_t* Bt = (const bf16_t*)(p.ws + OFF_WOUT) + (size_t)l * 1024 * 1024;
      gemm_phase<192>(A, 1024, Bt, 1024, 1024, 64, 4, lds, vb, epi);
    } break;
    case 7: norm_phase(p, l, 1); break;
    case 8: {
      EpiFF1 epi{(bf16_t*)(p.ws + OFF_UBUF)};
      const bf16_t* A = (const bf16_t*)(p.ws + OFF_HBUF);
      const bf16_t* Bt = (const bf16_t*)(p.ws + OFF_WFF1) + (size_t)l * 4096 * 1024;
      gemm_phase<256>(A, 1024, Bt, 1024, 1024, 48, 16, lds, vb, epi);
    } break;
    case 9: {
      EpiResid epi{nullptr, nullptr, (bf16_t*)(p.ws + OFF_XB), l == DEPTH - 1 ? p.out : nullptr, modl + 5120};
      const bf16_t* A = (const bf16_t*)(p.ws + OFF_UBUF);
      const bf16_t* Bt = (const bf16_t*)(p.ws + OFF_WFF2) + (size_t)l * 1024 * 4096;
      gemm_phase<192>(A, 4096, Bt, 4096, 4096, 64, 4, lds, vb, epi);
    } break;
  }
}

constexpr int N_PHASES = 1 + 10 * DEPTH;

__global__ void __launch_bounds__(512, 2) fwd_megakernel(Params p) {
  __shared__ __attribute__((aligned(1024))) char lds[LDS_BYTES + 64];
  uint4& xb_words = *(uint4*)(lds + LDS_BYTES);
  int* s_item = (int*)(lds + LDS_BYTES + 16);
  if (p.ph_end - p.ph_begin == 1) { run_phase(p, p.ph_begin, lds, s_item, blockIdx.x); return; }
  if (p.ph_begin < 0) { cg::this_grid().sync(); return; }
  if (threadIdx.x == 0) xb_words = make_uint4(0u, 0u, 0u, 0u);
  __syncthreads();
  XcdBarrier b = xcd_barrier_post((unsigned*)(p.ws + OFF_BAR), (volatile LAS unsigned*)&xb_words);
  const int vb = blockIdx.x;
  for (int ph = p.ph_begin; ph < p.ph_end; ++ph) {
    run_phase(p, ph, lds, s_item, vb);
    if (ph + 1 < p.ph_end) xcd_barrier(b);
  }
}

extern "C" void kernel_launch(void* const* d_in, const int* in_sizes, int n_in, void* d_out, int out_size, void* d_ws, size_t ws_size, hipStream_t stream) {
  static int grid_blocks = 0;
  if (!grid_blocks) {
    int dev = 0, cus = 0, per_cu = 0;
    (void)hipGetDevice(&dev);
    (void)hipDeviceGetAttribute(&cus, hipDeviceAttributeMultiprocessorCount, dev);
    (void)hipOccupancyMaxActiveBlocksPerMultiprocessor(&per_cu, fwd_megakernel, 512, 0);
    if (per_cu > 1) per_cu = 1;
    if (per_cu < 1) per_cu = 1;
    grid_blocks = cus * per_cu;
  }
  Params p{};
  for (int i = 0; i < 36; ++i) p.in[i] = (const float*)d_in[i];
  p.out = (float*)d_out;
  p.ws = (char*)d_ws;
  (void)hipMemsetAsync(d_ws, 0, 16384, stream);
#if MULTI_LAUNCH
  for (int ph = 0; ph < N_PHASES; ++ph) {
    p.ph_begin = ph; p.ph_end = ph + 1;
    hipLaunchKernelGGL(fwd_megakernel, dim3(grid_blocks), dim3(512), 0, stream, p);
  }
#else
  p.ph_begin = 0; p.ph_end = N_PHASES;
  void* args[] = {&p};
  hipError_t e = hipLaunchCooperativeKernel((void*)fwd_megakernel, dim3(grid_blocks), dim3(512), args, 0, stream);
  if (e != hipSuccess) fprintf(stderr, "cooperative launch failed: %s (grid %d)\n", hipGetErrorString(e), grid_blocks);
#endif
}
```

```cpp
#include <hip/hip_runtime.h>
#include <hip/hip_cooperative_groups.h>
#include <stdint.h>
#include <stdio.h>
namespace cg = cooperative_groups;

#ifndef MULTI_LAUNCH
#define MULTI_LAUNCH 0
#endif

#define DI __device__ __forceinline__
#define LAS __attribute__((address_space(3)))
typedef unsigned short bf16_t;
typedef short bf16x8 __attribute__((ext_vector_type(8)));
typedef short s16x4 __attribute__((ext_vector_type(4)));
typedef float f32x16 __attribute__((ext_vector_type(16)));
typedef float f32x4 __attribute__((ext_vector_type(4)));
typedef unsigned u32x4 __attribute__((ext_vector_type(4)));
typedef unsigned u32x2 __attribute__((ext_vector_type(2)));
#define MFMA32(a, b, c) __builtin_amdgcn_mfma_f32_32x32x16_bf16((a), (b), (c), 0, 0, 0)

constexpr int D = 1024, TP = 4096, TS = 8192, T = 12288, DEPTH = 4, PAST = 256;
constexpr int NPROJ = 2480, NPROJP = 2560, DFF = 4096;
constexpr int NKEY = 4096 + 4 * 2304;
constexpr int C_CQ = 0, C_CKV = 256, C_KR = 384, C_DQ = 416, C_DK = 672, C_DV = 928, C_Z = 1184, C_XBC = 1696, C_DT = 2464;
constexpr float EPS = 1e-6f;
constexpr int NCHUNK = 96;

constexpr size_t O_Y = 0, O_CKV = 12582912, O_KROPE = 14680064, O_DK = 15204352, O_DV = 19398656, O_SSM = 23592960;

constexpr size_t OFF_BAR = 0;
constexpr size_t OFF_XRANK = 14080;
constexpr size_t OFF_CTR = 14336;
constexpr size_t OFF_LAM = 15360;
constexpr size_t OFF_MOD = 16384;
constexpr size_t OFF_ROPE = OFF_MOD + 4ull * 5 * 6144 * 4;
constexpr size_t OFF_WIN = OFF_ROPE + 2048ull * 32 * 4;
constexpr size_t OFF_WOUT = OFF_WIN + 4ull * NPROJP * 1024 * 2;
constexpr size_t OFF_WFF1 = OFF_WOUT + 4ull * 1024 * 1024 * 2;
constexpr size_t OFF_WFF2 = OFF_WFF1 + 4ull * 4096 * 1024 * 2;
constexpr size_t OFF_WUQ = OFF_WFF2 + 4ull * 4096 * 1024 * 2;
constexpr size_t OFF_WUKV = OFF_WUQ + 4ull * 384 * 256 * 2;
constexpr size_t OFF_HBUF = OFF_WUKV + 4ull * 512 * 128 * 2;
constexpr size_t OFF_MIX = OFF_HBUF + (size_t)T * 1024 * 2;
constexpr size_t OFF_DT = OFF_MIX + (size_t)T * 1024 * 2;
constexpr size_t OFF_R = OFF_DT + (size_t)T * 16 * 4;
constexpr size_t OFF_UBUF = OFF_R;
constexpr size_t OFF_PROJ = OFF_R;
constexpr size_t OFF_QA = OFF_PROJ + (size_t)T * NPROJP * 2;
constexpr size_t OFF_KA = OFF_QA + (size_t)T * 384 * 2;
constexpr size_t OFF_VAT = OFF_KA + (size_t)NKEY * 384 * 2;
constexpr size_t OFF_QD = OFF_VAT + 256ull * NKEY * 2;
constexpr size_t OFF_KD = OFF_QD + (size_t)T * 256 * 2;
constexpr size_t OFF_VDT = OFF_KD + (size_t)NKEY * 256 * 2;
constexpr size_t OFF_XBC = OFF_VDT + 256ull * NKEY * 2;
constexpr size_t OFF_ST = OFF_XBC + (size_t)T * 768 * 2;
constexpr size_t OFF_HP = OFF_ST + 96ull * 8 * 2 * 4096 * 4;
constexpr size_t OFF_CDEC = OFF_HP + 96ull * 8 * 2 * 4096 * 2;
constexpr size_t OFF_XB = OFF_CDEC + 96ull * 16 * 4;
constexpr size_t WS_END = OFF_XB + (size_t)T * 1024 * 2;

struct Params {
  const float* in[36];
  float* out;
  char* ws;
  int ph_begin, ph_end;
};

DI unsigned pk2(float lo, float hi) { unsigned r; asm("v_cvt_pk_bf16_f32 %0, %1, %2" : "=v"(r) : "v"(lo), "v"(hi)); return r; }
DI float bflo(unsigned u) { return __uint_as_float(u << 16); }
DI float bfhi(unsigned u) { return __uint_as_float(u & 0xffff0000u); }
DI float bf1(bf16_t h) { return __uint_as_float(((unsigned)h) << 16); }
DI bf16_t f2bf(float x) { return (bf16_t)(pk2(x, 0.f) & 0xffffu); }
DI int crow(int r, int half) { return (r & 3) + 8 * (r >> 2) + 4 * half; }
DI float xor32(float v) { return __shfl_xor(v, 32); }
DI float wave_sum(float v) {
#pragma unroll
  for (int o = 32; o > 0; o >>= 1) v += __shfl_xor(v, o);
  return v;
}
DI f32x16 zero16() { f32x16 z; for (int i = 0; i < 16; ++i) z[i] = 0.f; return z; }
DI int get_tid() { int t = threadIdx.x; asm volatile("" : "+v"(t)); return t; }
DI int get_tid4() { return get_tid() & 255; }
DI int get_hb() { return get_tid() >> 8; }
DI int modrow_of(int m) { return m < TP ? 0 : 1 + ((m - TP) >> 11); }

#define XB_TMO      128
#define XB_XCNT(j)  (256  + 64 * (j))
#define XB_XSUB(j)  (1280 + 64 * (j))
#define XB_XGEN(j)  (2304 + 64 * (j))
#define XB_TOP      3328
#define XB_TOPGEN   3392
#define XCD_BAR_WORDS 3456
#define XB_SPIN_CAP (1u << 22)
DI unsigned xb_ld(unsigned* p) { return __hip_atomic_load(p, __ATOMIC_RELAXED, __HIP_MEMORY_SCOPE_AGENT); }
DI unsigned xb_add(unsigned* p, unsigned v) { return __hip_atomic_fetch_add(p, v, __ATOMIC_RELAXED, __HIP_MEMORY_SCOPE_AGENT); }
DI unsigned xb_xcc_id() { return (unsigned)__builtin_amdgcn_s_getreg((3 << 11) | 20) & 0xFu; }
#define XB_SPIN(cond, bar) do { unsigned _sp = 0; while (cond) { __builtin_amdgcn_s_sleep(1); \
    if ((++_sp & 255u) == 0u) { if (xb_ld(&(bar)[XB_TMO])) break; if (_sp > XB_SPIN_CAP) { atomicAdd(&(bar)[XB_TMO], 1u); break; } } } } while (0)
struct XcdBarrier { unsigned* bar; unsigned x; volatile LAS unsigned* st; };
DI XcdBarrier xcd_barrier_post(unsigned* bar, volatile LAS unsigned* st) {
  XcdBarrier b; b.bar = bar; b.x = xb_xcc_id(); b.st = st;
  if (threadIdx.x == 0) (void)xb_add(&bar[XB_XCNT(b.x)], 1u);
  return b;
}
DI void xcd_barrier_complete(unsigned* bar, unsigned x, unsigned& nloc, unsigned& nx) {
  const unsigned G = gridDim.x * gridDim.y * gridDim.z;
  unsigned sum, cnt, mine, sp = 0u;
  for (;;) {
    sum = 0u; cnt = 0u; mine = 0u;
#pragma unroll
    for (unsigned j = 0; j < 16; ++j) { const unsigned c = xb_ld(&bar[XB_XCNT(j)]); sum += c; cnt += (c > 0u) ? 1u : 0u; mine = (j == x) ? c : mine; }
    if (sum == G) break;
    __builtin_amdgcn_s_sleep(1);
    if ((++sp & 255u) == 0u) { if (xb_ld(&bar[XB_TMO])) break; if (sp > XB_SPIN_CAP) { atomicAdd(&bar[XB_TMO], 1u); break; } }
  }
  nloc = mine > 0u ? mine : 1u; nx = cnt > 0u ? cnt : 1u;
}
DI void xcd_barrier(const XcdBarrier& b) {
  asm volatile("s_waitcnt vmcnt(0)" ::: "memory");
  __syncthreads();
  if (threadIdx.x == 0) {
    unsigned* bar = b.bar;
    __builtin_amdgcn_s_waitcnt(0);
    unsigned nloc = b.st[0], nx = b.st[1];
    if (nloc == 0u) { xcd_barrier_complete(bar, b.x, nloc, nx); b.st[0] = nloc; b.st[1] = nx; }
    const unsigned old = xb_add(&bar[XB_XSUB(b.x)], 1u);
    const unsigned gen = old / nloc;
    if (old + 1u == (gen + 1u) * nloc) {
      __builtin_amdgcn_fence(__ATOMIC_RELEASE, "agent");
      asm volatile("s_waitcnt vmcnt(0)" ::: "memory");
      const unsigned og = xb_add(&bar[XB_TOP], 1u);
      const unsigned tg = og / nx;
      if (og + 1u == (tg + 1u) * nx) xb_add(&bar[XB_TOPGEN], 1u);
      else XB_SPIN(xb_ld(&bar[XB_TOPGEN]) == tg, bar);
      __builtin_amdgcn_fence(__ATOMIC_ACQUIRE, "agent");
      xb_add(&bar[XB_XGEN(b.x)], 1u);
      asm volatile("s_waitcnt vmcnt(0)" ::: "memory");
    } else {
      XB_SPIN(xb_ld(&bar[XB_XGEN(b.x)]) == gen, bar);
      __builtin_amdgcn_fence(__ATOMIC_ACQUIRE, "agent");
      asm volatile("s_waitcnt vmcnt(0)" ::: "memory");
    }
  }
  __syncthreads();
}

constexpr int HALF_LDS = 75776;
constexpr int LDS_BYTES = 2 * HALF_LDS;
constexpr int PITCH64 = 144;
constexpr int PITCH128 = 272;
constexpr int PITCH96 = 208;

DI void transpose_tile4(const float* src, int K, int N, bf16_t* dst, int t0, int ncols, char* lds) {
  float* tile = (float*)lds;
  const int tid = get_tid4();
  f32x4 v[4][4];
#pragma unroll
  for (int q = 0; q < 4; ++q) {
    const int k0 = ((t0 + q) / ncols) * 64, n0 = ((t0 + q) % ncols) * 64;
#pragma unroll
    for (int i = 0; i < 4; ++i) {
      const int r = (tid >> 4) + 16 * i, c4 = (tid & 15) * 4;
      v[q][i] = (f32x4){0.f, 0.f, 0.f, 0.f};
      if (n0 + c4 < N) v[q][i] = *(const f32x4*)(src + (size_t)(k0 + r) * N + n0 + c4);
    }
  }
  __syncthreads();
#pragma unroll
  for (int q = 0; q < 4; ++q)
#pragma unroll
    for (int i = 0; i < 4; ++i) {
      const int r = (tid >> 4) + 16 * i, c4 = (tid & 15) * 4;
      float* t = tile + q * (64 * 65) + r * 65 + c4;
      t[0] = v[q][i][0]; t[1] = v[q][i][1]; t[2] = v[q][i][2]; t[3] = v[q][i][3];
    }
  __syncthreads();
#pragma unroll
  for (int q = 0; q < 4; ++q) {
    const int k0 = ((t0 + q) / ncols) * 64, n0 = ((t0 + q) % ncols) * 64;
    const float* tq = tile + q * (64 * 65);
#pragma unroll
    for (int i = 0; i < 2; ++i) {
      const int n = (tid >> 3) + 32 * i, kc = (tid & 7) * 8;
      u32x4 w;
      w[0] = pk2(tq[(kc + 0) * 65 + n], tq[(kc + 1) * 65 + n]);
      w[1] = pk2(tq[(kc + 2) * 65 + n], tq[(kc + 3) * 65 + n]);
      w[2] = pk2(tq[(kc + 4) * 65 + n], tq[(kc + 5) * 65 + n]);
      w[3] = pk2(tq[(kc + 6) * 65 + n], tq[(kc + 7) * 65 + n]);
      *(u32x4*)(dst + (size_t)(n0 + n) * K + k0 + kc) = w;
    }
  }
}

DI void mod_item(const Params& p, int item, char* lds) {
  float* sc = (float*)lds;
  float* red = sc + 5 * 1024;
  const int tid = get_tid4(), lane = tid & 63, w = tid >> 6;
  const int l = item / 96, j0 = (item % 96) * 64;
  __syncthreads();
  for (int i = tid; i < 5 * 1024; i += 256) {
    const int r = i >> 10, k = i & 1023;
    const float v = (r == 0) ? p.in[8][k] : p.in[7][(r - 1) * 1024 + k];
    sc[i] = v / (1.f + __expf(-v));
  }
  __syncthreads();
  const float* W = p.in[11] + (size_t)l * 1024 * 6144 + j0 + lane;
  float a0 = 0.f, a1 = 0.f, a2 = 0.f, a3 = 0.f, a4 = 0.f;
  const int kb = w * 256;
#pragma unroll 32
  for (int k = 0; k < 256; ++k) {
    const float wv = W[(size_t)(kb + k) * 6144];
    a0 += sc[kb + k] * wv; a1 += sc[1024 + kb + k] * wv; a2 += sc[2048 + kb + k] * wv; a3 += sc[3072 + kb + k] * wv; a4 += sc[4096 + kb + k] * wv;
  }
  red[(w * 5 + 0) * 64 + lane] = a0; red[(w * 5 + 1) * 64 + lane] = a1; red[(w * 5 + 2) * 64 + lane] = a2;
  red[(w * 5 + 3) * 64 + lane] = a3; red[(w * 5 + 4) * 64 + lane] = a4;
  __syncthreads();
  for (int i = tid; i < 320; i += 256) {
    const int r = i / 64, c = i % 64;
    const float s = red[(0 * 5 + r) * 64 + c] + red[(1 * 5 + r) * 64 + c] + red[(2 * 5 + r) * 64 + c] + red[(3 * 5 + r) * 64 + c];
    float* mod = (float*)(p.ws + OFF_MOD);
    mod[((size_t)l * 5 + r) * 6144 + j0 + c] = s + p.in[12][(size_t)l * 6144 + j0 + c];
  }
}

DI void setup_phase(const Params& p, char* lds) {
  constexpr int N_IN = 16 * 40 / 4, N_OUT = 16 * 16 / 4, N_F1 = 16 * 64 / 4, N_F2 = 64 * 16 / 4, N_UQ = 4 * 6 / 4, N_UKV = 2 * 8 / 4;
  constexpr int PER_L = N_IN + N_OUT + N_F1 + N_F2 + N_UQ + N_UKV;
  constexpr int N_TR = PER_L * 4, N_MOD = 384, N_ROPE = 64;
  static_assert((N_MOD + N_TR) % 2 == 0, "pairing");
  if (blockIdx.x == 0 && get_tid() < 4) {
    const int l = get_tid();
    float d1 = 0.f, d2 = 0.f;
    for (int k = 0; k < 32; ++k) { d1 += p.in[23][l * 32 + k] * p.in[24][l * 32 + k]; d2 += p.in[25][l * 32 + k] * p.in[26][l * 32 + k]; }
    const float lam_init = 0.8f - 0.6f * expf(-0.3f * (float)l);
    float* lamp = (float*)(p.ws + OFF_LAM);
    lamp[l * 2] = expf(d1) - expf(d2) + lam_init; lamp[l * 2 + 1] = lam_init;
  }
  const int hb = get_hb();
  lds += hb * HALF_LDS;
  for (int pair = blockIdx.x; pair < (N_MOD + N_TR) / 2; pair += gridDim.x) {
    const int item = pair * 2 + hb;
    if (item < N_MOD) { mod_item(p, item, lds); continue; }
    int it = item - N_MOD;
    {
      const int l = it / PER_L; int r = it % PER_L;
      if (r < N_IN) { transpose_tile4(p.in[13] + (size_t)l * 1024 * NPROJ, 1024, NPROJ, (bf16_t*)(p.ws + OFF_WIN) + (size_t)l * NPROJP * 1024, r * 4, 40, lds); continue; }
      r -= N_IN;
      if (r < N_OUT) { transpose_tile4(p.in[14] + (size_t)l * 1024 * 1024, 1024, 1024, (bf16_t*)(p.ws + OFF_WOUT) + (size_t)l * 1024 * 1024, r * 4, 16, lds); continue; }
      r -= N_OUT;
      if (r < N_F1) { transpose_tile4(p.in[34] + (size_t)l * 1024 * 4096, 1024, 4096, (bf16_t*)(p.ws + OFF_WFF1) + (size_t)l * 4096 * 1024, r * 4, 64, lds); continue; }
      r -= N_F1;
      if (r < N_F2) { transpose_tile4(p.in[35] + (size_t)l * 4096 * 1024, 4096, 1024, (bf16_t*)(p.ws + OFF_WFF2) + (size_t)l * 1024 * 4096, r * 4, 16, lds); continue; }
      r -= N_F2;
      if (r < N_UQ) { transpose_tile4(p.in[17] + (size_t)l * 256 * 384, 256, 384, (bf16_t*)(p.ws + OFF_WUQ) + (size_t)l * 384 * 256, r * 4, 6, lds); continue; }
      r -= N_UQ;
      transpose_tile4(p.in[18] + (size_t)l * 128 * 512, 128, 512, (bf16_t*)(p.ws + OFF_WUKV) + (size_t)l * 512 * 128, r * 4, 8, lds);
    }
  }
  for (int it = blockIdx.x; it < N_ROPE; it += gridDim.x) {
    {
      const int idx = it * 512 + get_tid();
      const int pos = idx >> 4, j = idx & 15;
      const float fr = __builtin_amdgcn_exp2f(-(float)(j & 7) * (13.287712379549449f / 8.f));
      const float base = (j < 8) ? (float)(pos >> 6) : (float)(pos & 63);
      float rev = base * fr * 0.15915494309189535f;
      rev -= floorf(rev);
      float* tab = (float*)(p.ws + OFF_ROPE);
      tab[idx * 2 + 0] = __builtin_amdgcn_cosf(rev);
      tab[idx * 2 + 1] = __builtin_amdgcn_sinf(rev);
    }
  }
}

DI const float* x_row_in(const Params& p, int l, int m) {
  if (l == 0) return m < TP ? p.in[0] + (size_t)m * D : p.in[1] + (size_t)(m - TP) * D;
  return p.out + (size_t)m * D;
}
DI void norm_phase(const Params& p, int l, int which) {
  const int tid = get_tid(), lane = tid & 63, w = tid >> 6;
  const float* g = p.in[which == 0 ? 9 : 10] + (size_t)l * D;
  const float* modl = (const float*)(p.ws + OFF_MOD) + (size_t)l * 5 * 6144;
  bf16_t* hbuf = (bf16_t*)(p.ws + OFF_HBUF);
  constexpr int RW = 6;
  for (int item = blockIdx.x; item < T / (8 * RW); item += gridDim.x) {
    const int m0 = item * 8 * RW + w * RW;
    f32x4 v[RW][4];
#pragma unroll
    for (int rr = 0; rr < RW; ++rr) {
      if (which == 0 && l == 0) {
        const float* x = x_row_in(p, 0, m0 + rr);
#pragma unroll
        for (int i = 0; i < 4; ++i) v[rr][i] = *(const f32x4*)(x + i * 256 + lane * 4);
      } else {
        const bf16_t* x = (const bf16_t*)(p.ws + OFF_XB) + (size_t)(m0 + rr) * D;
#pragma unroll
        for (int i = 0; i < 4; ++i) { const u32x2 r = *(const u32x2*)(x + i * 256 + lane * 4); v[rr][i] = (f32x4){bflo(r[0]), bfhi(r[0]), bflo(r[1]), bfhi(r[1])}; }
      }
    }
    f32x4 gg[4];
#pragma unroll
    for (int i = 0; i < 4; ++i) gg[i] = *(const f32x4*)(g + i * 256 + lane * 4);
#pragma unroll
    for (int rr = 0; rr < RW; ++rr) {
      const int m = m0 + rr;
      const float* mod = modl + (size_t)modrow_of(m) * 6144 + (which == 0 ? 0 : 3072);
      float ss = 0.f;
#pragma unroll
      for (int i = 0; i < 4; ++i) ss += v[rr][i][0] * v[rr][i][0] + v[rr][i][1] * v[rr][i][1] + v[rr][i][2] * v[rr][i][2] + v[rr][i][3] * v[rr][i][3];
      ss = wave_sum(ss);
      const float rstd = rsqrtf(ss * (1.f / D) + EPS);
#pragma unroll
      for (int i = 0; i < 4; ++i) {
        const int c = i * 256 + lane * 4;
        const f32x4 sh = *(const f32x4*)(mod + c), scl = *(const f32x4*)(mod + 1024 + c);
        float o[4];
#pragma unroll
        for (int e = 0; e < 4; ++e) o[e] = v[rr][i][e] * rstd * gg[i][e] * (1.f + scl[e]) + sh[e];
        u32x2 wv; wv[0] = pk2(o[0], o[1]); wv[1] = pk2(o[2], o[3]);
        *(u32x2*)(hbuf + (size_t)m * D + c) = wv;
      }
    }
  }
}

DI int lds_byte2(int r, int c) { const int st = (r >> 4) * 2 + (c >> 5), ob = (r & 15) * 64 + (c & 31) * 2; return st * 1024 + (ob ^ (((ob >> 9) & 1) << 5)); }
DI void stage_rc2(int b, int& R, int& C) { const int st = b >> 10, sb = b & 1023, swz = sb ^ (((sb >> 9) & 1) << 5); R = (st >> 1) * 16 + swz / 64; C = (st & 1) * 32 + (swz % 64) / 2; }
#define WAIT_V0() asm volatile("s_waitcnt vmcnt(0)" ::: "memory")
DI bool unit_next(int vb, int i, int nM, int nN, int& pm, int& pn) {
  const int nwg = nM * nN;
  const long L = (long)i * gridDim.x + vb; if (L >= nwg) return false;
  int wgid = (int)L; { const int q = nwg / 8, r = nwg % 8, xcd = wgid % 8, off = wgid / 8; wgid = (xcd < r ? xcd * (q + 1) : r * (q + 1) + (xcd - r) * q) + off; }
  const int nig = 8 * nN, gid = wgid / nig, fm = gid * 8, gsz = (nM - fm) < 8 ? (nM - fm) : 8;
  pm = fm + ((wgid % nig) % gsz); pn = (wgid % nig) / gsz; return true;
}
template <int BM, class Epi>
DI void gemm_phase(const bf16_t* __restrict__ A, int lda, const bf16_t* __restrict__ Bt, int ldb, int K, int nM, int nN, char* shm, int vb, Epi epi) {
  constexpr int BK = 64, TILE_B = 256 * BK * 2, GL = 4, STAGE_B = 2 * TILE_B, GLA = BM / 64, MB = BM / 32;
  const int tid = get_tid(), wid = tid >> 6, lane = tid & 63, wr = wid >> 2, wc = wid & 3, fr = lane & 15, fq = lane >> 4;
  int sR[GL], sC[GL];
#pragma unroll
  for (int i = 0; i < GL; ++i) stage_rc2(wid * 1024 + i * 8192 + lane * 16, sR[i], sC[i]);
  const int lo_ = (fr * 64 + fq * 16) ^ ((fr >> 3) << 5);
  const int aoff = wr * (BM / 32) * 2048 + lo_, boff = TILE_B + wc * 8192 + lo_;
  int sRB[GL];
#pragma unroll
  for (int i = 0; i < GL; ++i) { const int rho = sR[i] & 31, nn = rho >> 4, ii = rho & 15; sRB[i] = (sR[i] & ~31) + 8 * (ii >> 2) + 4 * nn + (ii & 3); }
#define SA_(b) (shm + (b) * STAGE_B)
#define SB_(b) (shm + (b) * STAGE_B + TILE_B)
#define GLDS_STAGE(buf, Ab_, Bb_, kt) do { _Pragma("unroll") for (int i = 0; i < GL; ++i) { \
    if (i < GLA) __builtin_amdgcn_global_load_lds((const unsigned*)((Ab_) + (size_t)sR[i] * lda + (kt) * BK + sC[i]), (LAS unsigned*)(SA_(buf) + wid * 1024 + i * 8192), 16, 0, 0); \
    __builtin_amdgcn_global_load_lds((const unsigned*)((Bb_) + (size_t)sRB[i] * ldb + (kt) * BK + sC[i]), (LAS unsigned*)(SB_(buf) + wid * 1024 + i * 8192), 16, 0, 0); } } while (0)
  int pm, pn;
  if (!unit_next(vb, 0, nM, nN, pm, pn)) return;
  const int nt = K / BK;
  GLDS_STAGE(0, A + (size_t)pm * BM * lda, Bt + (size_t)pn * 256 * ldb, 0);
#pragma unroll 1
  for (int ui = 0;; ++ui) {
    int npm = 0, npn = 0;
    const bool hn = unit_next(vb, ui + 1, nM, nN, npm, npn);
    f32x4 acc[MB][4];
#pragma unroll
    for (int m = 0; m < MB; ++m)
#pragma unroll
      for (int n = 0; n < 4; ++n) acc[m][n] = (f32x4){0.f, 0.f, 0.f, 0.f};
    WAIT_V0(); __syncthreads();
#pragma unroll 1
    for (int t = 0; t < nt; ++t) {
      const int cur = t & 1;
      {
        const bool last = t + 1 >= nt;
        if (!last || hn) {
          const bf16_t* Ab = A + (size_t)(last ? npm : pm) * BM * lda + (last ? 0 : (t + 1) * BK);
          const bf16_t* Bb = Bt + (size_t)(last ? npn : pn) * 256 * ldb + (last ? 0 : (t + 1) * BK);
          GLDS_STAGE(cur ^ 1, Ab, Bb, 0);
        }
      }
      if constexpr (BM == 192) {
        bf16x8 At[2][MB], Bf[2][4];
#pragma unroll
        for (int ks = 0; ks < 2; ++ks) {
#pragma unroll
          for (int n = 0; n < 4; ++n) Bf[ks][n] = *(const bf16x8*)(shm + cur * STAGE_B + boff + (n * 2 + ks) * 1024);
#pragma unroll
          for (int m = 0; m < MB; ++m) At[ks][m] = *(const bf16x8*)(shm + cur * STAGE_B + aoff + (m * 2 + ks) * 1024);
          __builtin_amdgcn_sched_barrier(0);
        }
#pragma unroll
        for (int ks = 0; ks < 2; ++ks) {
#pragma unroll
          for (int m = 0; m < MB; ++m)
#pragma unroll
            for (int n = 0; n < 4; ++n) acc[m][n] = __builtin_amdgcn_mfma_f32_16x16x32_bf16(Bf[ks][n], At[ks][m], acc[m][n], 0, 0, 0);
          __builtin_amdgcn_sched_barrier(0);
        }
      } else {
#pragma unroll
        for (int ks = 0; ks < 2; ++ks) {
          bf16x8 At[MB], Bf[4];
#pragma unroll
          for (int n = 0; n < 4; ++n) Bf[n] = *(const bf16x8*)(shm + cur * STAGE_B + boff + (n * 2 + ks) * 1024);
#pragma unroll
          for (int m = 0; m < MB; ++m) At[m] = *(const bf16x8*)(shm + cur * STAGE_B + aoff + (m * 2 + ks) * 1024);
          __builtin_amdgcn_sched_barrier(0);
#pragma unroll
          for (int m = 0; m < MB; ++m)
#pragma unroll
            for (int n = 0; n < 4; ++n) acc[m][n] = __builtin_amdgcn_mfma_f32_16x16x32_bf16(Bf[n], At[m], acc[m][n], 0, 0, 0);
          __builtin_amdgcn_sched_barrier(0);
        }
      }
      if (t + 1 < nt) { WAIT_V0(); __syncthreads(); }
    }
    const int brow = pm * BM, bcol = pn * 256;
    if constexpr (Epi::PRELOAD) {
      u32x4 xr[MB][2];
#pragma unroll
      for (int m = 0; m < MB; ++m)
#pragma unroll
        for (int g2 = 0; g2 < 2; ++g2) xr[m][g2] = epi.preload(brow + wr * (BM / 2) + m * 16 + fr, bcol + wc * 64 + g2 * 32 + fq * 8);
#pragma unroll
      for (int m = 0; m < MB; ++m)
#pragma unroll
        for (int g2 = 0; g2 < 2; ++g2) epi(brow + wr * (BM / 2) + m * 16 + fr, bcol + wc * 64 + g2 * 32 + fq * 8, acc[m][2 * g2], acc[m][2 * g2 + 1], xr[m][g2]);
    } else {
#pragma unroll
      for (int m = 0; m < MB; ++m)
#pragma unroll
        for (int g2 = 0; g2 < 2; ++g2) epi(brow + wr * (BM / 2) + m * 16 + fr, bcol + wc * 64 + g2 * 32 + fq * 8, acc[m][2 * g2], acc[m][2 * g2 + 1]);
    }
    if (!hn) break;
    pm = npm; pn = npn;
  }
  __syncthreads();
#undef SA_
#undef SB_
#undef GLDS_STAGE
}

struct EpiInProj {
  static constexpr bool PRELOAD = false;
  bf16_t* proj; float* dt;
  DI void operator()(int m, int n, const f32x4& v0, const f32x4& v1) const {
    u32x4 o; o[0] = pk2(v0[0], v0[1]); o[1] = pk2(v0[2], v0[3]); o[2] = pk2(v1[0], v1[1]); o[3] = pk2(v1[2], v1[3]);
    *(u32x4*)(proj + (size_t)m * NPROJP + n) = o;
    if (n >= C_DT && n < NPROJ) { float* d = dt + (size_t)m * 16 + (n - C_DT); *(f32x4*)d = v0; *(f32x4*)(d + 4) = v1; }
  }
};
struct EpiResid {
  static constexpr bool PRELOAD = true;
  const float* xin_p; const float* xin_s;
  bf16_t* xb; float* xout_f;
  const float* gate;
  DI u32x4 preload(int m, int n) const { return xin_p ? (u32x4){0u, 0u, 0u, 0u} : *(const u32x4*)(xb + (size_t)m * D + n); }
  DI void operator()(int m, int n, const f32x4& v0, const f32x4& v1, const u32x4& r) const {
    const float* gp = gate + (size_t)modrow_of(m) * 6144 + n;
    const f32x4 g0 = *(const f32x4*)gp, g1 = *(const f32x4*)(gp + 4);
    f32x4 x0, x1;
    if (xin_p) { const float* xi = ((m < TP) ? xin_p + (size_t)m * D : xin_s + (size_t)(m - TP) * D) + n; x0 = *(const f32x4*)xi; x1 = *(const f32x4*)(xi + 4); }
    else { x0 = (f32x4){bflo(r[0]), bfhi(r[0]), bflo(r[1]), bfhi(r[1])}; x1 = (f32x4){bflo(r[2]), bfhi(r[2]), bflo(r[3]), bfhi(r[3])}; }
    const f32x4 y0 = x0 + g0 * v0, y1 = x1 + g1 * v1;
    if (xout_f) { float* o = xout_f + (size_t)m * D + n; *(f32x4*)o = y0; *(f32x4*)(o + 4) = y1; }
    else { u32x4 o; o[0] = pk2(y0[0], y0[1]); o[1] = pk2(y0[2], y0[3]); o[2] = pk2(y1[0], y1[1]); o[3] = pk2(y1[2], y1[3]); *(u32x4*)(xb + (size_t)m * D + n) = o; }
  }
};
struct EpiFF1 {
  static constexpr bool PRELOAD = false;
  bf16_t* u;
  DI void operator()(int m, int n, const f32x4& v0, const f32x4& v1) const {
    float r[8];
#pragma unroll
    for (int e = 0; e < 4; ++e) { const float t0 = v0[e] > 0.f ? v0[e] : 0.f, t1 = v1[e] > 0.f ? v1[e] : 0.f; r[e] = t0 * t0; r[4 + e] = t1 * t1; }
    u32x4 o; o[0] = pk2(r[0], r[1]); o[1] = pk2(r[2], r[3]); o[2] = pk2(r[4], r[5]); o[3] = pk2(r[6], r[7]);
    *(u32x4*)(u + (size_t)m * DFF + n) = o;
  }
};

DI void rope_block(f32x16& v, const float* tab, int pos, int half) {
  const float* t = tab + (size_t)pos * 32;
#pragma unroll
  for (int q = 0; q < 2; ++q)
#pragma unroll
    for (int r = 0; r < 4; ++r) {
      const int fi = q * 8 + r + 4 * half;
      const float c = t[fi * 2], s = t[fi * 2 + 1];
      const float x1 = v[q * 8 + r], x2 = v[q * 8 + r + 4];
      v[q * 8 + r] = x1 * c - x2 * s;
      v[q * 8 + r + 4] = x2 * c + x1 * s;
    }
}
DI void store_block_bf16(bf16_t* dst, const f32x16& v, int half) {
#pragma unroll
  for (int q = 0; q < 4; q += 2) {
    unsigned ax = pk2(v[4 * q], v[4 * q + 1]), ay = pk2(v[4 * q + 2], v[4 * q + 3]);
    unsigned bx = pk2(v[4 * q + 4], v[4 * q + 5]), by = pk2(v[4 * q + 6], v[4 * q + 7]);
    { auto r = __builtin_amdgcn_permlane32_swap(ax, bx, false, false); ax = r[0]; bx = r[1]; }
    { auto r = __builtin_amdgcn_permlane32_swap(ay, by, false, false); ay = r[0]; by = r[1]; }
    u32x4 wv; wv[0] = ax; wv[1] = ay; wv[2] = bx; wv[3] = by;
    *(u32x4*)(dst + 8 * q + 8 * half) = wv;
  }
}
DI f32x16 gain_block(const float* g, int half) {
  f32x16 o;
#pragma unroll
  for (int q = 0; q < 4; ++q) { const f32x4 v = *(const f32x4*)(g + 8 * q + 4 * half); o[4 * q] = v[0]; o[4 * q + 1] = v[1]; o[4 * q + 2] = v[2]; o[4 * q + 3] = v[3]; }
  return o;
}
DI float sumsq16(const f32x16& v) { float s = 0.f;
#pragma unroll
  for (int i = 0; i < 16; ++i) s += v[i] * v[i];
  return s; }

DI void mla_q_item(const Params& p, int l, int item4, char* lds) {
  const int item = item4 >> 2, head0 = item4 & 3;
  const int lane = get_tid() & 63, w = get_tid() >> 6, l32 = lane & 31, half = lane >> 5;
  {
    const bf16_t* Wg = (const bf16_t*)(p.ws + OFF_WUQ) + ((size_t)l * 384 + head0 * 96) * 256;
    u32x4 t[6];
#pragma unroll
    for (int i = 0; i < 6; ++i) { const int c = get_tid() + 512 * i; t[i] = *(const u32x4*)(Wg + (size_t)(c >> 5) * 256 + (c & 31) * 8); }
    __syncthreads();
#pragma unroll
    for (int i = 0; i < 6; ++i) { const int c = get_tid() + 512 * i; *(u32x4*)(lds + (c >> 5) * 528 + (c & 31) * 16) = t[i]; }
    if (get_tid() < 64) *(f32x4*)(lds + 50688 + get_tid() * 16) = *(const f32x4*)(p.in[15] + (size_t)l * 256 + get_tid() * 4);
  }
  const int tok = item * 256 + w * 32 + l32;
  const bf16_t* proj = (const bf16_t*)(p.ws + OFF_PROJ) + (size_t)tok * NPROJP + C_CQ;
  const float* gq = p.in[15] + (size_t)l * 256;
  float ss = 0.f;
  u32x4 raw[16];
#pragma unroll
  for (int s = 0; s < 16; ++s) raw[s] = *(const u32x4*)(proj + 16 * s + 8 * half);
#pragma unroll
  for (int s = 0; s < 16; ++s) {
#pragma unroll
    for (int e = 0; e < 4; ++e) { const float a = bflo(raw[s][e]), b = bfhi(raw[s][e]); ss += a * a + b * b; }
  }
  ss += xor32(ss);
  const float rstd = rsqrtf(ss * (1.f / 256.f) + EPS);
  __syncthreads();
  bf16x8 fr[16];
#pragma unroll
  for (int s = 0; s < 16; ++s) {
    const f32x4 g0 = *(const f32x4*)(lds + 50688 + (16 * s + 8 * half) * 4), g1 = *(const f32x4*)(lds + 50688 + (16 * s + 8 * half + 4) * 4);
    u32x4 o;
    o[0] = pk2(bflo(raw[s][0]) * rstd * g0[0], bfhi(raw[s][0]) * rstd * g0[1]);
    o[1] = pk2(bflo(raw[s][1]) * rstd * g0[2], bfhi(raw[s][1]) * rstd * g0[3]);
    o[2] = pk2(bflo(raw[s][2]) * rstd * g1[0], bfhi(raw[s][2]) * rstd * g1[1]);
    o[3] = pk2(bflo(raw[s][3]) * rstd * g1[2], bfhi(raw[s][3]) * rstd * g1[3]);
    fr[s] = __builtin_bit_cast(bf16x8, o);
  }
  const bf16_t* W = (const bf16_t*)(p.ws + OFF_WUQ) + (size_t)l * 384 * 256;
  const float* gqk = p.in[19] + (size_t)l * 96;
  const float* tab = (const float*)(p.ws + OFF_ROPE);
  const bool rope = tok >= TP;
  const int pos = rope ? ((tok - TP) & 2047) : 0;
  const float qscale = 0.10206207261596577f * 1.4426950408889634f;
  bf16_t* qa = (bf16_t*)(p.ws + OFF_QA) + (size_t)tok * 384;
#pragma unroll 1
  for (int head = head0; head < head0 + 1; ++head) {
    f32x16 acc[3];
#pragma unroll
    for (int db = 0; db < 3; ++db) acc[db] = zero16();
#pragma unroll
    for (int db = 0; db < 3; ++db) {
      bf16x8 a[16];
      const char* wrow = lds + (db * 32 + l32) * 528 + 16 * half;
#pragma unroll
      for (int s = 0; s < 16; ++s) a[s] = *(const bf16x8*)(wrow + 32 * s);
      __builtin_amdgcn_sched_barrier(0);
#pragma unroll
      for (int s = 0; s < 16; ++s) acc[db] = MFMA32(a[s], fr[s], acc[db]);
      __builtin_amdgcn_sched_barrier(0);
    }
    float s2 = sumsq16(acc[0]) + sumsq16(acc[1]) + sumsq16(acc[2]);
    s2 += xor32(s2);
    const float r2 = rsqrtf(s2 * (1.f / 96.f) + EPS);
#pragma unroll
    for (int db = 0; db < 3; ++db) {
      const f32x16 gb = gain_block(gqk + db * 32, half);
#pragma unroll
      for (int r = 0; r < 16; ++r) acc[db][r] *= r2 * gb[r];
    }
    if (rope) rope_block(acc[2], tab, pos, half);
#pragma unroll
    for (int db = 0; db < 3; ++db) {
#pragma unroll
      for (int r = 0; r < 16; ++r) acc[db][r] *= qscale;
      store_block_bf16(qa + head * 96 + db * 32, acc[db], half);
    }
  }
}

DI void mla_kv_item(const Params& p, int l, int item4, char* lds) {
  const int item = item4 >> 2, head0 = item4 & 3;
  const int lane = get_tid() & 63, w = get_tid() >> 6, l32 = lane & 31, half = lane >> 5;
  {
    const bf16_t* Wg = (const bf16_t*)(p.ws + OFF_WUKV) + ((size_t)l * 512 + head0 * 128) * 128;
    u32x4 t[4];
#pragma unroll
    for (int i = 0; i < 4; ++i) { const int c = get_tid() + 512 * i; t[i] = *(const u32x4*)(Wg + (size_t)(c >> 4) * 128 + (c & 15) * 8); }
    __syncthreads();
#pragma unroll
    for (int i = 0; i < 4; ++i) { const int c = get_tid() + 512 * i; *(u32x4*)(lds + (c >> 4) * PITCH128 + (c & 15) * 16) = t[i]; }
  }
  const int kr = item * 256 + w * 32 + l32;
  int tok = -1, b = 0, j = 0; bool cached = false, rope = false; int pos = 0;
  if (kr < TP) { tok = kr; }
  else { b = (kr - TP) / 2304; j = (kr - TP) % 2304; if (j < PAST) cached = true; else { tok = TP + b * 2048 + (j - PAST); rope = true; pos = j - PAST; } }
  bf16x8 fr[8];
  f32x16 krb;
  if (!cached) {
    const bf16_t* proj = (const bf16_t*)(p.ws + OFF_PROJ) + (size_t)tok * NPROJP;
    const float* gkv = p.in[16] + (size_t)l * 128;
    u32x4 raw[8]; float ss = 0.f;
    f32x4 gv0[8], gv1[8]; u32x2 rvv[4];
#pragma unroll
    for (int s = 0; s < 8; ++s) raw[s] = *(const u32x4*)(proj + C_CKV + 16 * s + 8 * half);
#pragma unroll
    for (int s = 0; s < 8; ++s) { gv0[s] = *(const f32x4*)(gkv + 16 * s + 8 * half); gv1[s] = *(const f32x4*)(gkv + 16 * s + 8 * half + 4); }
#pragma unroll
    for (int q = 0; q < 4; ++q) rvv[q] = *(const u32x2*)(proj + C_KR + 8 * q + 4 * half);
#pragma unroll
    for (int s = 0; s < 8; ++s) {
#pragma unroll
      for (int e = 0; e < 4; ++e) { const float a = bflo(raw[s][e]), bb = bfhi(raw[s][e]); ss += a * a + bb * bb; }
    }
    ss += xor32(ss);
    const float rstd = rsqrtf(ss * (1.f / 128.f) + EPS);
#pragma unroll
    for (int s = 0; s < 8; ++s) {
      const f32x4 g0 = gv0[s], g1 = gv1[s];
      f32x4 o0, o1;
      o0[0] = bflo(raw[s][0]) * rstd * g0[0]; o0[1] = bfhi(raw[s][0]) * rstd * g0[1]; o0[2] = bflo(raw[s][1]) * rstd * g0[2]; o0[3] = bfhi(raw[s][1]) * rstd * g0[3];
      o1[0] = bflo(raw[s][2]) * rstd * g1[0]; o1[1] = bfhi(raw[s][2]) * rstd * g1[1]; o1[2] = bflo(raw[s][3]) * rstd * g1[2]; o1[3] = bfhi(raw[s][3]) * rstd * g1[3];
      u32x4 o; o[0] = pk2(o0[0], o0[1]); o[1] = pk2(o0[2], o0[3]); o[2] = pk2(o1[0], o1[1]); o[3] = pk2(o1[2], o1[3]);
      fr[s] = __builtin_bit_cast(bf16x8, o);
      if (tok < TP && head0 == 0) {
        float* dst = p.out + O_CKV + (((size_t)(tok >> 8) * DEPTH + l) * 256 + (tok & 255)) * 128 + 16 * s + 8 * half;
        *(f32x4*)dst = o0; *(f32x4*)(dst + 4) = o1;
      }
    }
#pragma unroll
    for (int q = 0; q < 4; ++q) {
      const u32x2 rv = rvv[q];
      krb[4 * q] = bflo(rv[0]); krb[4 * q + 1] = bfhi(rv[0]); krb[4 * q + 2] = bflo(rv[1]); krb[4 * q + 3] = bfhi(rv[1]);
      if (tok < TP && head0 == 0) {
        float* dst = p.out + O_KROPE + (((size_t)(tok >> 8) * DEPTH + l) * 256 + (tok & 255)) * 32 + 8 * q + 4 * half;
        f32x4 o = {krb[4 * q], krb[4 * q + 1], krb[4 * q + 2], krb[4 * q + 3]};
        *(f32x4*)dst = o;
      }
    }
  } else {
    const float* src = p.in[2] + (((size_t)b * DEPTH + l) * PAST + j) * 128;
#pragma unroll
    for (int s = 0; s < 8; ++s) {
      const f32x4 v0 = *(const f32x4*)(src + 16 * s + 8 * half), v1 = *(const f32x4*)(src + 16 * s + 8 * half + 4);
      u32x4 o; o[0] = pk2(v0[0], v0[1]); o[1] = pk2(v0[2], v0[3]); o[2] = pk2(v1[0], v1[1]); o[3] = pk2(v1[2], v1[3]);
      fr[s] = __builtin_bit_cast(bf16x8, o);
    }
    const float* ks = p.in[3] + (((size_t)b * DEPTH + l) * PAST + j) * 32;
#pragma unroll
    for (int q = 0; q < 4; ++q) {
      const f32x4 v = *(const f32x4*)(ks + 8 * q + 4 * half);
      krb[4 * q] = v[0]; krb[4 * q + 1] = v[1]; krb[4 * q + 2] = v[2]; krb[4 * q + 3] = v[3];
    }
  }
  const bf16_t* W = (const bf16_t*)(p.ws + OFF_WUKV) + (size_t)l * 512 * 128;
  const float* gk = p.in[20] + (size_t)l * 96;
  const float* tab = (const float*)(p.ws + OFF_ROPE);
  bf16_t* ka = (bf16_t*)(p.ws + OFF_KA) + (size_t)kr * 384;
  bf16_t* vat = (bf16_t*)(p.ws + OFF_VAT);
  const float ssr = sumsq16(krb);
  __syncthreads();
#pragma unroll 1
  for (int head = head0; head < head0 + 1; ++head) {
    f32x16 acc[4];
#pragma unroll
    for (int db = 0; db < 4; ++db) acc[db] = zero16();
#pragma unroll
    for (int dp = 0; dp < 2; ++dp) {
      bf16x8 a[2][8];
#pragma unroll
      for (int d2 = 0; d2 < 2; ++d2)
#pragma unroll
        for (int s = 0; s < 8; ++s) a[d2][s] = *(const bf16x8*)(lds + ((dp * 2 + d2) * 32 + l32) * PITCH128 + 32 * s + 16 * half);
      __builtin_amdgcn_sched_barrier(0);
#pragma unroll
      for (int d2 = 0; d2 < 2; ++d2)
#pragma unroll
        for (int s = 0; s < 8; ++s) acc[dp * 2 + d2] = MFMA32(a[d2][s], fr[s], acc[dp * 2 + d2]);
      __builtin_amdgcn_sched_barrier(0);
    }
    float s2 = sumsq16(acc[0]) + sumsq16(acc[1]) + ssr;
    s2 += xor32(s2);
    const float r2 = rsqrtf(s2 * (1.f / 96.f) + EPS);
    f32x16 k2;
    {
      const f32x16 g0 = gain_block(gk, half), g1 = gain_block(gk + 32, half), g2 = gain_block(gk + 64, half);
#pragma unroll
      for (int r = 0; r < 16; ++r) { acc[0][r] *= r2 * g0[r]; acc[1][r] *= r2 * g1[r]; k2[r] = krb[r] * r2 * g2[r]; }
    }
    if (rope) rope_block(k2, tab, pos, half);
    store_block_bf16(ka + head * 96, acc[0], half);
    store_block_bf16(ka + head * 96 + 32, acc[1], half);
    store_block_bf16(ka + head * 96 + 64, k2, half);
#pragma unroll
    for (int db = 2; db < 4; ++db)
#pragma unroll
      for (int r = 0; r < 16; ++r)
        vat[((size_t)head * 64 + (db - 2) * 32 + crow(r, half)) * NKEY + kr] = f2bf(acc[db][r]);
  }
}

DI void diff_qk_thread(const Params& p, int l, int idx, bool isk) {
  const float* tab = (const float*)(p.ws + OFF_ROPE);
  const int hm = idx & 7, row = idx >> 3;
  float x[32];
  int tok = -1, pos = 0; bool rope = false, cached = false;
  if (!isk) { tok = row; if (tok >= TP) { rope = true; pos = (tok - TP) & 2047; } }
  else {
    if (row < TP) tok = row;
    else { const int b = (row - TP) / 2304, j = (row - TP) % 2304;
      if (j < PAST) { cached = true;
        const float* src = p.in[4] + ((((size_t)b * DEPTH + l) * PAST + j) * 8 + hm) * 32;
#pragma unroll
        for (int i = 0; i < 8; ++i) { const f32x4 v = *(const f32x4*)(src + 4 * i); x[4 * i] = v[0]; x[4 * i + 1] = v[1]; x[4 * i + 2] = v[2]; x[4 * i + 3] = v[3]; }
      } else { tok = TP + b * 2048 + (j - PAST); rope = true; pos = j - PAST; } }
  }
  if (!cached) {
    const bf16_t* src = (const bf16_t*)(p.ws + OFF_PROJ) + (size_t)tok * NPROJP + (isk ? C_DK : C_DQ) + hm * 32;
    float ss = 0.f;
#pragma unroll
    for (int i = 0; i < 4; ++i) {
      const u32x4 v = *(const u32x4*)(src + 8 * i);
#pragma unroll
      for (int e = 0; e < 4; ++e) { x[8 * i + 2 * e] = bflo(v[e]); x[8 * i + 2 * e + 1] = bfhi(v[e]); }
    }
#pragma unroll
    for (int i = 0; i < 32; ++i) ss += x[i] * x[i];
    const float rstd = rsqrtf(ss * (1.f / 32.f) + EPS);
    const float* g = p.in[isk ? 22 : 21] + (size_t)l * 32;
#pragma unroll
    for (int i = 0; i < 32; ++i) x[i] *= rstd * g[i];
    if (isk && tok < TP) {
      float* dst = p.out + O_DK + (((size_t)(tok >> 8) * DEPTH + l) * 256 + (tok & 255)) * 256 + hm * 32;
#pragma unroll
      for (int i = 0; i < 8; ++i) { f32x4 o = {x[4 * i], x[4 * i + 1], x[4 * i + 2], x[4 * i + 3]}; *(f32x4*)(dst + 4 * i) = o; }
    }
    if (rope) {
      const float* t = tab + (size_t)pos * 32;
#pragma unroll
      for (int q = 0; q < 2; ++q)
#pragma unroll
        for (int m = 0; m < 8; ++m) {
          const float c = t[(q * 8 + m) * 2], s = t[(q * 8 + m) * 2 + 1];
          const float x1 = x[q * 16 + m], x2 = x[q * 16 + 8 + m];
          x[q * 16 + m] = x1 * c - x2 * s; x[q * 16 + 8 + m] = x2 * c + x1 * s;
        }
    }
  }
  const float sc = isk ? 1.f : 0.17677669529663687f * 1.4426950408889634f;
  bf16_t* dst = (bf16_t*)(p.ws + (isk ? OFF_KD : OFF_QD)) + (size_t)row * 256 + hm * 32;
#pragma unroll
  for (int i = 0; i < 4; ++i) {
    u32x4 o;
#pragma unroll
    for (int e = 0; e < 4; ++e) o[e] = pk2(x[8 * i + 2 * e] * sc, x[8 * i + 2 * e + 1] * sc);
    *(u32x4*)(dst + 8 * i) = o;
  }
}
DI void diff_v_thread(const Params& p, int l, int idx) {
  const int head = idx / NKEY, kr = idx % NKEY;
  bf16_t* vdt = (bf16_t*)(p.ws + OFF_VDT) + (size_t)head * 64 * NKEY + kr;
  int tok = -1;
  if (kr < TP) tok = kr;
  else { const int b = (kr - TP) / 2304, j = (kr - TP) % 2304;
    if (j < PAST) {
      const float* src = p.in[5] + ((((size_t)b * DEPTH + l) * PAST + j) * 4 + head) * 64;
#pragma unroll
      for (int i = 0; i < 16; ++i) { const f32x4 v = *(const f32x4*)(src + 4 * i);
#pragma unroll
        for (int e = 0; e < 4; ++e) vdt[(size_t)(4 * i + e) * NKEY] = f2bf(v[e]); }
      return;
    }
    tok = TP + b * 2048 + (j - PAST);
  }
  const bf16_t* src = (const bf16_t*)(p.ws + OFF_PROJ) + (size_t)tok * NPROJP + C_DV + head * 64;
  float* od = (tok < TP) ? p.out + O_DV + (((size_t)(tok >> 8) * DEPTH + l) * 256 + (tok & 255)) * 256 + head * 64 : nullptr;
#pragma unroll
  for (int i = 0; i < 8; ++i) {
    const u32x4 v = *(const u32x4*)(src + 8 * i);
#pragma unroll
    for (int e = 0; e < 4; ++e) {
      vdt[(size_t)(8 * i + 2 * e) * NKEY] = (bf16_t)(v[e] & 0xffffu);
      vdt[(size_t)(8 * i + 2 * e + 1) * NKEY] = (bf16_t)(v[e] >> 16);
    }
    if (od) {
      f32x4 o0 = {bflo(v[0]), bfhi(v[0]), bflo(v[1]), bfhi(v[1])}, o1 = {bflo(v[2]), bfhi(v[2]), bflo(v[3]), bfhi(v[3])};
      *(f32x4*)(od + 8 * i) = o0; *(f32x4*)(od + 8 * i + 4) = o1;
    }
  }
}
template <int CU>
DI void conv_threads(const Params& p, int l, int idx0, int stride) {
  u32x4 v[CU][5]; f32x4 bia[CU][2];
  int tokv[CU], c0v[CU];
#pragma unroll
  for (int u = 0; u < CU; ++u) {
    const int idx = idx0 + u * stride;
    const int tok = idx / 96, c0 = (idx % 96) * 8;
    tokv[u] = tok; c0v[u] = c0;
    int pos, L;
    if (tok < TP) { pos = tok & 255; L = 256; } else { pos = (tok - TP) & 2047; L = 2048; }
    const bf16_t* src = (const bf16_t*)(p.ws + OFF_PROJ) + (size_t)tok * NPROJP + C_XBC + c0;
#pragma unroll
    for (int k = 0; k < 5; ++k) {
      const int pp = pos + k - 2;
      v[u][k] = (u32x4){0u, 0u, 0u, 0u};
      if (pp >= 0 && pp < L) v[u][k] = *(const u32x4*)(src + (ptrdiff_t)(k - 2) * NPROJP);
    }
    const float* cb = p.in[29] + (size_t)l * 768 + c0;
    bia[u][0] = *(const f32x4*)cb; bia[u][1] = *(const f32x4*)(cb + 4);
  }
#pragma unroll
  for (int u = 0; u < CU; ++u) {
    const float* cw = p.in[28] + (size_t)l * 5 * 768 + c0v[u];
    float acc[8] = {bia[u][0][0], bia[u][0][1], bia[u][0][2], bia[u][0][3], bia[u][1][0], bia[u][1][1], bia[u][1][2], bia[u][1][3]};
#pragma unroll
    for (int k = 0; k < 5; ++k) {
      const f32x4 w0 = *(const f32x4*)(cw + k * 768), w1 = *(const f32x4*)(cw + k * 768 + 4);
      const u32x4 x = v[u][k];
      acc[0] += w0[0] * bflo(x[0]); acc[1] += w0[1] * bfhi(x[0]); acc[2] += w0[2] * bflo(x[1]); acc[3] += w0[3] * bfhi(x[1]);
      acc[4] += w1[0] * bflo(x[2]); acc[5] += w1[1] * bfhi(x[2]); acc[6] += w1[2] * bflo(x[3]); acc[7] += w1[3] * bfhi(x[3]);
    }
#pragma unroll
    for (int e = 0; e < 8; ++e) acc[e] = acc[e] / (1.f + __expf(-acc[e]));
    u32x4 o; o[0] = pk2(acc[0], acc[1]); o[1] = pk2(acc[2], acc[3]); o[2] = pk2(acc[4], acc[5]); o[3] = pk2(acc[6], acc[7]);
    *(u32x4*)((bf16_t*)(p.ws + OFF_XBC) + (size_t)tokv[u] * 768 + c0v[u]) = o;
  }
}
DI void dt_thread(const Params& p, int l, int idx) {
  float* dt = (float*)(p.ws + OFF_DT);
  const float v = dt[idx] + p.in[31][(size_t)l * 16 + (idx & 15)];
  dt[idx] = fmaxf(v, 0.f) + log1pf(__expf(-fabsf(v)));
}

DI void prep_phase(const Params& p, int l, char* lds) {
  constexpr int N_Q = 48 * 4, N_KV = 52 * 4, N_DQ = T * 8 / 512, N_DKK = NKEY * 8 / 512, N_DV = NKEY * 4 / 512, N_CONV = T * 96 / 512 / 3, N_DTT = T * 16 / 512;
  constexpr int TOT = N_Q + N_KV + N_DQ + N_DKK + N_DV + N_CONV + N_DTT;
  for (int item = blockIdx.x; item < TOT; item += gridDim.x) {
    int it = item;
    if (it < N_Q) { mla_q_item(p, l, it, lds); continue; }
    it -= N_Q;
    if (it < N_KV) { mla_kv_item(p, l, it, lds); continue; }
    it -= N_KV;
    if (it < N_DQ) { diff_qk_thread(p, l, it * 512 + get_tid(), false); continue; }
    it -= N_DQ;
    if (it < N_DKK) { diff_qk_thread(p, l, it * 512 + get_tid(), true); continue; }
    it -= N_DKK;
    if (it < N_DV) { diff_v_thread(p, l, it * 512 + get_tid()); continue; }
    it -= N_DV;
    if (it < N_CONV) { conv_threads<3>(p, l, it * 512 + get_tid(), N_CONV * 512); continue; }
    it -= N_CONV;
    dt_thread(p, l, it * 512 + get_tid());
  }
}

DI void wave_scan2(float e0, float e1, float& o0, float& o1) {
  const int lane = get_tid() & 63;
  const float s = e0 + e1;
  float inc = s;
#pragma unroll
  for (int o = 1; o < 64; o <<= 1) { const float t = __shfl_up(inc, o); if (lane >= o) inc += t; }
  const float excl = inc - s;
  o0 = excl + e0; o1 = excl + s;
}
DI void ssd_dt_load(const Params& p, int cg_, int h, float& d0, float& d1) {
  const int lane = get_tid() & 63, w = get_tid4() >> 6;
  const float* dt = (const float*)(p.ws + OFF_DT) + (size_t)cg_ * 128 * 16;
  d0 = 0.f; d1 = 0.f;
  if (w == 0) { d0 = dt[(2 * lane) * 16 + h]; d1 = dt[(2 * lane + 1) * 16 + h]; }
  else if (w == 1) { d0 = dt[(127 - 2 * lane) * 16 + 8 + h]; d1 = dt[(126 - 2 * lane) * 16 + 8 + h]; }
}
DI void ssd_scalars_from(const Params& p, int l, int h, float d0, float d1, float* acf, float* sb, float* dtf, float* dtb) {
  const int lane = get_tid() & 63, w = get_tid4() >> 6;
  if (w == 0) {
    const float a = -__expf(p.in[30][(size_t)l * 16 + h]);
    float o0, o1; wave_scan2(d0 * a, d1 * a, o0, o1);
    acf[2 * lane] = o0; acf[2 * lane + 1] = o1; dtf[2 * lane] = d0; dtf[2 * lane + 1] = d1;
  } else if (w == 1) {
    const float a = -__expf(p.in[30][(size_t)l * 16 + 8 + h]);
    const int j0 = 127 - 2 * lane, j1 = 126 - 2 * lane;
    float o0, o1; wave_scan2(d0 * a, d1 * a, o0, o1);
    sb[j0] = o0; sb[j1] = o1; dtb[j0] = d0; dtb[j1] = d1;
  }
}
DI void ssd_scalars(const Params& p, int l, int cg_, int h, float* acf, float* sb, float* dtf, float* dtb) {
  const int lane = get_tid() & 63, w = get_tid4() >> 6;
  const float* dt = (const float*)(p.ws + OFF_DT) + (size_t)cg_ * 128 * 16;
  if (w == 0) {
    const float a = -__expf(p.in[30][(size_t)l * 16 + h]);
    const float d0 = dt[(2 * lane) * 16 + h], d1 = dt[(2 * lane + 1) * 16 + h];
    float o0, o1; wave_scan2(d0 * a, d1 * a, o0, o1);
    acf[2 * lane] = o0; acf[2 * lane + 1] = o1; dtf[2 * lane] = d0; dtf[2 * lane + 1] = d1;
  } else if (w == 1) {
    const float a = -__expf(p.in[30][(size_t)l * 16 + 8 + h]);
    const int j0 = 127 - 2 * lane, j1 = 126 - 2 * lane;
    const float d0 = dt[j0 * 16 + 8 + h], d1 = dt[j1 * 16 + 8 + h];
    float o0, o1; wave_scan2(d0 * a, d1 * a, o0, o1);
    sb[j0] = o0; sb[j1] = o1; dtb[j0] = d0; dtb[j1] = d1;
  }
}

DI void ssd_states_item(const Params& p, int l, int item, char* lds) {
  const int tid = get_tid4(), lane = tid & 63, w = tid >> 6, l32 = lane & 31, half = lane >> 5;
  const int cg_ = item >> 3, h = item & 7, g = h >> 2;
  char* XF = lds; char* XB = lds + 64 * PITCH128; char* BT = lds + 2 * 64 * PITCH128;
  float* sc = (float*)(lds + 3 * 64 * PITCH128);
  float* acf = sc, *sb = sc + 128, *dtf = sc + 256, *dtb = sc + 384;
  __syncthreads();
  ssd_scalars(p, l, cg_, h, acf, sb, dtf, dtb);
  __syncthreads();
  const bf16_t* xbc = (const bf16_t*)(p.ws + OFF_XBC) + (size_t)cg_ * 128 * 768;
  const float aL = acf[127], s0 = sb[0];
#pragma unroll
  for (int it = 0; it < 2; ++it) {
    const int t = tid + 256 * it, jp = t & 63, pc = t >> 6, j0 = 2 * jp;
    const u32x4 x0 = *(const u32x4*)(xbc + (size_t)j0 * 768 + h * 64 + pc * 8), x1 = *(const u32x4*)(xbc + (size_t)(j0 + 1) * 768 + h * 64 + pc * 8);
    const u32x4 b0 = *(const u32x4*)(xbc + (size_t)j0 * 768 + 512 + g * 64 + pc * 8), b1 = *(const u32x4*)(xbc + (size_t)(j0 + 1) * 768 + 512 + g * 64 + pc * 8);
    const float wf0 = __expf(aL - acf[j0]) * dtf[j0], wf1 = __expf(aL - acf[j0 + 1]) * dtf[j0 + 1];
    const float wb0 = __expf(s0 - sb[j0]) * dtb[j0], wb1 = __expf(s0 - sb[j0 + 1]) * dtb[j0 + 1];
#pragma unroll
    for (int e = 0; e < 4; ++e) {
      const float a0 = bflo(x0[e]), a1 = bfhi(x0[e]), c0 = bflo(x1[e]), c1 = bfhi(x1[e]);
      const int pr = pc * 8 + 2 * e;
      *(unsigned*)(XF + pr * PITCH128 + j0 * 2) = pk2(a0 * wf0, c0 * wf1);
      *(unsigned*)(XF + (pr + 1) * PITCH128 + j0 * 2) = pk2(a1 * wf0, c1 * wf1);
      *(unsigned*)(XB + pr * PITCH128 + j0 * 2) = pk2(a0 * wb0, c0 * wb1);
      *(unsigned*)(XB + (pr + 1) * PITCH128 + j0 * 2) = pk2(a1 * wb0, c1 * wb1);
      *(unsigned*)(BT + pr * PITCH128 + j0 * 2) = (b0[e] & 0xffffu) | (b1[e] << 16);
      *(unsigned*)(BT + (pr + 1) * PITCH128 + j0 * 2) = (b0[e] >> 16) | (b1[e] & 0xffff0000u);
    }
  }
  __syncthreads();
  const int dir = w >> 1, pb = w & 1;
  const char* Xs = (dir ? XB : XF) + (pb * 32 + l32) * PITCH128 + half * 16;
  const char* Bsrc = BT + l32 * PITCH128 + half * 16;
  f32x16 acc[2] = {zero16(), zero16()};
#pragma unroll
  for (int s = 0; s < 8; ++s) {
    const bf16x8 a = *(const bf16x8*)(Xs + s * 32);
    const bf16x8 b0 = *(const bf16x8*)(Bsrc + s * 32), b1 = *(const bf16x8*)(Bsrc + 32 * PITCH128 + s * 32);
    acc[0] = MFMA32(a, b0, acc[0]); acc[1] = MFMA32(a, b1, acc[1]);
  }
  float* ST = (float*)(p.ws + OFF_ST) + ((size_t)(cg_ * 8 + h) * 2 + dir) * 4096;
#pragma unroll
  for (int nb = 0; nb < 2; ++nb)
#pragma unroll
    for (int r = 0; r < 16; ++r) ST[(pb * 32 + crow(r, half)) * 64 + nb * 32 + l32] = acc[nb][r];
  if (tid == 0) { float* cd = (float*)(p.ws + OFF_CDEC) + (size_t)(cg_ * 8 + h) * 2; cd[0] = __expf(aL); cd[1] = __expf(s0); }
}

template <int NC>
DI void ssd_scan_thread(const Params& p, int l, int seq, int r, int cg0, f32x4 hs) {
  const float* ST = (const float*)(p.ws + OFF_ST);
  bf16_t* HP = (bf16_t*)(p.ws + OFF_HP);
  const float* CD = (const float*)(p.ws + OFF_CDEC);
  const int h = r >> 11, dir = (r >> 10) & 1, pn = r & 1023;
  f32x4 st[NC]; float dec[NC];
#pragma unroll
  for (int c = 0; c < NC; ++c) {
    const int cgi = cg0 + (dir ? NC - 1 - c : c);
    st[c] = *(const f32x4*)(ST + ((size_t)(cgi * 8 + h) * 2 + dir) * 4096 + pn * 4);
    dec[c] = CD[(size_t)(cgi * 8 + h) * 2 + dir];
  }
#pragma unroll
  for (int c = 0; c < NC; ++c) {
    const int cgi = cg0 + (dir ? NC - 1 - c : c);
    u32x2 hv; hv[0] = pk2(hs[0], hs[1]); hv[1] = pk2(hs[2], hs[3]);
    *(u32x2*)(HP + ((size_t)(cgi * 8 + h) * 2 + dir) * 4096 + pn * 4) = hv;
    hs = dec[c] * hs + st[c];
  }
  if (seq < 16) *(f32x4*)(p.out + O_SSM + ((((size_t)seq * DEPTH + l) * 2 + dir) * 8 + h) * 4096 + pn * 4) = hs;
}
DI void ssd_scan_phase(const Params& p, int l) {
  constexpr int PER_SEQ = 8 * 2 * 64 * 16;
  for (int item = blockIdx.x; item < 20 * PER_SEQ / 512; item += gridDim.x) {
    const int idx = item * 512 + get_tid();
    const int sq = idx / PER_SEQ; const int r = idx % PER_SEQ;
    const int seq = (sq < 4) ? 16 + sq : sq - 4;
    if (seq < 16) ssd_scan_thread<2>(p, l, seq, r, 2 * seq, (f32x4){0.f, 0.f, 0.f, 0.f});
    else {
      const int dir = (r >> 10) & 1, h = r >> 11, pn = r & 1023;
      const f32x4 h0 = *(const f32x4*)(p.in[6] + ((((size_t)(seq - 16) * DEPTH + l) * 2 + dir) * 8 + h) * 4096 + pn * 4);
      ssd_scan_thread<16>(p, l, seq, r, 32 + 16 * (seq - 16), h0);
    }
  }
}

DI void ssd_y_item(const Params& p, int l, int cg_, char* lds_blk) {
  const int tid = get_tid4(), lane = tid & 63, w = tid >> 6, l32 = lane & 31, half = lane >> 5;
  const int g = get_hb();
  char* lds = lds_blk + g * HALF_LDS;
  char* Bs = lds; char* Cs = lds + 128 * PITCH64; char* XT = lds + 2 * 128 * PITCH64;
  char* Hf = XT + 64 * PITCH128; char* Hb = Hf + 64 * PITCH64;
  float* sc = (float*)(Hb + 64 * PITCH64);
  float* acf = sc, *sb = sc + 128, *dtf = sc + 256, *dtb = sc + 384;
  const int tok0 = cg_ * 128;
  const int i = w * 32 + l32, tok = tok0 + i;
  const bf16_t* xbc = (const bf16_t*)(p.ws + OFF_XBC) + (size_t)tok0 * 768;
  const bf16_t* proj = (const bf16_t*)(p.ws + OFF_PROJ);
  bf16_t* mix = (bf16_t*)(p.ws + OFF_MIX);
  float ssq = 0.f;
  {
    __syncthreads();
#pragma unroll
    for (int it = 0; it < 4; ++it) {
      const int t = tid + 256 * it, r = t >> 3, c = (t & 7) * 8;
      *(u32x4*)(Bs + r * PITCH64 + c * 2) = *(const u32x4*)(xbc + (size_t)r * 768 + 512 + g * 64 + c);
      *(u32x4*)(Cs + r * PITCH64 + c * 2) = *(const u32x4*)(xbc + (size_t)r * 768 + 640 + g * 64 + c);
    }
    __syncthreads();
    u32x4 xr[2][2]; float dpre0, dpre1;
    auto head_loads = [&](int h) {
#pragma unroll
      for (int it = 0; it < 2; ++it) {
        const int t = tid + 256 * it, jp = t & 63, pc = t >> 6, j0 = 2 * jp;
        xr[it][0] = *(const u32x4*)(xbc + (size_t)j0 * 768 + h * 64 + pc * 8);
        xr[it][1] = *(const u32x4*)(xbc + (size_t)(j0 + 1) * 768 + h * 64 + pc * 8);
      }
      ssd_dt_load(p, cg_, h, dpre0, dpre1);
    };
    head_loads(g * 4);
#pragma unroll 1
    for (int hh = 0; hh < 4; ++hh) {
      const int h = g * 4 + hh;
      u32x4 hr[2][2];
      {
        const bf16_t* hp = (const bf16_t*)(p.ws + OFF_HP) + (size_t)(cg_ * 8 + h) * 2 * 4096;
#pragma unroll
        for (int it = 0; it < 2; ++it) { const int t = tid + 256 * it, r = t >> 3, c = (t & 7) * 8; hr[it][0] = *(const u32x4*)(hp + r * 64 + c); hr[it][1] = *(const u32x4*)(hp + 4096 + r * 64 + c); }
      }
      __syncthreads();
#pragma unroll
      for (int it = 0; it < 2; ++it) {
        const int t = tid + 256 * it, jp = t & 63, pc = t >> 6, j0 = 2 * jp;
        const u32x4 x0 = xr[it][0], x1 = xr[it][1];
#pragma unroll
        for (int e = 0; e < 4; ++e) {
          const int pr = pc * 8 + 2 * e;
          *(unsigned*)(XT + pr * PITCH128 + j0 * 2) = (x0[e] & 0xffffu) | (x1[e] << 16);
          *(unsigned*)(XT + (pr + 1) * PITCH128 + j0 * 2) = (x0[e] >> 16) | (x1[e] & 0xffff0000u);
        }
        const int r = t >> 3, c = (t & 7) * 8;
        *(u32x4*)(Hf + r * PITCH64 + c * 2) = hr[it][0];
        *(u32x4*)(Hb + r * PITCH64 + c * 2) = hr[it][1];
      }
      ssd_scalars_from(p, l, h, dpre0, dpre1, acf, sb, dtf, dtb);
      __syncthreads();
      if (hh < 3) head_loads(h + 1);
      const float aif = acf[i], aib = sb[i];
      f32x16 Y[2] = {zero16(), zero16()};
      int iv = i, hv = half;
      asm volatile("" : "+v"(iv), "+v"(hv));
      bf16x8 cfr[4];
#pragma unroll
      for (int s = 0; s < 4; ++s) cfr[s] = *(const bf16x8*)(Cs + i * PITCH64 + s * 32 + hv * 16);
      u32x2 xpre[8], zpre[8];
#pragma unroll
      for (int q8 = 0; q8 < 8; ++q8) {
        const int pc = (q8 >> 2) * 32 + 8 * (q8 & 3) + 4 * hv;
        xpre[q8] = *(const u32x2*)(xbc + (size_t)i * 768 + h * 64 + pc);
        zpre[q8] = *(const u32x2*)(proj + (size_t)tok * NPROJP + C_Z + h * 64 + pc);
      }
#pragma unroll 1
      for (int jb = 0; jb < 4; ++jb) {
        f32x16 G = zero16();
#pragma unroll
        for (int s = 0; s < 4; ++s) {
          const bf16x8 a = *(const bf16x8*)(Bs + (jb * 32 + l32) * PITCH64 + s * 32 + hv * 16);
          G = MFMA32(a, cfr[s], G);
        }
        f32x16 m;
#pragma unroll
        for (int q = 0; q < 4; ++q) {
          const int jq = jb * 32 + 8 * q + 4 * hv;
          const f32x4 af4 = *(const f32x4*)(acf + jq), sb4 = *(const f32x4*)(sb + jq), df4 = *(const f32x4*)(dtf + jq), db4 = *(const f32x4*)(dtb + jq);
#pragma unroll
          for (int e = 0; e < 4; ++e) {
            const int j = jq + e;
            const bool lo_ = j < iv;
            const float arg = lo_ ? (aif - af4[e]) : (aib - sb4[e]);
            const float dsel = lo_ ? df4[e] : db4[e];
            float wgt = __expf(arg) * dsel;
            wgt = (j == iv) ? (df4[e] + db4[e]) : wgt;
            m[4 * q + e] = G[4 * q + e] * wgt;
          }
        }
#pragma unroll
        for (int s = 0; s < 2; ++s) {
          u32x4 mf; mf[0] = pk2(m[8 * s], m[8 * s + 1]); mf[1] = pk2(m[8 * s + 2], m[8 * s + 3]); mf[2] = pk2(m[8 * s + 4], m[8 * s + 5]); mf[3] = pk2(m[8 * s + 6], m[8 * s + 7]);
          const bf16x8 mfr = __builtin_bit_cast(bf16x8, mf);
#pragma unroll
          for (int pb = 0; pb < 2; ++pb) {
            const char* xa = XT + (pb * 32 + l32) * PITCH128 + (jb * 32 + 16 * s + 4 * hv) * 2;
            u32x4 av; const u32x2 lo = *(const u32x2*)xa, hi = *(const u32x2*)(xa + 16);
            av[0] = lo[0]; av[1] = lo[1]; av[2] = hi[0]; av[3] = hi[1];
            Y[pb] = MFMA32(__builtin_bit_cast(bf16x8, av), mfr, Y[pb]);
          }
        }
      }
      {
        const float ef = __expf(aif), eb = __expf(aib);
#pragma unroll
        for (int pb = 0; pb < 2; ++pb) {
#pragma unroll
          for (int d = 0; d < 2; ++d) {
            f32x16 tf = zero16();
            const char* Hs = d ? Hb : Hf;
#pragma unroll
            for (int s = 0; s < 4; ++s) {
              const bf16x8 a = *(const bf16x8*)(Hs + (pb * 32 + l32) * PITCH64 + s * 32 + hv * 16);
              tf = MFMA32(a, cfr[s], tf);
            }
            const float ee = d ? eb : ef;
#pragma unroll
            for (int r = 0; r < 16; ++r) Y[pb][r] += ee * tf[r];
          }
        }
      }
      const float Dh = p.in[32][(size_t)l * 8 + h];
#pragma unroll
      for (int pb = 0; pb < 2; ++pb) {
        f32x16 yb;
#pragma unroll
        for (int q = 0; q < 4; ++q) {
          const u32x2 xv = xpre[pb * 4 + q];
          const u32x2 zv = zpre[pb * 4 + q];
          float y[4] = {Y[pb][4 * q] + Dh * bflo(xv[0]), Y[pb][4 * q + 1] + Dh * bfhi(xv[0]), Y[pb][4 * q + 2] + Dh * bflo(xv[1]), Y[pb][4 * q + 3] + Dh * bfhi(xv[1])};
          const float z[4] = {bflo(zv[0]), bfhi(zv[0]), bflo(zv[1]), bfhi(zv[1])};
#pragma unroll
          for (int e = 0; e < 4; ++e) { y[e] *= z[e] / (1.f + __expf(-z[e])); ssq += y[e] * y[e]; yb[4 * q + e] = y[e]; }
        }
        store_block_bf16(mix + (size_t)tok * 1024 + 512 + h * 64 + pb * 32, yb, half);
      }
    }
  }
  ssq += xor32(ssq);
  sc[512 + i] = ssq;
  __syncthreads();
  ssq += ((const float*)(lds_blk + (1 - g) * HALF_LDS + (2 * 128 * PITCH64 + 64 * PITCH128 + 2 * 64 * PITCH64)))[512 + i];
  const float rstd = rsqrtf(ssq * (1.f / 512.f) + EPS);
  const float* gn = p.in[33] + (size_t)l * 512;
  u32x4 vv[16];
#pragma unroll
  for (int e = 0; e < 16; ++e) {
    const int ch = (g * 4 + (e >> 2)) * 64 + ((e >> 1) & 1) * 32 + 16 * (e & 1) + 8 * half;
    vv[e] = *(const u32x4*)(mix + (size_t)tok * 1024 + 512 + ch);
  }
#pragma unroll
  for (int hq = 0; hq < 4; ++hq) {
    f32x4 gg[8];
#pragma unroll
    for (int e = 0; e < 4; ++e) {
      const int ch = (g * 4 + hq) * 64 + ((e >> 1) & 1) * 32 + 16 * (e & 1) + 8 * half;
      gg[2 * e] = *(const f32x4*)(gn + ch); gg[2 * e + 1] = *(const f32x4*)(gn + ch + 4);
    }
#pragma unroll
    for (int e = 0; e < 4; ++e) {
      const int ch = (g * 4 + hq) * 64 + ((e >> 1) & 1) * 32 + 16 * (e & 1) + 8 * half;
      const u32x4 v = vv[hq * 4 + e];
      u32x4 o;
      o[0] = pk2(bflo(v[0]) * rstd * gg[2 * e][0], bfhi(v[0]) * rstd * gg[2 * e][1]); o[1] = pk2(bflo(v[1]) * rstd * gg[2 * e][2], bfhi(v[1]) * rstd * gg[2 * e][3]);
      o[2] = pk2(bflo(v[2]) * rstd * gg[2 * e + 1][0], bfhi(v[2]) * rstd * gg[2 * e + 1][1]); o[3] = pk2(bflo(v[3]) * rstd * gg[2 * e + 1][2], bfhi(v[3]) * rstd * gg[2 * e + 1][3]);
      *(u32x4*)(mix + (size_t)tok * 1024 + 512 + ch) = o;
    }
  }
}

struct SeqInfo { int tok0, L, kbase, nk; };
DI SeqInfo seq_info(int s) { SeqInfo r; if (s < 16) { r.tok0 = s * 256; r.L = 256; r.kbase = s * 256; r.nk = 256; } else { r.tok0 = TP + (s - 16) * 2048; r.L = 2048; r.kbase = TP + (s - 16) * 2304; r.nk = 2304; } return r; }

DI void attn_mla_item(const Params& p, int item, char* lds) {
  const int tid = get_tid4(), lane = tid & 63, w = tid >> 6, l32 = lane & 31, half = lane >> 5;
  int seq, head, qb;
  if (item < 256) { seq = 16 + (item >> 6); head = (item >> 4) & 3; qb = item & 15; }
  else { const int it = item - 256; seq = it >> 3; head = (it >> 1) & 3; qb = it & 1; }
  const SeqInfo si = seq_info(seq);
  const int tok = si.tok0 + qb * 128 + w * 32 + l32;
  const bf16_t* qa = (const bf16_t*)(p.ws + OFF_QA) + (size_t)tok * 384 + head * 96;
  bf16x8 qf[6];
#pragma unroll
  for (int s = 0; s < 6; ++s) qf[s] = *(const bf16x8*)(qa + 16 * s + 8 * half);
  constexpr int KT = 64 * PITCH96, VT = 64 * PITCH64;
  char* Ks = lds; char* Vs = lds + 2 * KT;
  const bf16_t* kg = (const bf16_t*)(p.ws + OFF_KA) + (size_t)si.kbase * 384 + head * 96;
  const bf16_t* vg = (const bf16_t*)(p.ws + OFF_VAT) + (size_t)head * 64 * NKEY + si.kbase;
  u32x4 rk[3], rv[2];
  auto gload = [&](int t0) {
#pragma unroll
    for (int i = 0; i < 3; ++i) { const int c = tid + 256 * i, r = c / 12, cc = c % 12; rk[i] = *(const u32x4*)(kg + (size_t)(t0 + r) * 384 + cc * 8); }
#pragma unroll
    for (int i = 0; i < 2; ++i) { const int c = tid + 256 * i, r = c >> 3, cc = c & 7; rv[i] = *(const u32x4*)(vg + (size_t)r * NKEY + t0 + cc * 8); }
  };
  auto lstore = [&](int buf) {
#pragma unroll
    for (int i = 0; i < 3; ++i) { const int c = tid + 256 * i, r = c / 12, cc = c % 12; *(u32x4*)(Ks + buf * KT + r * PITCH96 + cc * 16) = rk[i]; }
#pragma unroll
    for (int i = 0; i < 2; ++i) { const int c = tid + 256 * i, r = c >> 3, cc = c & 7; *(u32x4*)(Vs + buf * VT + r * PITCH64 + cc * 16) = rv[i]; }
  };
  f32x16 O[2] = {zero16(), zero16()};
  float mrun = -1e30f, lsum = 0.f;
  const int nt = si.nk / 64;
  __syncthreads();
  gload(0); lstore(0);
  __syncthreads();
#pragma unroll 1
  for (int t = 0; t < nt; ++t) {
    const int cur = t & 1;
    if (t + 1 < nt) gload((t + 1) * 64);
    f32x16 S[2];
#pragma unroll
    for (int kb = 0; kb < 2; ++kb) {
      S[kb] = zero16();
#pragma unroll
      for (int s = 0; s < 6; ++s) {
        const bf16x8 a = *(const bf16x8*)(Ks + cur * KT + (kb * 32 + l32) * PITCH96 + s * 32 + half * 16);
        S[kb] = MFMA32(a, qf[s], S[kb]);
      }
    }
    float mx = S[0][0];
#pragma unroll
    for (int r = 0; r < 16; ++r) { mx = fmaxf(mx, S[0][r]); mx = fmaxf(mx, S[1][r]); }
    mx = fmaxf(mx, xor32(mx));
    if (__any(mx > mrun + 8.f)) {
      const float mnew = fmaxf(mrun, mx);
      const float alpha = __builtin_amdgcn_exp2f(mrun - mnew);
      mrun = mnew;
      lsum *= alpha;
#pragma unroll
      for (int r = 0; r < 16; ++r) { O[0][r] *= alpha; O[1][r] *= alpha; }
    }
    float ps = 0.f;
#pragma unroll
    for (int kb = 0; kb < 2; ++kb)
#pragma unroll
      for (int r = 0; r < 16; ++r) { const float e = __builtin_amdgcn_exp2f(S[kb][r] - mrun); S[kb][r] = e; ps += e; }
    lsum += ps;
#pragma unroll
    for (int kb = 0; kb < 2; ++kb)
#pragma unroll
      for (int s = 0; s < 2; ++s) {
        u32x4 pf; pf[0] = pk2(S[kb][8 * s], S[kb][8 * s + 1]); pf[1] = pk2(S[kb][8 * s + 2], S[kb][8 * s + 3]); pf[2] = pk2(S[kb][8 * s + 4], S[kb][8 * s + 5]); pf[3] = pk2(S[kb][8 * s + 6], S[kb][8 * s + 7]);
        const bf16x8 pfr = __builtin_bit_cast(bf16x8, pf);
#pragma unroll
        for (int dvb = 0; dvb < 2; ++dvb) {
          const char* va = Vs + cur * VT + (dvb * 32 + l32) * PITCH64 + (kb * 32 + 16 * s + 4 * half) * 2;
          u32x4 av; const u32x2 lo = *(const u32x2*)va, hi = *(const u32x2*)(va + 16);
          av[0] = lo[0]; av[1] = lo[1]; av[2] = hi[0]; av[3] = hi[1];
          O[dvb] = MFMA32(__builtin_bit_cast(bf16x8, av), pfr, O[dvb]);
        }
      }
    if (t + 1 < nt) lstore(cur ^ 1);
    __syncthreads();
  }
  lsum += xor32(lsum);
  const float inv = 1.f / lsum;
  bf16_t* mix = (bf16_t*)(p.ws + OFF_MIX) + (size_t)tok * 1024 + head * 64;
#pragma unroll
  for (int dvb = 0; dvb < 2; ++dvb) {
#pragma unroll
    for (int r = 0; r < 16; ++r) O[dvb][r] *= inv;
    store_block_bf16(mix + dvb * 32, O[dvb], half);
  }
}

constexpr int PITCH32 = 80;
DI void attn_diff_item(const Params& p, int l, int item, char* lds_blk) {
  const int tid = get_tid4(), lane = tid & 63, w = tid >> 6, l32 = lane & 31, half = lane >> 5;
  const int hbk = get_hb();
  char* lds = lds_blk + hbk * HALF_LDS;
  int seq, head, qb;
  if (item < 256) { seq = 16 + (item >> 6); head = (item >> 4) & 3; qb = item & 15; }
  else { const int it = item - 256; seq = it >> 3; head = (it >> 1) & 3; qb = it & 1; }
  const SeqInfo si = seq_info(seq);
  const int tok = si.tok0 + qb * 128 + w * 32 + l32;
  constexpr int KT = 64 * PITCH32, VT = 64 * PITCH64;
  char* Ks = lds; char* Vs = lds + 2 * KT;
  const bf16_t* vg = (const bf16_t*)(p.ws + OFF_VDT) + (size_t)head * 64 * NKEY + si.kbase;
  const int nt = si.nk / 64;
  const float lam_init = ((const float*)(p.ws + OFF_LAM))[l * 2 + 1];
  const float lam = ((const float*)(p.ws + OFF_LAM))[l * 2];
  f32x16 R[2] = {zero16(), zero16()};
#pragma unroll 1
  for (int mp = hbk; mp < hbk + 1; ++mp) {
    const bf16_t* qd = (const bf16_t*)(p.ws + OFF_QD) + (size_t)tok * 256 + head * 64 + mp * 32;
    bf16x8 qf[2];
#pragma unroll
    for (int s = 0; s < 2; ++s) qf[s] = *(const bf16x8*)(qd + 16 * s + 8 * half);
    const bf16_t* kg = (const bf16_t*)(p.ws + OFF_KD) + (size_t)si.kbase * 256 + head * 64 + mp * 32;
    u32x4 rk, rv[2];
    auto gload = [&](int t0) {
      rk = *(const u32x4*)(kg + (size_t)(t0 + (tid >> 2)) * 256 + (tid & 3) * 8);
#pragma unroll
      for (int i = 0; i < 2; ++i) { const int c = tid + 256 * i, r = c >> 3, cc = c & 7; rv[i] = *(const u32x4*)(vg + (size_t)r * NKEY + t0 + cc * 8); }
    };
    auto lstore = [&](int buf) {
      *(u32x4*)(Ks + buf * KT + (tid >> 2) * PITCH32 + (tid & 3) * 16) = rk;
#pragma unroll
      for (int i = 0; i < 2; ++i) { const int c = tid + 256 * i, r = c >> 3, cc = c & 7; *(u32x4*)(Vs + buf * VT + r * PITCH64 + cc * 16) = rv[i]; }
    };
    f32x16 O[2] = {zero16(), zero16()};
    float mrun = -1e30f, lsum = 0.f;
    __syncthreads();
    gload(0); lstore(0);
    __syncthreads();
#pragma unroll 1
    for (int t = 0; t < nt; ++t) {
      const int cur = t & 1;
      if (t + 1 < nt) gload((t + 1) * 64);
      f32x16 S[2];
#pragma unroll
      for (int kb = 0; kb < 2; ++kb) {
        S[kb] = zero16();
#pragma unroll
        for (int s = 0; s < 2; ++s) {
          const bf16x8 a = *(const bf16x8*)(Ks + cur * KT + (kb * 32 + l32) * PITCH32 + s * 32 + half * 16);
          S[kb] = MFMA32(a, qf[s], S[kb]);
        }
      }
      float mx = S[0][0];
#pragma unroll
      for (int r = 0; r < 16; ++r) { mx = fmaxf(mx, S[0][r]); mx = fmaxf(mx, S[1][r]); }
      mx = fmaxf(mx, xor32(mx));
      if (__any(mx > mrun + 8.f)) {
        const float mnew = fmaxf(mrun, mx);
        const float alpha = __builtin_amdgcn_exp2f(mrun - mnew);
        mrun = mnew;
        lsum *= alpha;
#pragma unroll
        for (int r = 0; r < 16; ++r) { O[0][r] *= alpha; O[1][r] *= alpha; }
      }
      float ps = 0.f;
#pragma unroll
      for (int kb = 0; kb < 2; ++kb)
#pragma unroll
        for (int r = 0; r < 16; ++r) { const float e = __builtin_amdgcn_exp2f(S[kb][r] - mrun); S[kb][r] = e; ps += e; }
      lsum += ps;
#pragma unroll
      for (int kb = 0; kb < 2; ++kb)
#pragma unroll
        for (int s = 0; s < 2; ++s) {
          u32x4 pf; pf[0] = pk2(S[kb][8 * s], S[kb][8 * s + 1]); pf[1] = pk2(S[kb][8 * s + 2], S[kb][8 * s + 3]); pf[2] = pk2(S[kb][8 * s + 4], S[kb][8 * s + 5]); pf[3] = pk2(S[kb][8 * s + 6], S[kb][8 * s + 7]);
          const bf16x8 pfr = __builtin_bit_cast(bf16x8, pf);
#pragma unroll
          for (int dvb = 0; dvb < 2; ++dvb) {
            const char* va = Vs + cur * VT + (dvb * 32 + l32) * PITCH64 + (kb * 32 + 16 * s + 4 * half) * 2;
            u32x4 av; const u32x2 lo = *(const u32x2*)va, hi = *(const u32x2*)(va + 16);
            av[0] = lo[0]; av[1] = lo[1]; av[2] = hi[0]; av[3] = hi[1];
            O[dvb] = MFMA32(__builtin_bit_cast(bf16x8, av), pfr, O[dvb]);
          }
        }
      if (t + 1 < nt) lstore(cur ^ 1);
      __syncthreads();
    }
    lsum += xor32(lsum);
    const float coef = (mp == 0) ? 1.f / lsum : -lam / lsum;
#pragma unroll
    for (int dvb = 0; dvb < 2; ++dvb)
#pragma unroll
      for (int r = 0; r < 16; ++r) R[dvb][r] += O[dvb][r] * coef;
  }
  {
    constexpr int XO = 32768;
    float* xo = (float*)(lds + XO);
    if (hbk == 1) {
#pragma unroll
      for (int dvb = 0; dvb < 2; ++dvb)
#pragma unroll
        for (int r = 0; r < 16; ++r) xo[((w * 2 + dvb) * 16 + r) * 64 + lane] = R[dvb][r];
    }
    __syncthreads();
    if (hbk == 1) return;
    const float* xi = (const float*)(lds_blk + HALF_LDS + XO);
#pragma unroll
    for (int dvb = 0; dvb < 2; ++dvb)
#pragma unroll
      for (int r = 0; r < 16; ++r) R[dvb][r] += xi[((w * 2 + dvb) * 16 + r) * 64 + lane];
  }
  float ss = sumsq16(R[0]) + sumsq16(R[1]);
  ss += xor32(ss);
  const float rstd = rsqrtf(ss * (1.f / 64.f) + EPS) * (1.f - lam_init);
  const float* gs = p.in[27] + (size_t)l * 64;
  bf16_t* mix = (bf16_t*)(p.ws + OFF_MIX) + (size_t)tok * 1024 + 256 + head * 64;
#pragma unroll
  for (int dvb = 0; dvb < 2; ++dvb) {
    { const f32x16 gb = gain_block(gs + dvb * 32, half);
#pragma unroll
      for (int r = 0; r < 16; ++r) R[dvb][r] *= rstd * gb[r]; }
    store_block_bf16(mix + dvb * 32, R[dvb], half);
  }
}

DI void run_phase(const Params& p, int ph, char* lds, int* s_item, int vb) {
#ifdef ONLY_SUB
  const int l = (ph - 1) / 10, sub = ONLY_SUB;
  if (ONLY_SUB == 10) { setup_phase(p, lds); return; }
#else
  if (ph == 0) { setup_phase(p, lds); return; }
  const int l = (ph - 1) / 10, sub = (ph - 1) % 10;
#endif
  const float* modl = (const float*)(p.ws + OFF_MOD) + (size_t)l * 5 * 6144;
  switch (sub) {
    case 0: norm_phase(p, l, 0); break;
    case 1: {
      EpiInProj epi{(bf16_t*)(p.ws + OFF_PROJ), (float*)(p.ws + OFF_DT)};
      const bf16_t* A = (const bf16_t*)(p.ws + OFF_HBUF);
      const bf16_t* Bt = (const bf16_t*)(p.ws + OFF_WIN) + (size_t)l * NPROJP * 1024;
      gemm_phase<256>(A, 1024, Bt, 1024, 1024, 48, 10, lds, vb, epi);
    } break;
    case 2: prep_phase(p, l, lds); break;
    case 3: {
      const int hb = get_hb();
      for (int pair = blockIdx.x; pair < NCHUNK * 4; pair += gridDim.x) ssd_states_item(p, l, pair * 2 + hb, lds + hb * HALF_LDS);
    } break;
    case 4: ssd_scan_phase(p, l); break;
    case 5: {
      unsigned* ctr = (unsigned*)(p.ws + OFF_CTR) + l;
      const int hb = get_hb();
      for (;;) {
        __syncthreads();
        if (threadIdx.x == 0) *s_item = (int)atomicAdd(ctr, 1u);
        __syncthreads();
        const int it = *s_item;
        if (it >= 672) break;
        if (it < 96) ssd_y_item(p, l, it, lds);
        else if (it < 224) attn_mla_item(p, (it - 96) * 2 + hb, lds + hb * HALF_LDS);
        else if (it < 480) attn_diff_item(p, l, it - 224, lds);
        else if (it < 544) attn_mla_item(p, 256 + (it - 480) * 2 + hb, lds + hb * HALF_LDS);
        else attn_diff_item(p, l, 256 + (it - 544), lds);
      }
    } break;
    case 6: {
      EpiResid epi{l == 0 ? p.in[0] : nullptr, l == 0 ? p.in[1] : nullptr, (bf16_t*)(p.ws + OFF_XB), nullptr, modl + 2048};
      const bf16_t* A = (const bf16_t*)(p.ws + OFF_MIX);
      const bf16_t* Bt = (const bf16_t*)(p.ws + OFF_WOUT) + (size_t)l * 1024 * 1024;
      gemm_phase<192>(A, 1024, Bt, 1024, 1024, 64, 4, lds, vb, epi);
    } break;
    case 7: norm_phase(p, l, 1); break;
    case 8: {
      EpiFF1 epi{(bf16_t*)(p.ws + OFF_UBUF)};
      const bf16_t* A = (const bf16_t*)(p.ws + OFF_HBUF);
      const bf16_t* Bt = (const bf16_t*)(p.ws + OFF_WFF1) + (size_t)l * 4096 * 1024;
      gemm_phase<256>(A, 1024, Bt, 1024, 1024, 48, 16, lds, vb, epi);
    } break;
    case 9: {
      EpiResid epi{nullptr, nullptr, (bf16_t*)(p.ws + OFF_XB), l == DEPTH - 1 ? p.out : nullptr, modl + 5120};
      const bf16_t* A = (const bf16_t*)(p.ws + OFF_UBUF);
      const bf16_t* Bt = (const bf16_t*)(p.ws + OFF_WFF2) + (size_t)l * 1024 * 4096;
      gemm_phase<192>(A, 4096, Bt, 4096, 4096, 64, 4, lds, vb, epi);
    } break;
  }
}

constexpr int N_PHASES = 1 + 10 * DEPTH;

__global__ void __launch_bounds__(512, 2) fwd_megakernel(Params p) {
  __shared__ __attribute__((aligned(1024))) char lds[LDS_BYTES + 64];
  uint4& xb_words = *(uint4*)(lds + LDS_BYTES);
  int* s_item = (int*)(lds + LDS_BYTES + 16);
  if (p.ph_end - p.ph_begin == 1) { run_phase(p, p.ph_begin, lds, s_item, blockIdx.x); return; }
  if (p.ph_begin < 0) { cg::this_grid().sync(); return; }
  if (threadIdx.x == 0) xb_words = make_uint4(0u, 0u, 0u, 0u);
  __syncthreads();
  XcdBarrier b = xcd_barrier_post((unsigned*)(p.ws + OFF_BAR), (volatile LAS unsigned*)&xb_words);
  const int vb = blockIdx.x;
  for (int ph = p.ph_begin; ph < p.ph_end; ++ph) {
    run_phase(p, ph, lds, s_item, vb);
    if (ph + 1 < p.ph_end) xcd_barrier(b);
  }
}

extern "C" void kernel_launch(void* const* d_in, const int* in_sizes, int n_in, void* d_out, int out_size, void* d_ws, size_t ws_size, hipStream_t stream) {
  static int grid_blocks = 0;
  if (!grid_blocks) {
    int dev = 0, cus = 0, per_cu = 0;
    (void)hipGetDevice(&dev);
    (void)hipDeviceGetAttribute(&cus, hipDeviceAttributeMultiprocessorCount, dev);
    (void)hipOccupancyMaxActiveBlocksPerMultiprocessor(&per_cu, fwd_megakernel, 512, 0);
    if (per_cu > 1) per_cu = 1;
    if (per_cu < 1) per_cu = 1;
    grid_blocks = cus * per_cu;
  }
  Params p{};
  for (int i = 0; i < 36; ++i) p.in[i] = (const float*)d_in[i];
  p.out = (float*)d_out;
  p.ws = (char*)d_ws;
  (void)hipMemsetAsync(d_ws, 0, 16384, stream);
#if MULTI_LAUNCH
  for (int ph = 0; ph < N_PHASES; ++ph) {
    p.ph_begin = ph; p.ph_end = ph + 1;
    hipLaunchKernelGGL(fwd_megakernel, dim3(grid_blocks), dim3(512), 0, stream, p);
  }
#else
  p.ph_begin = 0; p.ph_end = N_PHASES;
  void* args[] = {&p};
  hipError_t e = hipLaunchCooperativeKernel((void*)fwd_megakernel, dim3(grid_blocks), dim3(512), args, 0, stream);
  if (e != hipSuccess) fprintf(stderr, "cooperative launch failed: %s (grid %d)\n", hipGetErrorString(e), grid_blocks);
#endif
}
```

```cpp
#include <hip/hip_runtime.h>
#include <hip/hip_cooperative_groups.h>
#include <stdint.h>
#include <stdio.h>
namespace cg = cooperative_groups;

#ifndef MULTI_LAUNCH
#define MULTI_LAUNCH 0
#endif

#define DI __device__ __forceinline__
#define LAS __attribute__((address_space(3)))
typedef unsigned short bf16_t;
typedef short bf16x8 __attribute__((ext_vector_type(8)));
typedef short s16x4 __attribute__((ext_vector_type(4)));
typedef float f32x16 __attribute__((ext_vector_type(16)));
typedef float f32x4 __attribute__((ext_vector_type(4)));
typedef unsigned u32x4 __attribute__((ext_vector_type(4)));
typedef unsigned u32x2 __attribute__((ext_vector_type(2)));
#define MFMA32(a, b, c) __builtin_amdgcn_mfma_f32_32x32x16_bf16((a), (b), (c), 0, 0, 0)

constexpr int D = 1024, TP = 4096, TS = 8192, T = 12288, DEPTH = 4, PAST = 256;
constexpr int NPROJ = 2480, NPROJP = 2560, DFF = 4096;
constexpr int NKEY = 4096 + 4 * 2304;
constexpr int C_CQ = 0, C_CKV = 256, C_KR = 384, C_DQ = 416, C_DK = 672, C_DV = 928, C_Z = 1184, C_XBC = 1696, C_DT = 2464;
constexpr float EPS = 1e-6f;
constexpr int NCHUNK = 96;

constexpr size_t O_Y = 0, O_CKV = 12582912, O_KROPE = 14680064, O_DK = 15204352, O_DV = 19398656, O_SSM = 23592960;

constexpr size_t OFF_BAR = 0;
constexpr size_t OFF_XRANK = 14080;
constexpr size_t OFF_CTR = 14336;
constexpr size_t OFF_LAM = 15360;
constexpr size_t OFF_MOD = 16384;
constexpr size_t OFF_ROPE = OFF_MOD + 4ull * 5 * 6144 * 4;
constexpr size_t OFF_WIN = OFF_ROPE + 2048ull * 32 * 4;
constexpr size_t OFF_WOUT = OFF_WIN + 4ull * NPROJP * 1024 * 2;
constexpr size_t OFF_WFF1 = OFF_WOUT + 4ull * 1024 * 1024 * 2;
constexpr size_t OFF_WFF2 = OFF_WFF1 + 4ull * 4096 * 1024 * 2;
constexpr size_t OFF_WUQ = OFF_WFF2 + 4ull * 4096 * 1024 * 2;
constexpr size_t OFF_WUKV = OFF_WUQ + 4ull * 384 * 256 * 2;
constexpr size_t OFF_HBUF = OFF_WUKV + 4ull * 512 * 128 * 2;
constexpr size_t OFF_MIX = OFF_HBUF + (size_t)T * 1024 * 2;
constexpr size_t OFF_DT = OFF_MIX + (size_t)T * 1024 * 2;
constexpr size_t OFF_R = OFF_DT + (size_t)T * 16 * 4;
constexpr size_t OFF_UBUF = OFF_R;
constexpr size_t OFF_PROJ = OFF_R;
constexpr size_t OFF_QA = OFF_PROJ + (size_t)T * NPROJP * 2;
constexpr size_t OFF_KA = OFF_QA + (size_t)T * 384 * 2;
constexpr size_t OFF_VAT = OFF_KA + (size_t)NKEY * 384 * 2;
constexpr size_t OFF_QD = OFF_VAT + 256ull * NKEY * 2;
constexpr size_t OFF_KD = OFF_QD + (size_t)T * 256 * 2;
constexpr size_t OFF_VDT = OFF_KD + (size_t)NKEY * 256 * 2;
constexpr size_t OFF_XBC = OFF_VDT + 256ull * NKEY * 2;
constexpr size_t OFF_ST = OFF_XBC + (size_t)T * 768 * 2;
constexpr size_t OFF_HP = OFF_ST + 96ull * 8 * 2 * 4096 * 4;
constexpr size_t OFF_CDEC = OFF_HP + 96ull * 8 * 2 * 4096 * 2;
constexpr size_t OFF_XB = OFF_CDEC + 96ull * 16 * 4;
constexpr size_t WS_END = OFF_XB + (size_t)T * 1024 * 2;

struct Params {
  const float* in[36];
  float* out;
  char* ws;
  int ph_begin, ph_end;
};

DI unsigned pk2(float lo, float hi) { unsigned r; asm("v_cvt_pk_bf16_f32 %0, %1, %2" : "=v"(r) : "v"(lo), "v"(hi)); return r; }
DI float bflo(unsigned u) { return __uint_as_float(u << 16); }
DI float bfhi(unsigned u) { return __uint_as_float(u & 0xffff0000u); }
DI float bf1(bf16_t h) { return __uint_as_float(((unsigned)h) << 16); }
DI bf16_t f2bf(float x) { return (bf16_t)(pk2(x, 0.f) & 0xffffu); }
DI int crow(int r, int half) { return (r & 3) + 8 * (r >> 2) + 4 * half; }
DI float xor32(float v) { return __shfl_xor(v, 32); }
DI float wave_sum(float v) {
#pragma unroll
  for (int o = 32; o > 0; o >>= 1) v += __shfl_xor(v, o);
  return v;
}
DI f32x16 zero16() { f32x16 z; for (int i = 0; i < 16; ++i) z[i] = 0.f; return z; }
DI int get_tid() { int t = threadIdx.x; asm volatile("" : "+v"(t)); return t; }
DI int get_tid4() { return get_tid() & 255; }
DI int get_hb() { return get_tid() >> 8; }
DI int modrow_of(int m) { return m < TP ? 0 : 1 + ((m - TP) >> 11); }

#define XB_TMO      128
#define XB_XCNT(j)  (256  + 64 * (j))
#define XB_XSUB(j)  (1280 + 64 * (j))
#define XB_XGEN(j)  (2304 + 64 * (j))
#define XB_TOP      3328
#define XB_TOPGEN   3392
#define XCD_BAR_WORDS 3456
#define XB_SPIN_CAP (1u << 22)
DI unsigned xb_ld(unsigned* p) { return __hip_atomic_load(p, __ATOMIC_RELAXED, __HIP_MEMORY_SCOPE_AGENT); }
DI unsigned xb_add(unsigned* p, unsigned v) { return __hip_atomic_fetch_add(p, v, __ATOMIC_RELAXED, __HIP_MEMORY_SCOPE_AGENT); }
DI unsigned xb_xcc_id() { return (unsigned)__builtin_amdgcn_s_getreg((3 << 11) | 20) & 0xFu; }
#define XB_SPIN(cond, bar) do { unsigned _sp = 0; while (cond) { __builtin_amdgcn_s_sleep(1); \
    if ((++_sp & 255u) == 0u) { if (xb_ld(&(bar)[XB_TMO])) break; if (_sp > XB_SPIN_CAP) { atomicAdd(&(bar)[XB_TMO], 1u); break; } } } } while (0)
struct XcdBarrier { unsigned* bar; unsigned x; volatile LAS unsigned* st; };
DI XcdBarrier xcd_barrier_post(unsigned* bar, volatile LAS unsigned* st) {
  XcdBarrier b; b.bar = bar; b.x = xb_xcc_id(); b.st = st;
  if (threadIdx.x == 0) (void)xb_add(&bar[XB_XCNT(b.x)], 1u);
  return b;
}
DI void xcd_barrier_complete(unsigned* bar, unsigned x, unsigned& nloc, unsigned& nx) {
  const unsigned G = gridDim.x * gridDim.y * gridDim.z;
  unsigned sum, cnt, mine, sp = 0u;
  for (;;) {
    sum = 0u; cnt = 0u; mine = 0u;
#pragma unroll
    for (unsigned j = 0; j < 16; ++j) { const unsigned c = xb_ld(&bar[XB_XCNT(j)]); sum += c; cnt += (c > 0u) ? 1u : 0u; mine = (j == x) ? c : mine; }
    if (sum == G) break;
    __builtin_amdgcn_s_sleep(1);
    if ((++sp & 255u) == 0u) { if (xb_ld(&bar[XB_TMO])) break; if (sp > XB_SPIN_CAP) { atomicAdd(&bar[XB_TMO], 1u); break; } }
  }
  nloc = mine > 0u ? mine : 1u; nx = cnt > 0u ? cnt : 1u;
}
DI void xcd_barrier(const XcdBarrier& b) {
  asm volatile("s_waitcnt vmcnt(0)" ::: "memory");
  __syncthreads();
  if (threadIdx.x == 0) {
    unsigned* bar = b.bar;
    __builtin_amdgcn_s_waitcnt(0);
    unsigned nloc = b.st[0], nx = b.st[1];
    if (nloc == 0u) { xcd_barrier_complete(bar, b.x, nloc, nx); b.st[0] = nloc; b.st[1] = nx; }
    const unsigned old = xb_add(&bar[XB_XSUB(b.x)], 1u);
    const unsigned gen = old / nloc;
    if (old + 1u == (gen + 1u) * nloc) {
      __builtin_amdgcn_fence(__ATOMIC_RELEASE, "agent");
      asm volatile("s_waitcnt vmcnt(0)" ::: "memory");
      const unsigned og = xb_add(&bar[XB_TOP], 1u);
      const unsigned tg = og / nx;
      if (og + 1u == (tg + 1u) * nx) xb_add(&bar[XB_TOPGEN], 1u);
      else XB_SPIN(xb_ld(&bar[XB_TOPGEN]) == tg, bar);
      __builtin_amdgcn_fence(__ATOMIC_ACQUIRE, "agent");
      xb_add(&bar[XB_XGEN(b.x)], 1u);
      asm volatile("s_waitcnt vmcnt(0)" ::: "memory");
    } else {
      XB_SPIN(xb_ld(&bar[XB_XGEN(b.x)]) == gen, bar);
      __builtin_amdgcn_fence(__ATOMIC_ACQUIRE, "agent");
      asm volatile("s_waitcnt vmcnt(0)" ::: "memory");
    }
  }
  __syncthreads();
}

constexpr int HALF_LDS = 75776;
constexpr int LDS_BYTES = 2 * HALF_LDS;
constexpr int PITCH64 = 144;
constexpr int PITCH128 = 272;
constexpr int PITCH96 = 208;

DI void transpose_tile4(const float* src, int K, int N, bf16_t* dst, int t0, int ncols, char* lds) {
  float* tile = (float*)lds;
  const int tid = get_tid4();
  f32x4 v[4][4];
#pragma unroll
  for (int q = 0; q < 4; ++q) {
    const int k0 = ((t0 + q) / ncols) * 64, n0 = ((t0 + q) % ncols) * 64;
#pragma unroll
    for (int i = 0; i < 4; ++i) {
      const int r = (tid >> 4) + 16 * i, c4 = (tid & 15) * 4;
      v[q][i] = (f32x4){0.f, 0.f, 0.f, 0.f};
      if (n0 + c4 < N) v[q][i] = *(const f32x4*)(src + (size_t)(k0 + r) * N + n0 + c4);
    }
  }
  __syncthreads();
#pragma unroll
  for (int q = 0; q < 4; ++q)
#pragma unroll
    for (int i = 0; i < 4; ++i) {
      const int r = (tid >> 4) + 16 * i, c4 = (tid & 15) * 4;
      float* t = tile + q * (64 * 65) + r * 65 + c4;
      t[0] = v[q][i][0]; t[1] = v[q][i][1]; t[2] = v[q][i][2]; t[3] = v[q][i][3];
    }
  __syncthreads();
#pragma unroll
  for (int q = 0; q < 4; ++q) {
    const int k0 = ((t0 + q) / ncols) * 64, n0 = ((t0 + q) % ncols) * 64;
    const float* tq = tile + q * (64 * 65);
#pragma unroll
    for (int i = 0; i < 2; ++i) {
      const int n = (tid >> 3) + 32 * i, kc = (tid & 7) * 8;
      u32x4 w;
      w[0] = pk2(tq[(kc + 0) * 65 + n], tq[(kc + 1) * 65 + n]);
      w[1] = pk2(tq[(kc + 2) * 65 + n], tq[(kc + 3) * 65 + n]);
      w[2] = pk2(tq[(kc + 4) * 65 + n], tq[(kc + 5) * 65 + n]);
      w[3] = pk2(tq[(kc + 6) * 65 + n], tq[(kc + 7) * 65 + n]);
      *(u32x4*)(dst + (size_t)(n0 + n) * K + k0 + kc) = w;
    }
  }
}

DI void mod_item(const Params& p, int item, char* lds) {
  float* sc = (float*)lds;
  float* red = sc + 5 * 1024;
  const int tid = get_tid4(), lane = tid & 63, w = tid >> 6;
  const int l = item / 96, j0 = (item % 96) * 64;
  __syncthreads();
  for (int i = tid; i < 5 * 1024; i += 256) {
    const int r = i >> 10, k = i & 1023;
    const float v = (r == 0) ? p.in[8][k] : p.in[7][(r - 1) * 1024 + k];
    sc[i] = v / (1.f + __expf(-v));
  }
  __syncthreads();
  const float* W = p.in[11] + (size_t)l * 1024 * 6144 + j0 + lane;
  float a0 = 0.f, a1 = 0.f, a2 = 0.f, a3 = 0.f, a4 = 0.f;
  const int kb = w * 256;
#pragma unroll 32
  for (int k = 0; k < 256; ++k) {
    const float wv = W[(size_t)(kb + k) * 6144];
    a0 += sc[kb + k] * wv; a1 += sc[1024 + kb + k] * wv; a2 += sc[2048 + kb + k] * wv; a3 += sc[3072 + kb + k] * wv; a4 += sc[4096 + kb + k] * wv;
  }
  red[(w * 5 + 0) * 64 + lane] = a0; red[(w * 5 + 1) * 64 + lane] = a1; red[(w * 5 + 2) * 64 + lane] = a2;
  red[(w * 5 + 3) * 64 + lane] = a3; red[(w * 5 + 4) * 64 + lane] = a4;
  __syncthreads();
  for (int i = tid; i < 320; i += 256) {
    const int r = i / 64, c = i % 64;
    const float s = red[(0 * 5 + r) * 64 + c] + red[(1 * 5 + r) * 64 + c] + red[(2 * 5 + r) * 64 + c] + red[(3 * 5 + r) * 64 + c];
    float* mod = (float*)(p.ws + OFF_MOD);
    mod[((size_t)l * 5 + r) * 6144 + j0 + c] = s + p.in[12][(size_t)l * 6144 + j0 + c];
  }
}

DI void setup_phase(const Params& p, char* lds) {
  constexpr int N_IN = 16 * 40 / 4, N_OUT = 16 * 16 / 4, N_F1 = 16 * 64 / 4, N_F2 = 64 * 16 / 4, N_UQ = 4 * 6 / 4, N_UKV = 2 * 8 / 4;
  constexpr int PER_L = N_IN + N_OUT + N_F1 + N_F2 + N_UQ + N_UKV;
  constexpr int N_TR = PER_L * 4, N_MOD = 384, N_ROPE = 64;
  static_assert((N_MOD + N_TR) % 2 == 0, "pairing");
  if (blockIdx.x == 0 && get_tid() < 4) {
    const int l = get_tid();
    float d1 = 0.f, d2 = 0.f;
    for (int k = 0; k < 32; ++k) { d1 += p.in[23][l * 32 + k] * p.in[24][l * 32 + k]; d2 += p.in[25][l * 32 + k] * p.in[26][l * 32 + k]; }
    const float lam_init = 0.8f - 0.6f * expf(-0.3f * (float)l);
    float* lamp = (float*)(p.ws + OFF_LAM);
    lamp[l * 2] = expf(d1) - expf(d2) + lam_init; lamp[l * 2 + 1] = lam_init;
  }
  const int hb = get_hb();
  lds += hb * HALF_LDS;
  for (int pair = blockIdx.x; pair < (N_MOD + N_TR) / 2; pair += gridDim.x) {
    const int item = pair * 2 + hb;
    if (item < N_MOD) { mod_item(p, item, lds); continue; }
    int it = item - N_MOD;
    {
      const int l = it / PER_L; int r = it % PER_L;
      if (r < N_IN) { transpose_tile4(p.in[13] + (size_t)l * 1024 * NPROJ, 1024, NPROJ, (bf16_t*)(p.ws + OFF_WIN) + (size_t)l * NPROJP * 1024, r * 4, 40, lds); continue; }
      r -= N_IN;
      if (r < N_OUT) { transpose_tile4(p.in[14] + (size_t)l * 1024 * 1024, 1024, 1024, (bf16_t*)(p.ws + OFF_WOUT) + (size_t)l * 1024 * 1024, r * 4, 16, lds); continue; }
      r -= N_OUT;
      if (r < N_F1) { transpose_tile4(p.in[34] + (size_t)l * 1024 * 4096, 1024, 4096, (bf16_t*)(p.ws + OFF_WFF1) + (size_t)l * 4096 * 1024, r * 4, 64, lds); continue; }
      r -= N_F1;
      if (r < N_F2) { transpose_tile4(p.in[35] + (size_t)l * 4096 * 1024, 4096, 1024, (bf16_t*)(p.ws + OFF_WFF2) + (size_t)l * 1024 * 4096, r * 4, 16, lds); continue; }
      r -= N_F2;
      if (r < N_UQ) { transpose_tile4(p.in[17] + (size_t)l * 256 * 384, 256, 384, (bf16_t*)(p.ws + OFF_WUQ) + (size_t)l * 384 * 256, r * 4, 6, lds); continue; }
      r -= N_UQ;
      transpose_tile4(p.in[18] + (size_t)l * 128 * 512, 128, 512, (bf16_t*)(p.ws + OFF_WUKV) + (size_t)l * 512 * 128, r * 4, 8, lds);
    }
  }
  for (int it = blockIdx.x; it < N_ROPE; it += gridDim.x) {
    {
      const int idx = it * 512 + get_tid();
      const int pos = idx >> 4, j = idx & 15;
      const float fr = __builtin_amdgcn_exp2f(-(float)(j & 7) * (13.287712379549449f / 8.f));
      const float base = (j < 8) ? (float)(pos >> 6) : (float)(pos & 63);
      float rev = base * fr * 0.15915494309189535f;
      rev -= floorf(rev);
      float* tab = (float*)(p.ws + OFF_ROPE);
      tab[idx * 2 + 0] = __builtin_amdgcn_cosf(rev);
      tab[idx * 2 + 1] = __builtin_amdgcn_sinf(rev);
    }
  }
}

DI const float* x_row_in(const Params& p, int l, int m) {
  if (l == 0) return m < TP ? p.in[0] + (size_t)m * D : p.in[1] + (size_t)(m - TP) * D;
  return p.out + (size_t)m * D;
}
DI void norm_phase(const Params& p, int l, int which) {
  const int tid = get_tid(), lane = tid & 63, w = tid >> 6;
  const float* g = p.in[which == 0 ? 9 : 10] + (size_t)l * D;
  const float* modl = (const float*)(p.ws + OFF_MOD) + (size_t)l * 5 * 6144;
  bf16_t* hbuf = (bf16_t*)(p.ws + OFF_HBUF);
  constexpr int RW = 6;
  for (int item = blockIdx.x; item < T / (8 * RW); item += gridDim.x) {
    const int m0 = item * 8 * RW + w * RW;
    f32x4 v[RW][4];
#pragma unroll
    for (int rr = 0; rr < RW; ++rr) {
      if (which == 0 && l == 0) {
        const float* x = x_row_in(p, 0, m0 + rr);
#pragma unroll
        for (int i = 0; i < 4; ++i) v[rr][i] = *(const f32x4*)(x + i * 256 + lane * 4);
      } else {
        const bf16_t* x = (const bf16_t*)(p.ws + OFF_XB) + (size_t)(m0 + rr) * D;
#pragma unroll
        for (int i = 0; i < 4; ++i) { const u32x2 r = *(const u32x2*)(x + i * 256 + lane * 4); v[rr][i] = (f32x4){bflo(r[0]), bfhi(r[0]), bflo(r[1]), bfhi(r[1])}; }
      }
    }
    f32x4 gg[4];
#pragma unroll
    for (int i = 0; i < 4; ++i) gg[i] = *(const f32x4*)(g + i * 256 + lane * 4);
#pragma unroll
    for (int rr = 0; rr < RW; ++rr) {
      const int m = m0 + rr;
      const float* mod = modl + (size_t)modrow_of(m) * 6144 + (which == 0 ? 0 : 3072);
      float ss = 0.f;
#pragma unroll
      for (int i = 0; i < 4; ++i) ss += v[rr][i][0] * v[rr][i][0] + v[rr][i][1] * v[rr][i][1] + v[rr][i][2] * v[rr][i][2] + v[rr][i][3] * v[rr][i][3];
      ss = wave_sum(ss);
      const float rstd = rsqrtf(ss * (1.f / D) + EPS);
#pragma unroll
      for (int i = 0; i < 4; ++i) {
        const int c = i * 256 + lane * 4;
        const f32x4 sh = *(const f32x4*)(mod + c), scl = *(const f32x4*)(mod + 1024 + c);
        float o[4];
#pragma unroll
        for (int e = 0; e < 4; ++e) o[e] = v[rr][i][e] * rstd * gg[i][e] * (1.f + scl[e]) + sh[e];
        u32x2 wv; wv[0] = pk2(o[0], o[1]); wv[1] = pk2(o[2], o[3]);
        *(u32x2*)(hbuf + (size_t)m * D + c) = wv;
      }
    }
  }
}

DI int lds_byte2(int r, int c) { const int st = (r >> 4) * 2 + (c >> 5), ob = (r & 15) * 64 + (c & 31) * 2; return st * 1024 + (ob ^ (((ob >> 9) & 1) << 5)); }
DI void stage_rc2(int b, int& R, int& C) { const int st = b >> 10, sb = b & 1023, swz = sb ^ (((sb >> 9) & 1) << 5); R = (st >> 1) * 16 + swz / 64; C = (st & 1) * 32 + (swz % 64) / 2; }
#define WAIT_V0() asm volatile("s_waitcnt vmcnt(0)" ::: "memory")
DI bool unit_next(int vb, int i, int nM, int nN, int& pm, int& pn) {
  const int nwg = nM * nN;
  const long L = (long)i * gridDim.x + vb; if (L >= nwg) return false;
  int wgid = (int)L; { const int q = nwg / 8, r = nwg % 8, xcd = wgid % 8, off = wgid / 8; wgid = (xcd < r ? xcd * (q + 1) : r * (q + 1) + (xcd - r) * q) + off; }
  const int nig = 8 * nN, gid = wgid / nig, fm = gid * 8, gsz = (nM - fm) < 8 ? (nM - fm) : 8;
  pm = fm + ((wgid % nig) % gsz); pn = (wgid % nig) / gsz; return true;
}
template <int BM, class Epi>
DI void gemm_phase(const bf16_t* __restrict__ A, int lda, const bf16_t* __restrict__ Bt, int ldb, int K, int nM, int nN, char* shm, int vb, Epi epi) {
  constexpr int BK = 64, TILE_B = 256 * BK * 2, GL = 4, STAGE_B = 2 * TILE_B, GLA = BM / 64, MB = BM / 32;
  const int tid = get_tid(), wid = tid >> 6, lane = tid & 63, wr = wid >> 2, wc = wid & 3, fr = lane & 15, fq = lane >> 4;
  int sR[GL], sC[GL];
#pragma unroll
  for (int i = 0; i < GL; ++i) stage_rc2(wid * 1024 + i * 8192 + lane * 16, sR[i], sC[i]);
  const int lo_ = (fr * 64 + fq * 16) ^ ((fr >> 3) << 5);
  const int aoff = wr * (BM / 32) * 2048 + lo_, boff = TILE_B + wc * 8192 + lo_;
  int sRB[GL];
#pragma unroll
  for (int i = 0; i < GL; ++i) { const int rho = sR[i] & 31, nn = rho >> 4, ii = rho & 15; sRB[i] = (sR[i] & ~31) + 8 * (ii >> 2) + 4 * nn + (ii & 3); }
#define SA_(b) (shm + (b) * STAGE_B)
#define SB_(b) (shm + (b) * STAGE_B + TILE_B)
#define GLDS_STAGE(buf, Ab_, Bb_, kt) do { _Pragma("unroll") for (int i = 0; i < GL; ++i) { \
    if (i < GLA) __builtin_amdgcn_global_load_lds((const unsigned*)((Ab_) + (size_t)sR[i] * lda + (kt) * BK + sC[i]), (LAS unsigned*)(SA_(buf) + wid * 1024 + i * 8192), 16, 0, 0); \
    __builtin_amdgcn_global_load_lds((const unsigned*)((Bb_) + (size_t)sRB[i] * ldb + (kt) * BK + sC[i]), (LAS unsigned*)(SB_(buf) + wid * 1024 + i * 8192), 16, 0, 0); } } while (0)
  int pm, pn;
  if (!unit_next(vb, 0, nM, nN, pm, pn)) return;
  const int nt = K / BK;
  GLDS_STAGE(0, A + (size_t)pm * BM * lda, Bt + (size_t)pn * 256 * ldb, 0);
#pragma unroll 1
  for (int ui = 0;; ++ui) {
    int npm = 0, npn = 0;
    const bool hn = unit_next(vb, ui + 1, nM, nN, npm, npn);
    f32x4 acc[MB][4];
#pragma unroll
    for (int m = 0; m < MB; ++m)
#pragma unroll
      for (int n = 0; n < 4; ++n) acc[m][n] = (f32x4){0.f, 0.f, 0.f, 0.f};
    WAIT_V0(); __syncthreads();
#pragma unroll 1
    for (int t = 0; t < nt; ++t) {
      const int cur = t & 1;
      {
        const bool last = t + 1 >= nt;
        if (!last || hn) {
          const bf16_t* Ab = A + (size_t)(last ? npm : pm) * BM * lda + (last ? 0 : (t + 1) * BK);
          const bf16_t* Bb = Bt + (size_t)(last ? npn : pn) * 256 * ldb + (last ? 0 : (t + 1) * BK);
          GLDS_STAGE(cur ^ 1, Ab, Bb, 0);
        }
      }
      if constexpr (BM == 192) {
        bf16x8 At[2][MB], Bf[2][4];
#pragma unroll
        for (int ks = 0; ks < 2; ++ks) {
#pragma unroll
          for (int n = 0; n < 4; ++n) Bf[ks][n] = *(const bf16x8*)(shm + cur * STAGE_B + boff + (n * 2 + ks) * 1024);
#pragma unroll
          for (int m = 0; m < MB; ++m) At[ks][m] = *(const bf16x8*)(shm + cur * STAGE_B + aoff + (m * 2 + ks) * 1024);
          __builtin_amdgcn_sched_barrier(0);
        }
#pragma unroll
        for (int ks = 0; ks < 2; ++ks) {
#pragma unroll
          for (int m = 0; m < MB; ++m)
#pragma unroll
            for (int n = 0; n < 4; ++n) acc[m][n] = __builtin_amdgcn_mfma_f32_16x16x32_bf16(Bf[ks][n], At[ks][m], acc[m][n], 0, 0, 0);
          __builtin_amdgcn_sched_barrier(0);
        }
      } else {
#pragma unroll
        for (int ks = 0; ks < 2; ++ks) {
          bf16x8 At[MB], Bf[4];
#pragma unroll
          for (int n = 0; n < 4; ++n) Bf[n] = *(const bf16x8*)(shm + cur * STAGE_B + boff + (n * 2 + ks) * 1024);
#pragma unroll
          for (int m = 0; m < MB; ++m) At[m] = *(const bf16x8*)(shm + cur * STAGE_B + aoff + (m * 2 + ks) * 1024);
          __builtin_amdgcn_sched_barrier(0);
#pragma unroll
          for (int m = 0; m < MB; ++m)
#pragma unroll
            for (int n = 0; n < 4; ++n) acc[m][n] = __builtin_amdgcn_mfma_f32_16x16x32_bf16(Bf[n], At[m], acc[m][n], 0, 0, 0);
          __builtin_amdgcn_sched_barrier(0);
        }
      }
      if (t + 1 < nt) { WAIT_V0(); __syncthreads(); }
    }
    const int brow = pm * BM, bcol = pn * 256;
    if constexpr (Epi::PRELOAD) {
      u32x4 xr[MB][2];
#pragma unroll
      for (int m = 0; m < MB; ++m)
#pragma unroll
        for (int g2 = 0; g2 < 2; ++g2) xr[m][g2] = epi.preload(brow + wr * (BM / 2) + m * 16 + fr, bcol + wc * 64 + g2 * 32 + fq * 8);
#pragma unroll
      for (int m = 0; m < MB; ++m)
#pragma unroll
        for (int g2 = 0; g2 < 2; ++g2) epi(brow + wr * (BM / 2) + m * 16 + fr, bcol + wc * 64 + g2 * 32 + fq * 8, acc[m][2 * g2], acc[m][2 * g2 + 1], xr[m][g2]);
    } else {
#pragma unroll
      for (int m = 0; m < MB; ++m)
#pragma unroll
        for (int g2 = 0; g2 < 2; ++g2) epi(brow + wr * (BM / 2) + m * 16 + fr, bcol + wc * 64 + g2 * 32 + fq * 8, acc[m][2 * g2], acc[m][2 * g2 + 1]);
    }
    if (!hn) break;
    pm = npm; pn = npn;
  }
  __syncthreads();
#undef SA_
#undef SB_
#undef GLDS_STAGE
}

struct EpiInProj {
  static constexpr bool PRELOAD = false;
  bf16_t* proj; float* dt;
  DI void operator()(int m, int n, const f32x4& v0, const f32x4& v1) const {
    u32x4 o; o[0] = pk2(v0[0], v0[1]); o[1] = pk2(v0[2], v0[3]); o[2] = pk2(v1[0], v1[1]); o[3] = pk2(v1[2], v1[3]);
    *(u32x4*)(proj + (size_t)m * NPROJP + n) = o;
    if (n >= C_DT && n < NPROJ) { float* d = dt + (size_t)m * 16 + (n - C_DT); *(f32x4*)d = v0; *(f32x4*)(d + 4) = v1; }
  }
};
struct EpiResid {
  static constexpr bool PRELOAD = true;
  const float* xin_p; const float* xin_s;
  bf16_t* xb; float* xout_f;
  const float* gate;
  DI u32x4 preload(int m, int n) const { return xin_p ? (u32x4){0u, 0u, 0u, 0u} : *(const u32x4*)(xb + (size_t)m * D + n); }
  DI void operator()(int m, int n, const f32x4& v0, const f32x4& v1, const u32x4& r) const {
    const float* gp = gate + (size_t)modrow_of(m) * 6144 + n;
    const f32x4 g0 = *(const f32x4*)gp, g1 = *(const f32x4*)(gp + 4);
    f32x4 x0, x1;
    if (xin_p) { const float* xi = ((m < TP) ? xin_p + (size_t)m * D : xin_s + (size_t)(m - TP) * D) + n; x0 = *(const f32x4*)xi; x1 = *(const f32x4*)(xi + 4); }
    else { x0 = (f32x4){bflo(r[0]), bfhi(r[0]), bflo(r[1]), bfhi(r[1])}; x1 = (f32x4){bflo(r[2]), bfhi(r[2]), bflo(r[3]), bfhi(r[3])}; }
    const f32x4 y0 = x0 + g0 * v0, y1 = x1 + g1 * v1;
    if (xout_f) { float* o = xout_f + (size_t)m * D + n; *(f32x4*)o = y0; *(f32x4*)(o + 4) = y1; }
    else { u32x4 o; o[0] = pk2(y0[0], y0[1]); o[1] = pk2(y0[2], y0[3]); o[2] = pk2(y1[0], y1[1]); o[3] = pk2(y1[2], y1[3]); *(u32x4*)(xb + (size_t)m * D + n) = o; }
  }
};
struct EpiFF1 {
  static constexpr bool PRELOAD = false;
  bf16_t* u;
  DI void operator()(int m, int n, const f32x4& v0, const f32x4& v1) const {
    float r[8];
#pragma unroll
    for (int e = 0; e < 4; ++e) { const float t0 = v0[e] > 0.f ? v0[e] : 0.f, t1 = v1[e] > 0.f ? v1[e] : 0.f; r[e] = t0 * t0; r[4 + e] = t1 * t1; }
    u32x4 o; o[0] = pk2(r[0], r[1]); o[1] = pk2(r[2], r[3]); o[2] = pk2(r[4], r[5]); o[3] = pk2(r[6], r[7]);
    *(u32x4*)(u + (size_t)m * DFF + n) = o;
  }
};

DI void rope_block(f32x16& v, const float* tab, int pos, int half) {
  const float* t = tab + (size_t)pos * 32;
#pragma unroll
  for (int q = 0; q < 2; ++q)
#pragma unroll
    for (int r = 0; r < 4; ++r) {
      const int fi = q * 8 + r + 4 * half;
      const float c = t[fi * 2], s = t[fi * 2 + 1];
      const float x1 = v[q * 8 + r], x2 = v[q * 8 + r + 4];
      v[q * 8 + r] = x1 * c - x2 * s;
      v[q * 8 + r + 4] = x2 * c + x1 * s;
    }
}
DI void store_block_bf16(bf16_t* dst, const f32x16& v, int half) {
#pragma unroll
  for (int q = 0; q < 4; q += 2) {
    unsigned ax = pk2(v[4 * q], v[4 * q + 1]), ay = pk2(v[4 * q + 2], v[4 * q + 3]);
    unsigned bx = pk2(v[4 * q + 4], v[4 * q + 5]), by = pk2(v[4 * q + 6], v[4 * q + 7]);
    { auto r = __builtin_amdgcn_permlane32_swap(ax, bx, false, false); ax = r[0]; bx = r[1]; }
    { auto r = __builtin_amdgcn_permlane32_swap(ay, by, false, false); ay = r[0]; by = r[1]; }
    u32x4 wv; wv[0] = ax; wv[1] = ay; wv[2] = bx; wv[3] = by;
    *(u32x4*)(dst + 8 * q + 8 * half) = wv;
  }
}
DI f32x16 gain_block(const float* g, int half) {
  f32x16 o;
#pragma unroll
  for (int q = 0; q < 4; ++q) { const f32x4 v = *(const f32x4*)(g + 8 * q + 4 * half); o[4 * q] = v[0]; o[4 * q + 1] = v[1]; o[4 * q + 2] = v[2]; o[4 * q + 3] = v[3]; }
  return o;
}
DI float sumsq16(const f32x16& v) { float s = 0.f;
#pragma unroll
  for (int i = 0; i < 16; ++i) s += v[i] * v[i];
  return s; }

DI void mla_q_item(const Params& p, int l, int item4, char* lds) {
  const int item = item4 >> 2, head0 = item4 & 3;
  const int lane = get_tid() & 63, w = get_tid() >> 6, l32 = lane & 31, half = lane >> 5;
  {
    const bf16_t* Wg = (const bf16_t*)(p.ws + OFF_WUQ) + ((size_t)l * 384 + head0 * 96) * 256;
    u32x4 t[6];
#pragma unroll
    for (int i = 0; i < 6; ++i) { const int c = get_tid() + 512 * i; t[i] = *(const u32x4*)(Wg + (size_t)(c >> 5) * 256 + (c & 31) * 8); }
    __syncthreads();
#pragma unroll
    for (int i = 0; i < 6; ++i) { const int c = get_tid() + 512 * i; *(u32x4*)(lds + (c >> 5) * 528 + (c & 31) * 16) = t[i]; }
    if (get_tid() < 64) *(f32x4*)(lds + 50688 + get_tid() * 16) = *(const f32x4*)(p.in[15] + (size_t)l * 256 + get_tid() * 4);
  }
  const int tok = item * 256 + w * 32 + l32;
  const bf16_t* proj = (const bf16_t*)(p.ws + OFF_PROJ) + (size_t)tok * NPROJP + C_CQ;
  const float* gq = p.in[15] + (size_t)l * 256;
  float ss = 0.f;
  u32x4 raw[16];
#pragma unroll
  for (int s = 0; s < 16; ++s) raw[s] = *(const u32x4*)(proj + 16 * s + 8 * half);
#pragma unroll
  for (int s = 0; s < 16; ++s) {
#pragma unroll
    for (int e = 0; e < 4; ++e) { const float a = bflo(raw[s][e]), b = bfhi(raw[s][e]); ss += a * a + b * b; }
  }
  ss += xor32(ss);
  const float rstd = rsqrtf(ss * (1.f / 256.f) + EPS);
  __syncthreads();
  bf16x8 fr[16];
#pragma unroll
  for (int s = 0; s < 16; ++s) {
    const f32x4 g0 = *(const f32x4*)(lds + 50688 + (16 * s + 8 * half) * 4), g1 = *(const f32x4*)(lds + 50688 + (16 * s + 8 * half + 4) * 4);
    u32x4 o;
    o[0] = pk2(bflo(raw[s][0]) * rstd * g0[0], bfhi(raw[s][0]) * rstd * g0[1]);
    o[1] = pk2(bflo(raw[s][1]) * rstd * g0[2], bfhi(raw[s][1]) * rstd * g0[3]);
    o[2] = pk2(bflo(raw[s][2]) * rstd * g1[0], bfhi(raw[s][2]) * rstd * g1[1]);
    o[3] = pk2(bflo(raw[s][3]) * rstd * g1[2], bfhi(raw[s][3]) * rstd * g1[3]);
    fr[s] = __builtin_bit_cast(bf16x8, o);
  }
  const bf16_t* W = (const bf16_t*)(p.ws + OFF_WUQ) + (size_t)l * 384 * 256;
  const float* gqk = p.in[19] + (size_t)l * 96;
  const float* tab = (const float*)(p.ws + OFF_ROPE);
  const bool rope = tok >= TP;
  const int pos = rope ? ((tok - TP) & 2047) : 0;
  const float qscale = 0.10206207261596577f * 1.4426950408889634f;
  bf16_t* qa = (bf16_t*)(p.ws + OFF_QA) + (size_t)tok * 384;
#pragma unroll 1
  for (int head = head0; head < head0 + 1; ++head) {
    f32x16 acc[3];
#pragma unroll
    for (int db = 0; db < 3; ++db) acc[db] = zero16();
#pragma unroll
    for (int db = 0; db < 3; ++db) {
      bf16x8 a[16];
      const char* wrow = lds + (db * 32 + l32) * 528 + 16 * half;
#pragma unroll
      for (int s = 0; s < 16; ++s) a[s] = *(const bf16x8*)(wrow + 32 * s);
      __builtin_amdgcn_sched_barrier(0);
#pragma unroll
      for (int s = 0; s < 16; ++s) acc[db] = MFMA32(a[s], fr[s], acc[db]);
      __builtin_amdgcn_sched_barrier(0);
    }
    float s2 = sumsq16(acc[0]) + sumsq16(acc[1]) + sumsq16(acc[2]);
    s2 += xor32(s2);
    const float r2 = rsqrtf(s2 * (1.f / 96.f) + EPS);
#pragma unroll
    for (int db = 0; db < 3; ++db) {
      const f32x16 gb = gain_block(gqk + db * 32, half);
#pragma unroll
      for (int r = 0; r < 16; ++r) acc[db][r] *= r2 * gb[r];
    }
    if (rope) rope_block(acc[2], tab, pos, half);
#pragma unroll
    for (int db = 0; db < 3; ++db) {
#pragma unroll
      for (int r = 0; r < 16; ++r) acc[db][r] *= qscale;
      store_block_bf16(qa + head * 96 + db * 32, acc[db], half);
    }
  }
}

DI void mla_kv_item(const Params& p, int l, int item4, char* lds) {
  const int item = item4 >> 2, head0 = item4 & 3;
  const int lane = get_tid() & 63, w = get_tid() >> 6, l32 = lane & 31, half = lane >> 5;
  {
    const bf16_t* Wg = (const bf16_t*)(p.ws + OFF_WUKV) + ((size_t)l * 512 + head0 * 128) * 128;
    u32x4 t[4];
#pragma unroll
    for (int i = 0; i < 4; ++i) { const int c = get_tid() + 512 * i; t[i] = *(const u32x4*)(Wg + (size_t)(c >> 4) * 128 + (c & 15) * 8); }
    __syncthreads();
#pragma unroll
    for (int i = 0; i < 4; ++i) { const int c = get_tid() + 512 * i; *(u32x4*)(lds + (c >> 4) * PITCH128 + (c & 15) * 16) = t[i]; }
  }
  const int kr = item * 256 + w * 32 + l32;
  int tok = -1, b = 0, j = 0; bool cached = false, rope = false; int pos = 0;
  if (kr < TP) { tok = kr; }
  else { b = (kr - TP) / 2304; j = (kr - TP) % 2304; if (j < PAST) cached = true; else { tok = TP + b * 2048 + (j - PAST); rope = true; pos = j - PAST; } }
  bf16x8 fr[8];
  f32x16 krb;
  if (!cached) {
    const bf16_t* proj = (const bf16_t*)(p.ws + OFF_PROJ) + (size_t)tok * NPROJP;
    const float* gkv = p.in[16] + (size_t)l * 128;
    u32x4 raw[8]; float ss = 0.f;
    f32x4 gv0[8], gv1[8]; u32x2 rvv[4];
#pragma unroll
    for (int s = 0; s < 8; ++s) raw[s] = *(const u32x4*)(proj + C_CKV + 16 * s + 8 * half);
#pragma unroll
    for (int s = 0; s < 8; ++s) { gv0[s] = *(const f32x4*)(gkv + 16 * s + 8 * half); gv1[s] = *(const f32x4*)(gkv + 16 * s + 8 * half + 4); }
#pragma unroll
    for (int q = 0; q < 4; ++q) rvv[q] = *(const u32x2*)(proj + C_KR + 8 * q + 4 * half);
#pragma unroll
    for (int s = 0; s < 8; ++s) {
#pragma unroll
      for (int e = 0; e < 4; ++e) { const float a = bflo(raw[s][e]), bb = bfhi(raw[s][e]); ss += a * a + bb * bb; }
    }
    ss += xor32(ss);
    const float rstd = rsqrtf(ss * (1.f / 128.f) + EPS);
#pragma unroll
    for (int s = 0; s < 8; ++s) {
      const f32x4 g0 = gv0[s], g1 = gv1[s];
      f32x4 o0, o1;
      o0[0] = bflo(raw[s][0]) * rstd * g0[0]; o0[1] = bfhi(raw[s][0]) * rstd * g0[1]; o0[2] = bflo(raw[s][1]) * rstd * g0[2]; o0[3] = bfhi(raw[s][1]) * rstd * g0[3];
      o1[0] = bflo(raw[s][2]) * rstd * g1[0]; o1[1] = bfhi(raw[s][2]) * rstd * g1[1]; o1[2] = bflo(raw[s][3]) * rstd * g1[2]; o1[3] = bfhi(raw[s][3]) * rstd * g1[3];
      u32x4 o; o[0] = pk2(o0[0], o0[1]); o[1] = pk2(o0[2], o0[3]); o[2] = pk2(o1[0], o1[1]); o[3] = pk2(o1[2], o1[3]);
      fr[s] = __builtin_bit_cast(bf16x8, o);
      if (tok < TP && head0 == 0) {
        float* dst = p.out + O_CKV + (((size_t)(tok >> 8) * DEPTH + l) * 256 + (tok & 255)) * 128 + 16 * s + 8 * half;
        *(f32x4*)dst = o0; *(f32x4*)(dst + 4) = o1;
      }
    }
#pragma unroll
    for (int q = 0; q < 4; ++q) {
      const u32x2 rv = rvv[q];
      krb[4 * q] = bflo(rv[0]); krb[4 * q + 1] = bfhi(rv[0]); krb[4 * q + 2] = bflo(rv[1]); krb[4 * q + 3] = bfhi(rv[1]);
      if (tok < TP && head0 == 0) {
        float* dst = p.out + O_KROPE + (((size_t)(tok >> 8) * DEPTH + l) * 256 + (tok & 255)) * 32 + 8 * q + 4 * half;
        f32x4 o = {krb[4 * q], krb[4 * q + 1], krb[4 * q + 2], krb[4 * q + 3]};
        *(f32x4*)dst = o;
      }
    }
  } else {
    const float* src = p.in[2] + (((size_t)b * DEPTH + l) * PAST + j) * 128;
#pragma unroll
    for (int s = 0; s < 8; ++s) {
      const f32x4 v0 = *(const f32x4*)(src + 16 * s + 8 * half), v1 = *(const f32x4*)(src + 16 * s + 8 * half + 4);
      u32x4 o; o[0] = pk2(v0[0], v0[1]); o[1] = pk2(v0[2], v0[3]); o[2] = pk2(v1[0], v1[1]); o[3] = pk2(v1[2], v1[3]);
      fr[s] = __builtin_bit_cast(bf16x8, o);
    }
    const float* ks = p.in[3] + (((size_t)b * DEPTH + l) * PAST + j) * 32;
#pragma unroll
    for (int q = 0; q < 4; ++q) {
      const f32x4 v = *(const f32x4*)(ks + 8 * q + 4 * half);
      krb[4 * q] = v[0]; krb[4 * q + 1] = v[1]; krb[4 * q + 2] = v[2]; krb[4 * q + 3] = v[3];
    }
  }
  const bf16_t* W = (const bf16_t*)(p.ws + OFF_WUKV) + (size_t)l * 512 * 128;
  const float* gk = p.in[20] + (size_t)l * 96;
  const float* tab = (const float*)(p.ws + OFF_ROPE);
  bf16_t* ka = (bf16_t*)(p.ws + OFF_KA) + (size_t)kr * 384;
  bf16_t* vat = (bf16_t*)(p.ws + OFF_VAT);
  const float ssr = sumsq16(krb);
  __syncthreads();
#pragma unroll 1
  for (int head = head0; head < head0 + 1; ++head) {
    f32x16 acc[4];
#pragma unroll
    for (int db = 0; db < 4; ++db) acc[db] = zero16();
#pragma unroll
    for (int dp = 0; dp < 2; ++dp) {
      bf16x8 a[2][8];
#pragma unroll
      for (int d2 = 0; d2 < 2; ++d2)
#pragma unroll
        for (int s = 0; s < 8; ++s) a[d2][s] = *(const bf16x8*)(lds + ((dp * 2 + d2) * 32 + l32) * PITCH128 + 32 * s + 16 * half);
      __builtin_amdgcn_sched_barrier(0);
#pragma unroll
      for (int d2 = 0; d2 < 2; ++d2)
#pragma unroll
        for (int s = 0; s < 8; ++s) acc[dp * 2 + d2] = MFMA32(a[d2][s], fr[s], acc[dp * 2 + d2]);
      __builtin_amdgcn_sched_barrier(0);
    }
    float s2 = sumsq16(acc[0]) + sumsq16(acc[1]) + ssr;
    s2 += xor32(s2);
    const float r2 = rsqrtf(s2 * (1.f / 96.f) + EPS);
    f32x16 k2;
    {
      const f32x16 g0 = gain_block(gk, half), g1 = gain_block(gk + 32, half), g2 = gain_block(gk + 64, half);
#pragma unroll
      for (int r = 0; r < 16; ++r) { acc[0][r] *= r2 * g0[r]; acc[1][r] *= r2 * g1[r]; k2[r] = krb[r] * r2 * g2[r]; }
    }
    if (rope) rope_block(k2, tab, pos, half);
    store_block_bf16(ka + head * 96, acc[0], half);
    store_block_bf16(ka + head * 96 + 32, acc[1], half);
    store_block_bf16(ka + head * 96 + 64, k2, half);
    {
      char* ldsw = lds + 53248 + w * 9216;
#pragma unroll
      for (int db = 2; db < 4; ++db)
#pragma unroll
        for (int r = 0; r < 16; ++r) *(bf16_t*)(ldsw + ((db - 2) * 32 + crow(r, half)) * 80 + l32 * 2) = f2bf(acc[db][r]);
      const int kr0w = kr - l32;
#pragma unroll
      for (int c = 0; c < 4; ++c) {
        const int ch = c * 64 + lane, dv = ch >> 2, cc = ch & 3;
        *(u32x4*)(vat + ((size_t)head * 64 + dv) * NKEY + kr0w + cc * 8) = *(const u32x4*)(ldsw + dv * 80 + cc * 16);
      }
    }
  }
}

DI void diff_qk_thread(const Params& p, int l, int idx, bool isk) {
  const float* tab = (const float*)(p.ws + OFF_ROPE);
  const int hm = idx & 7, row = idx >> 3;
  float x[32];
  int tok = -1, pos = 0; bool rope = false, cached = false;
  if (!isk) { tok = row; if (tok >= TP) { rope = true; pos = (tok - TP) & 2047; } }
  else {
    if (row < TP) tok = row;
    else { const int b = (row - TP) / 2304, j = (row - TP) % 2304;
      if (j < PAST) { cached = true;
        const float* src = p.in[4] + ((((size_t)b * DEPTH + l) * PAST + j) * 8 + hm) * 32;
#pragma unroll
        for (int i = 0; i < 8; ++i) { const f32x4 v = *(const f32x4*)(src + 4 * i); x[4 * i] = v[0]; x[4 * i + 1] = v[1]; x[4 * i + 2] = v[2]; x[4 * i + 3] = v[3]; }
      } else { tok = TP + b * 2048 + (j - PAST); rope = true; pos = j - PAST; } }
  }
  if (!cached) {
    const bf16_t* src = (const bf16_t*)(p.ws + OFF_PROJ) + (size_t)tok * NPROJP + (isk ? C_DK : C_DQ) + hm * 32;
    float ss = 0.f;
#pragma unroll
    for (int i = 0; i < 4; ++i) {
      const u32x4 v = *(const u32x4*)(src + 8 * i);
#pragma unroll
      for (int e = 0; e < 4; ++e) { x[8 * i + 2 * e] = bflo(v[e]); x[8 * i + 2 * e + 1] = bfhi(v[e]); }
    }
#pragma unroll
    for (int i = 0; i < 32; ++i) ss += x[i] * x[i];
    const float rstd = rsqrtf(ss * (1.f / 32.f) + EPS);
    const float* g = p.in[isk ? 22 : 21] + (size_t)l * 32;
#pragma unroll
    for (int i = 0; i < 32; ++i) x[i] *= rstd * g[i];
    if (isk && tok < TP) {
      float* dst = p.out + O_DK + (((size_t)(tok >> 8) * DEPTH + l) * 256 + (tok & 255)) * 256 + hm * 32;
#pragma unroll
      for (int i = 0; i < 8; ++i) { f32x4 o = {x[4 * i], x[4 * i + 1], x[4 * i + 2], x[4 * i + 3]}; *(f32x4*)(dst + 4 * i) = o; }
    }
    if (rope) {
      const float* t = tab + (size_t)pos * 32;
#pragma unroll
      for (int q = 0; q < 2; ++q)
#pragma unroll
        for (int m = 0; m < 8; ++m) {
          const float c = t[(q * 8 + m) * 2], s = t[(q * 8 + m) * 2 + 1];
          const float x1 = x[q * 16 + m], x2 = x[q * 16 + 8 + m];
          x[q * 16 + m] = x1 * c - x2 * s; x[q * 16 + 8 + m] = x2 * c + x1 * s;
        }
    }
  }
  const float sc = isk ? 1.f : 0.17677669529663687f * 1.4426950408889634f;
  bf16_t* dst = (bf16_t*)(p.ws + (isk ? OFF_KD : OFF_QD)) + (size_t)row * 256 + hm * 32;
#pragma unroll
  for (int i = 0; i < 4; ++i) {
    u32x4 o;
#pragma unroll
    for (int e = 0; e < 4; ++e) o[e] = pk2(x[8 * i + 2 * e] * sc, x[8 * i + 2 * e + 1] * sc);
    *(u32x4*)(dst + 8 * i) = o;
  }
}
DI void diff_v_thread(const Params& p, int l, int idx, char* ldsw) {
  const int lane = get_tid() & 63;
  const int head = idx / NKEY, kr = idx % NKEY, kr0 = kr - lane;
  constexpr int VP = 144;
  int tok = -1;
  if (kr < TP) tok = kr;
  else { const int b = (kr - TP) / 2304, j = (kr - TP) % 2304;
    if (j < PAST) {
      const float* src = p.in[5] + ((((size_t)b * DEPTH + l) * PAST + j) * 4 + head) * 64;
#pragma unroll
      for (int i = 0; i < 16; ++i) { const f32x4 v = *(const f32x4*)(src + 4 * i);
#pragma unroll
        for (int e = 0; e < 4; ++e) *(bf16_t*)(ldsw + (4 * i + e) * VP + lane * 2) = f2bf(v[e]); }
      tok = -2;
    } else tok = TP + b * 2048 + (j - PAST);
  }
  if (tok >= 0) {
    const bf16_t* src = (const bf16_t*)(p.ws + OFF_PROJ) + (size_t)tok * NPROJP + C_DV + head * 64;
    float* od = (tok < TP) ? p.out + O_DV + (((size_t)(tok >> 8) * DEPTH + l) * 256 + (tok & 255)) * 256 + head * 64 : nullptr;
#pragma unroll
    for (int i = 0; i < 8; ++i) {
      const u32x4 v = *(const u32x4*)(src + 8 * i);
#pragma unroll
      for (int e = 0; e < 4; ++e) {
        *(bf16_t*)(ldsw + (8 * i + 2 * e) * VP + lane * 2) = (bf16_t)(v[e] & 0xffffu);
        *(bf16_t*)(ldsw + (8 * i + 2 * e + 1) * VP + lane * 2) = (bf16_t)(v[e] >> 16);
      }
      if (od) {
        f32x4 o0 = {bflo(v[0]), bfhi(v[0]), bflo(v[1]), bfhi(v[1])}, o1 = {bflo(v[2]), bfhi(v[2]), bflo(v[3]), bfhi(v[3])};
        *(f32x4*)(od + 8 * i) = o0; *(f32x4*)(od + 8 * i + 4) = o1;
      }
    }
  }
  bf16_t* vdt = (bf16_t*)(p.ws + OFF_VDT) + (size_t)head * 64 * NKEY + kr0;
#pragma unroll
  for (int c = 0; c < 8; ++c) {
    const int ch = c * 64 + lane, dv = ch >> 3, cc = ch & 7;
    *(u32x4*)(vdt + (size_t)dv * NKEY + cc * 8) = *(const u32x4*)(ldsw + dv * VP + cc * 16);
  }
}
template <int CU>
DI void conv_threads(const Params& p, int l, int idx0, int stride) {
  u32x4 v[CU][5]; f32x4 bia[CU][2];
  int tokv[CU], c0v[CU];
#pragma unroll
  for (int u = 0; u < CU; ++u) {
    const int idx = idx0 + u * stride;
    const int tok = idx / 96, c0 = (idx % 96) * 8;
    tokv[u] = tok; c0v[u] = c0;
    int pos, L;
    if (tok < TP) { pos = tok & 255; L = 256; } else { pos = (tok - TP) & 2047; L = 2048; }
    const bf16_t* src = (const bf16_t*)(p.ws + OFF_PROJ) + (size_t)tok * NPROJP + C_XBC + c0;
#pragma unroll
    for (int k = 0; k < 5; ++k) {
      const int pp = pos + k - 2;
      v[u][k] = (u32x4){0u, 0u, 0u, 0u};
      if (pp >= 0 && pp < L) v[u][k] = *(const u32x4*)(src + (ptrdiff_t)(k - 2) * NPROJP);
    }
    const float* cb = p.in[29] + (size_t)l * 768 + c0;
    bia[u][0] = *(const f32x4*)cb; bia[u][1] = *(const f32x4*)(cb + 4);
  }
#pragma unroll
  for (int u = 0; u < CU; ++u) {
    const float* cw = p.in[28] + (size_t)l * 5 * 768 + c0v[u];
    float acc[8] = {bia[u][0][0], bia[u][0][1], bia[u][0][2], bia[u][0][3], bia[u][1][0], bia[u][1][1], bia[u][1][2], bia[u][1][3]};
#pragma unroll
    for (int k = 0; k < 5; ++k) {
      const f32x4 w0 = *(const f32x4*)(cw + k * 768), w1 = *(const f32x4*)(cw + k * 768 + 4);
      const u32x4 x = v[u][k];
      acc[0] += w0[0] * bflo(x[0]); acc[1] += w0[1] * bfhi(x[0]); acc[2] += w0[2] * bflo(x[1]); acc[3] += w0[3] * bfhi(x[1]);
      acc[4] += w1[0] * bflo(x[2]); acc[5] += w1[1] * bfhi(x[2]); acc[6] += w1[2] * bflo(x[3]); acc[7] += w1[3] * bfhi(x[3]);
    }
#pragma unroll
    for (int e = 0; e < 8; ++e) acc[e] = acc[e] / (1.f + __expf(-acc[e]));
    u32x4 o; o[0] = pk2(acc[0], acc[1]); o[1] = pk2(acc[2], acc[3]); o[2] = pk2(acc[4], acc[5]); o[3] = pk2(acc[6], acc[7]);
    *(u32x4*)((bf16_t*)(p.ws + OFF_XBC) + (size_t)tokv[u] * 768 + c0v[u]) = o;
  }
}
DI void dt_thread(const Params& p, int l, int idx) {
  float* dt = (float*)(p.ws + OFF_DT);
  const float v = dt[idx] + p.in[31][(size_t)l * 16 + (idx & 15)];
  dt[idx] = fmaxf(v, 0.f) + log1pf(__expf(-fabsf(v)));
}

DI void prep_phase(const Params& p, int l, char* lds) {
  constexpr int N_Q = 48 * 4, N_KV = 52 * 4, N_DQ = T * 8 / 512, N_DKK = NKEY * 8 / 512, N_DV = NKEY * 4 / 512, N_CONV = T * 96 / 512 / 3, N_DTT = T * 16 / 512;
  constexpr int TOT = N_Q + N_KV + N_DQ + N_DKK + N_DV + N_CONV + N_DTT;
  for (int item = blockIdx.x; item < TOT; item += gridDim.x) {
    int it = item;
    if (it < N_Q) { mla_q_item(p, l, it, lds); continue; }
    it -= N_Q;
    if (it < N_KV) { mla_kv_item(p, l, it, lds); continue; }
    it -= N_KV;
    if (it < N_DQ) { diff_qk_thread(p, l, it * 512 + get_tid(), false); continue; }
    it -= N_DQ;
    if (it < N_DKK) { diff_qk_thread(p, l, it * 512 + get_tid(), true); continue; }
    it -= N_DKK;
    if (it < N_DV) { diff_v_thread(p, l, it * 512 + get_tid(), lds + 53248 + (get_tid() >> 6) * 9216); continue; }
    it -= N_DV;
    if (it < N_CONV) { conv_threads<3>(p, l, it * 512 + get_tid(), N_CONV * 512); continue; }
    it -= N_CONV;
    dt_thread(p, l, it * 512 + get_tid());
  }
}

DI void wave_scan2(float e0, float e1, float& o0, float& o1) {
  const int lane = get_tid() & 63;
  const float s = e0 + e1;
  float inc = s;
#pragma unroll
  for (int o = 1; o < 64; o <<= 1) { const float t = __shfl_up(inc, o); if (lane >= o) inc += t; }
  const float excl = inc - s;
  o0 = excl + e0; o1 = excl + s;
}
DI void ssd_dt_load(const Params& p, int cg_, int h, float& d0, float& d1) {
  const int lane = get_tid() & 63, w = get_tid4() >> 6;
  const float* dt = (const float*)(p.ws + OFF_DT) + (size_t)cg_ * 128 * 16;
  d0 = 0.f; d1 = 0.f;
  if (w == 0) { d0 = dt[(2 * lane) * 16 + h]; d1 = dt[(2 * lane + 1) * 16 + h]; }
  else if (w == 1) { d0 = dt[(127 - 2 * lane) * 16 + 8 + h]; d1 = dt[(126 - 2 * lane) * 16 + 8 + h]; }
}
DI void ssd_scalars_from(const Params& p, int l, int h, float d0, float d1, float* acf, float* sb, float* dtf, float* dtb) {
  const int lane = get_tid() & 63, w = get_tid4() >> 6;
  if (w == 0) {
    const float a = -__expf(p.in[30][(size_t)l * 16 + h]);
    float o0, o1; wave_scan2(d0 * a, d1 * a, o0, o1);
    acf[2 * lane] = o0; acf[2 * lane + 1] = o1; dtf[2 * lane] = d0; dtf[2 * lane + 1] = d1;
  } else if (w == 1) {
    const float a = -__expf(p.in[30][(size_t)l * 16 + 8 + h]);
    const int j0 = 127 - 2 * lane, j1 = 126 - 2 * lane;
    float o0, o1; wave_scan2(d0 * a, d1 * a, o0, o1);
    sb[j0] = o0; sb[j1] = o1; dtb[j0] = d0; dtb[j1] = d1;
  }
}
DI void ssd_scalars(const Params& p, int l, int cg_, int h, float* acf, float* sb, float* dtf, float* dtb) {
  const int lane = get_tid() & 63, w = get_tid4() >> 6;
  const float* dt = (const float*)(p.ws + OFF_DT) + (size_t)cg_ * 128 * 16;
  if (w == 0) {
    const float a = -__expf(p.in[30][(size_t)l * 16 + h]);
    const float d0 = dt[(2 * lane) * 16 + h], d1 = dt[(2 * lane + 1) * 16 + h];
    float o0, o1; wave_scan2(d0 * a, d1 * a, o0, o1);
    acf[2 * lane] = o0; acf[2 * lane + 1] = o1; dtf[2 * lane] = d0; dtf[2 * lane + 1] = d1;
  } else if (w == 1) {
    const float a = -__expf(p.in[30][(size_t)l * 16 + 8 + h]);
    const int j0 = 127 - 2 * lane, j1 = 126 - 2 * lane;
    const float d0 = dt[j0 * 16 + 8 + h], d1 = dt[j1 * 16 + 8 + h];
    float o0, o1; wave_scan2(d0 * a, d1 * a, o0, o1);
    sb[j0] = o0; sb[j1] = o1; dtb[j0] = d0; dtb[j1] = d1;
  }
}

DI void ssd_states_item(const Params& p, int l, int item, char* lds) {
  const int tid = get_tid4(), lane = tid & 63, w = tid >> 6, l32 = lane & 31, half = lane >> 5;
  const int cg_ = item >> 3, h = item & 7, g = h >> 2;
  char* XF = lds; char* XB = lds + 64 * PITCH128; char* BT = lds + 2 * 64 * PITCH128;
  float* sc = (float*)(lds + 3 * 64 * PITCH128);
  float* acf = sc, *sb = sc + 128, *dtf = sc + 256, *dtb = sc + 384;
  __syncthreads();
  ssd_scalars(p, l, cg_, h, acf, sb, dtf, dtb);
  __syncthreads();
  const bf16_t* xbc = (const bf16_t*)(p.ws + OFF_XBC) + (size_t)cg_ * 128 * 768;
  const float aL = acf[127], s0 = sb[0];
#pragma unroll
  for (int it = 0; it < 2; ++it) {
    const int t = tid + 256 * it, jp = t & 63, pc = t >> 6, j0 = 2 * jp;
    const u32x4 x0 = *(const u32x4*)(xbc + (size_t)j0 * 768 + h * 64 + pc * 8), x1 = *(const u32x4*)(xbc + (size_t)(j0 + 1) * 768 + h * 64 + pc * 8);
    const u32x4 b0 = *(const u32x4*)(xbc + (size_t)j0 * 768 + 512 + g * 64 + pc * 8), b1 = *(const u32x4*)(xbc + (size_t)(j0 + 1) * 768 + 512 + g * 64 + pc * 8);
    const float wf0 = __expf(aL - acf[j0]) * dtf[j0], wf1 = __expf(aL - acf[j0 + 1]) * dtf[j0 + 1];
    const float wb0 = __expf(s0 - sb[j0]) * dtb[j0], wb1 = __expf(s0 - sb[j0 + 1]) * dtb[j0 + 1];
#pragma unroll
    for (int e = 0; e < 4; ++e) {
      const float a0 = bflo(x0[e]), a1 = bfhi(x0[e]), c0 = bflo(x1[e]), c1 = bfhi(x1[e]);
      const int pr = pc * 8 + 2 * e;
      *(unsigned*)(XF + pr * PITCH128 + j0 * 2) = pk2(a0 * wf0, c0 * wf1);
      *(unsigned*)(XF + (pr + 1) * PITCH128 + j0 * 2) = pk2(a1 * wf0, c1 * wf1);
      *(unsigned*)(XB + pr * PITCH128 + j0 * 2) = pk2(a0 * wb0, c0 * wb1);
      *(unsigned*)(XB + (pr + 1) * PITCH128 + j0 * 2) = pk2(a1 * wb0, c1 * wb1);
      *(unsigned*)(BT + pr * PITCH128 + j0 * 2) = (b0[e] & 0xffffu) | (b1[e] << 16);
      *(unsigned*)(BT + (pr + 1) * PITCH128 + j0 * 2) = (b0[e] >> 16) | (b1[e] & 0xffff0000u);
    }
  }
  __syncthreads();
  const int dir = w >> 1, pb = w & 1;
  const char* Xs = (dir ? XB : XF) + (pb * 32 + l32) * PITCH128 + half * 16;
  const char* Bsrc = BT + l32 * PITCH128 + half * 16;
  f32x16 acc[2] = {zero16(), zero16()};
#pragma unroll
  for (int s = 0; s < 8; ++s) {
    const bf16x8 a = *(const bf16x8*)(Xs + s * 32);
    const bf16x8 b0 = *(const bf16x8*)(Bsrc + s * 32), b1 = *(const bf16x8*)(Bsrc + 32 * PITCH128 + s * 32);
    acc[0] = MFMA32(a, b0, acc[0]); acc[1] = MFMA32(a, b1, acc[1]);
  }
  float* ST = (float*)(p.ws + OFF_ST) + ((size_t)(cg_ * 8 + h) * 2 + dir) * 4096;
#pragma unroll
  for (int nb = 0; nb < 2; ++nb)
#pragma unroll
    for (int r = 0; r < 16; ++r) ST[(pb * 32 + crow(r, half)) * 64 + nb * 32 + l32] = acc[nb][r];
  if (tid == 0) { float* cd = (float*)(p.ws + OFF_CDEC) + (size_t)(cg_ * 8 + h) * 2; cd[0] = __expf(aL); cd[1] = __expf(s0); }
}

template <int NC>
DI void ssd_scan_thread(const Params& p, int l, int seq, int r, int cg0, f32x4 hs) {
  const float* ST = (const float*)(p.ws + OFF_ST);
  bf16_t* HP = (bf16_t*)(p.ws + OFF_HP);
  const float* CD = (const float*)(p.ws + OFF_CDEC);
  const int h = r >> 11, dir = (r >> 10) & 1, pn = r & 1023;
  f32x4 st[NC]; float dec[NC];
#pragma unroll
  for (int c = 0; c < NC; ++c) {
    const int cgi = cg0 + (dir ? NC - 1 - c : c);
    st[c] = *(const f32x4*)(ST + ((size_t)(cgi * 8 + h) * 2 + dir) * 4096 + pn * 4);
    dec[c] = CD[(size_t)(cgi * 8 + h) * 2 + dir];
  }
#pragma unroll
  for (int c = 0; c < NC; ++c) {
    const int cgi = cg0 + (dir ? NC - 1 - c : c);
    u32x2 hv; hv[0] = pk2(hs[0], hs[1]); hv[1] = pk2(hs[2], hs[3]);
    *(u32x2*)(HP + ((size_t)(cgi * 8 + h) * 2 + dir) * 4096 + pn * 4) = hv;
    hs = dec[c] * hs + st[c];
  }
  if (seq < 16) *(f32x4*)(p.out + O_SSM + ((((size_t)seq * DEPTH + l) * 2 + dir) * 8 + h) * 4096 + pn * 4) = hs;
}
DI void ssd_scan_phase(const Params& p, int l) {
  constexpr int PER_SEQ = 8 * 2 * 64 * 16;
  for (int item = blockIdx.x; item < 20 * PER_SEQ / 512; item += gridDim.x) {
    const int idx = item * 512 + get_tid();
    const int sq = idx / PER_SEQ; const int r = idx % PER_SEQ;
    const int seq = (sq < 4) ? 16 + sq : sq - 4;
    if (seq < 16) ssd_scan_thread<2>(p, l, seq, r, 2 * seq, (f32x4){0.f, 0.f, 0.f, 0.f});
    else {
      const int dir = (r >> 10) & 1, h = r >> 11, pn = r & 1023;
      const f32x4 h0 = *(const f32x4*)(p.in[6] + ((((size_t)(seq - 16) * DEPTH + l) * 2 + dir) * 8 + h) * 4096 + pn * 4);
      ssd_scan_thread<16>(p, l, seq, r, 32 + 16 * (seq - 16), h0);
    }
  }
}

DI void ssd_y_item(const Params& p, int l, int cg_, char* lds_blk) {
  const int tid = get_tid4(), lane = tid & 63, w = tid >> 6, l32 = lane & 31, half = lane >> 5;
  const int g = get_hb();
  char* lds = lds_blk + g * HALF_LDS;
  char* Bs = lds; char* Cs = lds + 128 * PITCH64; char* XT = lds + 2 * 128 * PITCH64;
  char* Hf = XT + 64 * PITCH128; char* Hb = Hf + 64 * PITCH64;
  float* sc = (float*)(Hb + 64 * PITCH64);
  float* acf = sc, *sb = sc + 128, *dtf = sc + 256, *dtb = sc + 384;
  const int tok0 = cg_ * 128;
  const int i = w * 32 + l32, tok = tok0 + i;
  const bf16_t* xbc = (const bf16_t*)(p.ws + OFF_XBC) + (size_t)tok0 * 768;
  const bf16_t* proj = (const bf16_t*)(p.ws + OFF_PROJ);
  bf16_t* mix = (bf16_t*)(p.ws + OFF_MIX);
  float ssq = 0.f;
  {
    __syncthreads();
#pragma unroll
    for (int it = 0; it < 4; ++it) {
      const int t = tid + 256 * it, r = t >> 3, c = (t & 7) * 8;
      *(u32x4*)(Bs + r * PITCH64 + c * 2) = *(const u32x4*)(xbc + (size_t)r * 768 + 512 + g * 64 + c);
      *(u32x4*)(Cs + r * PITCH64 + c * 2) = *(const u32x4*)(xbc + (size_t)r * 768 + 640 + g * 64 + c);
    }
    __syncthreads();
    u32x4 xr[2][2]; float dpre0, dpre1;
    auto head_loads = [&](int h) {
#pragma unroll
      for (int it = 0; it < 2; ++it) {
        const int t = tid + 256 * it, jp = t & 63, pc = t >> 6, j0 = 2 * jp;
        xr[it][0] = *(const u32x4*)(xbc + (size_t)j0 * 768 + h * 64 + pc * 8);
        xr[it][1] = *(const u32x4*)(xbc + (size_t)(j0 + 1) * 768 + h * 64 + pc * 8);
      }
      ssd_dt_load(p, cg_, h, dpre0, dpre1);
    };
    head_loads(g * 4);
#pragma unroll 1
    for (int hh = 0; hh < 4; ++hh) {
      const int h = g * 4 + hh;
      u32x4 hr[2][2];
      {
        const bf16_t* hp = (const bf16_t*)(p.ws + OFF_HP) + (size_t)(cg_ * 8 + h) * 2 * 4096;
#pragma unroll
        for (int it = 0; it < 2; ++it) { const int t = tid + 256 * it, r = t >> 3, c = (t & 7) * 8; hr[it][0] = *(const u32x4*)(hp + r * 64 + c); hr[it][1] = *(const u32x4*)(hp + 4096 + r * 64 + c); }
      }
      __syncthreads();
#pragma unroll
      for (int it = 0; it < 2; ++it) {
        const int t = tid + 256 * it, jp = t & 63, pc = t >> 6, j0 = 2 * jp;
        const u32x4 x0 = xr[it][0], x1 = xr[it][1];
#pragma unroll
        for (int e = 0; e < 4; ++e) {
          const int pr = pc * 8 + 2 * e;
          *(unsigned*)(XT + pr * PITCH128 + j0 * 2) = (x0[e] & 0xffffu) | (x1[e] << 16);
          *(unsigned*)(XT + (pr + 1) * PITCH128 + j0 * 2) = (x0[e] >> 16) | (x1[e] & 0xffff0000u);
        }
        const int r = t >> 3, c = (t & 7) * 8;
        *(u32x4*)(Hf + r * PITCH64 + c * 2) = hr[it][0];
        *(u32x4*)(Hb + r * PITCH64 + c * 2) = hr[it][1];
      }
      ssd_scalars_from(p, l, h, dpre0, dpre1, acf, sb, dtf, dtb);
      __syncthreads();
      if (hh < 3) head_loads(h + 1);
      const float aif = acf[i], aib = sb[i];
      f32x16 Y[2] = {zero16(), zero16()};
      int iv = i, hv = half;
      asm volatile("" : "+v"(iv), "+v"(hv));
      bf16x8 cfr[4];
#pragma unroll
      for (int s = 0; s < 4; ++s) cfr[s] = *(const bf16x8*)(Cs + i * PITCH64 + s * 32 + hv * 16);
      u32x2 xpre[8], zpre[8];
#pragma unroll
      for (int q8 = 0; q8 < 8; ++q8) {
        const int pc = (q8 >> 2) * 32 + 8 * (q8 & 3) + 4 * hv;
        xpre[q8] = *(const u32x2*)(xbc + (size_t)i * 768 + h * 64 + pc);
        zpre[q8] = *(const u32x2*)(proj + (size_t)tok * NPROJP + C_Z + h * 64 + pc);
      }
#pragma unroll 1
      for (int jb = 0; jb < 4; ++jb) {
        f32x16 G = zero16();
#pragma unroll
        for (int s = 0; s < 4; ++s) {
          const bf16x8 a = *(const bf16x8*)(Bs + (jb * 32 + l32) * PITCH64 + s * 32 + hv * 16);
          G = MFMA32(a, cfr[s], G);
        }
        f32x16 m;
#pragma unroll
        for (int q = 0; q < 4; ++q) {
          const int jq = jb * 32 + 8 * q + 4 * hv;
          const f32x4 af4 = *(const f32x4*)(acf + jq), sb4 = *(const f32x4*)(sb + jq), df4 = *(const f32x4*)(dtf + jq), db4 = *(const f32x4*)(dtb + jq);
#pragma unroll
          for (int e = 0; e < 4; ++e) {
            const int j = jq + e;
            const bool lo_ = j < iv;
            const float arg = lo_ ? (aif - af4[e]) : (aib - sb4[e]);
            const float dsel = lo_ ? df4[e] : db4[e];
            float wgt = __expf(arg) * dsel;
            wgt = (j == iv) ? (df4[e] + db4[e]) : wgt;
            m[4 * q + e] = G[4 * q + e] * wgt;
          }
        }
#pragma unroll
        for (int s = 0; s < 2; ++s) {
          u32x4 mf; mf[0] = pk2(m[8 * s], m[8 * s + 1]); mf[1] = pk2(m[8 * s + 2], m[8 * s + 3]); mf[2] = pk2(m[8 * s + 4], m[8 * s + 5]); mf[3] = pk2(m[8 * s + 6], m[8 * s + 7]);
          const bf16x8 mfr = __builtin_bit_cast(bf16x8, mf);
#pragma unroll
          for (int pb = 0; pb < 2; ++pb) {
            const char* xa = XT + (pb * 32 + l32) * PITCH128 + (jb * 32 + 16 * s + 4 * hv) * 2;
            u32x4 av; const u32x2 lo = *(const u32x2*)xa, hi = *(const u32x2*)(xa + 16);
            av[0] = lo[0]; av[1] = lo[1]; av[2] = hi[0]; av[3] = hi[1];
            Y[pb] = MFMA32(__builtin_bit_cast(bf16x8, av), mfr, Y[pb]);
          }
        }
      }
      {
        const float ef = __expf(aif), eb = __expf(aib);
#pragma unroll
        for (int pb = 0; pb < 2; ++pb) {
#pragma unroll
          for (int d = 0; d < 2; ++d) {
            f32x16 tf = zero16();
            const char* Hs = d ? Hb : Hf;
#pragma unroll
            for (int s = 0; s < 4; ++s) {
              const bf16x8 a = *(const bf16x8*)(Hs + (pb * 32 + l32) * PITCH64 + s * 32 + hv * 16);
              tf = MFMA32(a, cfr[s], tf);
            }
            const float ee = d ? eb : ef;
#pragma unroll
            for (int r = 0; r < 16; ++r) Y[pb][r] += ee * tf[r];
          }
        }
      }
      const float Dh = p.in[32][(size_t)l * 8 + h];
#pragma unroll
      for (int pb = 0; pb < 2; ++pb) {
        f32x16 yb;
#pragma unroll
        for (int q = 0; q < 4; ++q) {
          const u32x2 xv = xpre[pb * 4 + q];
          const u32x2 zv = zpre[pb * 4 + q];
          float y[4] = {Y[pb][4 * q] + Dh * bflo(xv[0]), Y[pb][4 * q + 1] + Dh * bfhi(xv[0]), Y[pb][4 * q + 2] + Dh * bflo(xv[1]), Y[pb][4 * q + 3] + Dh * bfhi(xv[1])};
          const float z[4] = {bflo(zv[0]), bfhi(zv[0]), bflo(zv[1]), bfhi(zv[1])};
#pragma unroll
          for (int e = 0; e < 4; ++e) { y[e] *= z[e] / (1.f + __expf(-z[e])); ssq += y[e] * y[e]; yb[4 * q + e] = y[e]; }
        }
        store_block_bf16(mix + (size_t)tok * 1024 + 512 + h * 64 + pb * 32, yb, half);
      }
    }
  }
  ssq += xor32(ssq);
  sc[512 + i] = ssq;
  __syncthreads();
  ssq += ((const float*)(lds_blk + (1 - g) * HALF_LDS + (2 * 128 * PITCH64 + 64 * PITCH128 + 2 * 64 * PITCH64)))[512 + i];
  const float rstd = rsqrtf(ssq * (1.f / 512.f) + EPS);
  const float* gn = p.in[33] + (size_t)l * 512;
  u32x4 vv[16];
#pragma unroll
  for (int e = 0; e < 16; ++e) {
    const int ch = (g * 4 + (e >> 2)) * 64 + ((e >> 1) & 1) * 32 + 16 * (e & 1) + 8 * half;
    vv[e] = *(const u32x4*)(mix + (size_t)tok * 1024 + 512 + ch);
  }
#pragma unroll
  for (int hq = 0; hq < 4; ++hq) {
    f32x4 gg[8];
#pragma unroll
    for (int e = 0; e < 4; ++e) {
      const int ch = (g * 4 + hq) * 64 + ((e >> 1) & 1) * 32 + 16 * (e & 1) + 8 * half;
      gg[2 * e] = *(const f32x4*)(gn + ch); gg[2 * e + 1] = *(const f32x4*)(gn + ch + 4);
    }
#pragma unroll
    for (int e = 0; e < 4; ++e) {
      const int ch = (g * 4 + hq) * 64 + ((e >> 1) & 1) * 32 + 16 * (e & 1) + 8 * half;
      const u32x4 v = vv[hq * 4 + e];
      u32x4 o;
      o[0] = pk2(bflo(v[0]) * rstd * gg[2 * e][0], bfhi(v[0]) * rstd * gg[2 * e][1]); o[1] = pk2(bflo(v[1]) * rstd * gg[2 * e][2], bfhi(v[1]) * rstd * gg[2 * e][3]);
      o[2] = pk2(bflo(v[2]) * rstd * gg[2 * e + 1][0], bfhi(v[2]) * rstd * gg[2 * e + 1][1]); o[3] = pk2(bflo(v[3]) * rstd * gg[2 * e + 1][2], bfhi(v[3]) * rstd * gg[2 * e + 1][3]);
      *(u32x4*)(mix + (size_t)tok * 1024 + 512 + ch) = o;
    }
  }
}

struct SeqInfo { int tok0, L, kbase, nk; };
DI SeqInfo seq_info(int s) { SeqInfo r; if (s < 16) { r.tok0 = s * 256; r.L = 256; r.kbase = s * 256; r.nk = 256; } else { r.tok0 = TP + (s - 16) * 2048; r.L = 2048; r.kbase = TP + (s - 16) * 2304; r.nk = 2304; } return r; }

DI void attn_mla_item(const Params& p, int item, char* lds) {
  const int tid = get_tid4(), lane = tid & 63, w = tid >> 6, l32 = lane & 31, half = lane >> 5;
  int seq, head, qb;
  if (item < 256) { seq = 16 + (item >> 6); head = (item >> 4) & 3; qb = item & 15; }
  else { const int it = item - 256; seq = it >> 3; head = (it >> 1) & 3; qb = it & 1; }
  const SeqInfo si = seq_info(seq);
  const int tok = si.tok0 + qb * 128 + w * 32 + l32;
  const bf16_t* qa = (const bf16_t*)(p.ws + OFF_QA) + (size_t)tok * 384 + head * 96;
  bf16x8 qf[6];
#pragma unroll
  for (int s = 0; s < 6; ++s) qf[s] = *(const bf16x8*)(qa + 16 * s + 8 * half);
  constexpr int KT = 64 * PITCH96, VT = 64 * PITCH64;
  char* Ks = lds; char* Vs = lds + 2 * KT;
  const bf16_t* kg = (const bf16_t*)(p.ws + OFF_KA) + (size_t)si.kbase * 384 + head * 96;
  const bf16_t* vg = (const bf16_t*)(p.ws + OFF_VAT) + (size_t)head * 64 * NKEY + si.kbase;
  u32x4 rk[3], rv[2];
  auto gload = [&](int t0) {
#pragma unroll
    for (int i = 0; i < 3; ++i) { const int c = tid + 256 * i, r = c / 12, cc = c % 12; rk[i] = *(const u32x4*)(kg + (size_t)(t0 + r) * 384 + cc * 8); }
#pragma unroll
    for (int i = 0; i < 2; ++i) { const int c = tid + 256 * i, r = c >> 3, cc = c & 7; rv[i] = *(const u32x4*)(vg + (size_t)r * NKEY + t0 + cc * 8); }
  };
  auto lstore = [&](int buf) {
#pragma unroll
    for (int i = 0; i < 3; ++i) { const int c = tid + 256 * i, r = c / 12, cc = c % 12; *(u32x4*)(Ks + buf * KT + r * PITCH96 + cc * 16) = rk[i]; }
#pragma unroll
    for (int i = 0; i < 2; ++i) { const int c = tid + 256 * i, r = c >> 3, cc = c & 7; *(u32x4*)(Vs + buf * VT + r * PITCH64 + cc * 16) = rv[i]; }
  };
  f32x16 O[2] = {zero16(), zero16()};
  float mrun = -1e30f, lsum = 0.f;
  const int nt = si.nk / 64;
  __syncthreads();
  gload(0); lstore(0);
  __syncthreads();
#pragma unroll 1
  for (int t = 0; t < nt; ++t) {
    const int cur = t & 1;
    if (t + 1 < nt) gload((t + 1) * 64);
    f32x16 S[2];
#pragma unroll
    for (int kb = 0; kb < 2; ++kb) {
      S[kb] = zero16();
#pragma unroll
      for (int s = 0; s < 6; ++s) {
        const bf16x8 a = *(const bf16x8*)(Ks + cur * KT + (kb * 32 + l32) * PITCH96 + s * 32 + half * 16);
        S[kb] = MFMA32(a, qf[s], S[kb]);
      }
    }
    float mx = S[0][0];
#pragma unroll
    for (int r = 0; r < 16; ++r) { mx = fmaxf(mx, S[0][r]); mx = fmaxf(mx, S[1][r]); }
    mx = fmaxf(mx, xor32(mx));
    if (__any(mx > mrun + 8.f)) {
      const float mnew = fmaxf(mrun, mx);
      const float alpha = __builtin_amdgcn_exp2f(mrun - mnew);
      mrun = mnew;
      lsum *= alpha;
#pragma unroll
      for (int r = 0; r < 16; ++r) { O[0][r] *= alpha; O[1][r] *= alpha; }
    }
    float ps = 0.f;
#pragma unroll
    for (int kb = 0; kb < 2; ++kb)
#pragma unroll
      for (int r = 0; r < 16; ++r) { const float e = __builtin_amdgcn_exp2f(S[kb][r] - mrun); S[kb][r] = e; ps += e; }
    lsum += ps;
#pragma unroll
    for (int kb = 0; kb < 2; ++kb)
#pragma unroll
      for (int s = 0; s < 2; ++s) {
        u32x4 pf; pf[0] = pk2(S[kb][8 * s], S[kb][8 * s + 1]); pf[1] = pk2(S[kb][8 * s + 2], S[kb][8 * s + 3]); pf[2] = pk2(S[kb][8 * s + 4], S[kb][8 * s + 5]); pf[3] = pk2(S[kb][8 * s + 6], S[kb][8 * s + 7]);
        const bf16x8 pfr = __builtin_bit_cast(bf16x8, pf);
#pragma unroll
        for (int dvb = 0; dvb < 2; ++dvb) {
          const char* va = Vs + cur * VT + (dvb * 32 + l32) * PITCH64 + (kb * 32 + 16 * s + 4 * half) * 2;
          u32x4 av; const u32x2 lo = *(const u32x2*)va, hi = *(const u32x2*)(va + 16);
          av[0] = lo[0]; av[1] = lo[1]; av[2] = hi[0]; av[3] = hi[1];
          O[dvb] = MFMA32(__builtin_bit_cast(bf16x8, av), pfr, O[dvb]);
        }
      }
    if (t + 1 < nt) lstore(cur ^ 1);
    __syncthreads();
  }
  lsum += xor32(lsum);
  const float inv = 1.f / lsum;
  bf16_t* mix = (bf16_t*)(p.ws + OFF_MIX) + (size_t)tok * 1024 + head * 64;
#pragma unroll
  for (int dvb = 0; dvb < 2; ++dvb) {
#pragma unroll
    for (int r = 0; r < 16; ++r) O[dvb][r] *= inv;
    store_block_bf16(mix + dvb * 32, O[dvb], half);
  }
}

constexpr int PITCH32 = 80;
DI void attn_diff_item(const Params& p, int l, int item, char* lds_blk) {
  const int tid = get_tid4(), lane = tid & 63, w = tid >> 6, l32 = lane & 31, half = lane >> 5;
  const int hbk = get_hb();
  char* lds = lds_blk + hbk * HALF_LDS;
  int seq, head, qb;
  if (item < 256) { seq = 16 + (item >> 6); head = (item >> 4) & 3; qb = item & 15; }
  else { const int it = item - 256; seq = it >> 3; head = (it >> 1) & 3; qb = it & 1; }
  const SeqInfo si = seq_info(seq);
  const int tok = si.tok0 + qb * 128 + w * 32 + l32;
  constexpr int KT = 64 * PITCH32, VT = 64 * PITCH64;
  char* Ks = lds; char* Vs = lds + 2 * KT;
  const bf16_t* vg = (const bf16_t*)(p.ws + OFF_VDT) + (size_t)head * 64 * NKEY + si.kbase;
  const int nt = si.nk / 64;
  const float lam_init = ((const float*)(p.ws + OFF_LAM))[l * 2 + 1];
  const float lam = ((const float*)(p.ws + OFF_LAM))[l * 2];
  f32x16 R[2] = {zero16(), zero16()};
#pragma unroll 1
  for (int mp = hbk; mp < hbk + 1; ++mp) {
    const bf16_t* qd = (const bf16_t*)(p.ws + OFF_QD) + (size_t)tok * 256 + head * 64 + mp * 32;
    bf16x8 qf[2];
#pragma unroll
    for (int s = 0; s < 2; ++s) qf[s] = *(const bf16x8*)(qd + 16 * s + 8 * half);
    const bf16_t* kg = (const bf16_t*)(p.ws + OFF_KD) + (size_t)si.kbase * 256 + head * 64 + mp * 32;
    u32x4 rk, rv[2];
    auto gload = [&](int t0) {
      rk = *(const u32x4*)(kg + (size_t)(t0 + (tid >> 2)) * 256 + (tid & 3) * 8);
#pragma unroll
      for (int i = 0; i < 2; ++i) { const int c = tid + 256 * i, r = c >> 3, cc = c & 7; rv[i] = *(const u32x4*)(vg + (size_t)r * NKEY + t0 + cc * 8); }
    };
    auto lstore = [&](int buf) {
      *(u32x4*)(Ks + buf * KT + (tid >> 2) * PITCH32 + (tid & 3) * 16) = rk;
#pragma unroll
      for (int i = 0; i < 2; ++i) { const int c = tid + 256 * i, r = c >> 3, cc = c & 7; *(u32x4*)(Vs + buf * VT + r * PITCH64 + cc * 16) = rv[i]; }
    };
    f32x16 O[2] = {zero16(), zero16()};
    float mrun = -1e30f, lsum = 0.f;
    __syncthreads();
    gload(0); lstore(0);
    __syncthreads();
#pragma unroll 1
    for (int t = 0; t < nt; ++t) {
      const int cur = t & 1;
      if (t + 1 < nt) gload((t + 1) * 64);
      f32x16 S[2];
#pragma unroll
      for (int kb = 0; kb < 2; ++kb) {
        S[kb] = zero16();
#pragma unroll
        for (int s = 0; s < 2; ++s) {
          const bf16x8 a = *(const bf16x8*)(Ks + cur * KT + (kb * 32 + l32) * PITCH32 + s * 32 + half * 16);
          S[kb] = MFMA32(a, qf[s], S[kb]);
        }
      }
      float mx = S[0][0];
#pragma unroll
      for (int r = 0; r < 16; ++r) { mx = fmaxf(mx, S[0][r]); mx = fmaxf(mx, S[1][r]); }
      mx = fmaxf(mx, xor32(mx));
      if (__any(mx > mrun + 8.f)) {
        const float mnew = fmaxf(mrun, mx);
        const float alpha = __builtin_amdgcn_exp2f(mrun - mnew);
        mrun = mnew;
        lsum *= alpha;
#pragma unroll
        for (int r = 0; r < 16; ++r) { O[0][r] *= alpha; O[1][r] *= alpha; }
      }
      float ps = 0.f;
#pragma unroll
      for (int kb = 0; kb < 2; ++kb)
#pragma unroll
        for (int r = 0; r < 16; ++r) { const float e = __builtin_amdgcn_exp2f(S[kb][r] - mrun); S[kb][r] = e; ps += e; }
      lsum += ps;
#pragma unroll
      for (int kb = 0; kb < 2; ++kb)
#pragma unroll
        for (int s = 0; s < 2; ++s) {
          u32x4 pf; pf[0] = pk2(S[kb][8 * s], S[kb][8 * s + 1]); pf[1] = pk2(S[kb][8 * s + 2], S[kb][8 * s + 3]); pf[2] = pk2(S[kb][8 * s + 4], S[kb][8 * s + 5]); pf[3] = pk2(S[kb][8 * s + 6], S[kb][8 * s + 7]);
          const bf16x8 pfr = __builtin_bit_cast(bf16x8, pf);
#pragma unroll
          for (int dvb = 0; dvb < 2; ++dvb) {
            const char* va = Vs + cur * VT + (dvb * 32 + l32) * PITCH64 + (kb * 32 + 16 * s + 4 * half) * 2;
            u32x4 av; const u32x2 lo = *(const u32x2*)va, hi = *(const u32x2*)(va + 16);
            av[0] = lo[0]; av[1] = lo[1]; av[2] = hi[0]; av[3] = hi[1];
            O[dvb] = MFMA32(__builtin_bit_cast(bf16x8, av), pfr, O[dvb]);
          }
        }
      if (t + 1 < nt) lstore(cur ^ 1);
      __syncthreads();
    }
    lsum += xor32(lsum);
    const float coef = (mp == 0) ? 1.f / lsum : -lam / lsum;
#pragma unroll
    for (int dvb = 0; dvb < 2; ++dvb)
#pragma unroll
      for (int r = 0; r < 16; ++r) R[dvb][r] += O[dvb][r] * coef;
  }
  {
    constexpr int XO = 32768;
    float* xo = (float*)(lds + XO);
    if (hbk == 1) {
#pragma unroll
      for (int dvb = 0; dvb < 2; ++dvb)
#pragma unroll
        for (int r = 0; r < 16; ++r) xo[((w * 2 + dvb) * 16 + r) * 64 + lane] = R[dvb][r];
    }
    __syncthreads();
    if (hbk == 1) return;
    const float* xi = (const float*)(lds_blk + HALF_LDS + XO);
#pragma unroll
    for (int dvb = 0; dvb < 2; ++dvb)
#pragma unroll
      for (int r = 0; r < 16; ++r) R[dvb][r] += xi[((w * 2 + dvb) * 16 + r) * 64 + lane];
  }
  float ss = sumsq16(R[0]) + sumsq16(R[1]);
  ss += xor32(ss);
  const float rstd = rsqrtf(ss * (1.f / 64.f) + EPS) * (1.f - lam_init);
  const float* gs = p.in[27] + (size_t)l * 64;
  bf16_t* mix = (bf16_t*)(p.ws + OFF_MIX) + (size_t)tok * 1024 + 256 + head * 64;
#pragma unroll
  for (int dvb = 0; dvb < 2; ++dvb) {
    { const f32x16 gb = gain_block(gs + dvb * 32, half);
#pragma unroll
      for (int r = 0; r < 16; ++r) R[dvb][r] *= rstd * gb[r]; }
    store_block_bf16(mix + dvb * 32, R[dvb], half);
  }
}

DI void run_phase(const Params& p, int ph, char* lds, int* s_item, int vb) {
#ifdef ONLY_SUB
  const int l = (ph - 1) / 10, sub = ONLY_SUB;
  if (ONLY_SUB == 10) { setup_phase(p, lds); return; }
#else
  if (ph == 0) { setup_phase(p, lds); return; }
  const int l = (ph - 1) / 10, sub = (ph - 1) % 10;
#endif
  const float* modl = (const float*)(p.ws + OFF_MOD) + (size_t)l * 5 * 6144;
  switch (sub) {
    case 0: norm_phase(p, l, 0); break;
    case 1: {
      EpiInProj epi{(bf16_t*)(p.ws + OFF_PROJ), (float*)(p.ws + OFF_DT)};
      const bf16_t* A = (const bf16_t*)(p.ws + OFF_HBUF);
      const bf16_t* Bt = (const bf16_t*)(p.ws + OFF_WIN) + (size_t)l * NPROJP * 1024;
      gemm_phase<256>(A, 1024, Bt, 1024, 1024, 48, 10, lds, vb, epi);
    } break;
    case 2: prep_phase(p, l, lds); break;
    case 3: {
      const int hb = get_hb();
      for (int pair = blockIdx.x; pair < NCHUNK * 4; pair += gridDim.x) ssd_states_item(p, l, pair * 2 + hb, lds + hb * HALF_LDS);
    } break;
    case 4: ssd_scan_phase(p, l); break;
    case 5: {
      unsigned* ctr = (unsigned*)(p.ws + OFF_CTR) + l;
      const int hb = get_hb();
      for (;;) {
        __syncthreads();
        if (threadIdx.x == 0) *s_item = (int)atomicAdd(ctr, 1u);
        __syncthreads();
        const int it = *s_item;
        if (it >= 672) break;
        if (it < 96) ssd_y_item(p, l, it, lds);
        else if (it < 224) attn_mla_item(p, (it - 96) * 2 + hb, lds + hb * HALF_LDS);
        else if (it < 480) attn_diff_item(p, l, it - 224, lds);
        else if (it < 544) attn_mla_item(p, 256 + (it - 480) * 2 + hb, lds + hb * HALF_LDS);
        else attn_diff_item(p, l, 256 + (it - 544), lds);
      }
    } break;
    case 6: {
      EpiResid epi{l == 0 ? p.in[0] : nullptr, l == 0 ? p.in[1] : nullptr, (bf16_t*)(p.ws + OFF_XB), nullptr, modl + 2048};
      const bf16_t* A = (const bf16_t*)(p.ws + OFF_MIX);
      const bf16_t* Bt = (const bf16_t*)(p.ws + OFF_WOUT) + (size_t)l * 1024 * 1024;
      gemm_phase<192>(A, 1024, Bt, 1024, 1024, 64, 4, lds, vb, epi);
    } break;
    case 7: norm_phase(p, l, 1); break;
    case 8: {
      EpiFF1 epi{(bf16_t*)(p.ws + OFF_UBUF)};
      const bf16_t* A = (const bf16_t*)(p.ws + OFF_HBUF);
      const bf16_t* Bt = (const bf16_t*)(p.ws + OFF_WFF1) + (size_t)l * 4096 * 1024;
      gemm_phase<256>(A, 1024, Bt, 1024, 1024, 48, 16, lds, vb, epi);
    } break;
    case 9: {
      EpiResid epi{nullptr, nullptr, (bf16_t*)(p.ws + OFF_XB), l == DEPTH - 1 ? p.out : nullptr, modl + 5120};
      const bf16_t* A = (const bf16_t*)(p.ws + OFF_UBUF);
      const bf16_t* Bt = (const bf16_t*)(p.ws + OFF_WFF2) + (size_t)l * 1024 * 4096;
      gemm_phase<192>(A, 4096, Bt, 4096, 4096, 64, 4, lds, vb, epi);
    } break;
  }
}

constexpr int N_PHASES = 1 + 10 * DEPTH;

__global__ void __launch_bounds__(512, 2) fwd_megakernel(Params p) {
  __shared__ __attribute__((aligned(1024))) char lds[LDS_BYTES + 64];
  uint4& xb_words = *(uint4*)(lds + LDS_BYTES);
  int* s_item = (int*)(lds + LDS_BYTES + 16);
  if (p.ph_end - p.ph_begin == 1) { run_phase(p, p.ph_begin, lds, s_item, blockIdx.x); return; }
  if (p.ph_begin < 0) { cg::this_grid().sync(); return; }
  if (threadIdx.x == 0) xb_words = make_uint4(0u, 0u, 0u, 0u);
  __syncthreads();
  XcdBarrier b = xcd_barrier_post((unsigned*)(p.ws + OFF_BAR), (volatile LAS unsigned*)&xb_words);
  const int vb = blockIdx.x;
  for (int ph = p.ph_begin; ph < p.ph_end; ++ph) {
    run_phase(p, ph, lds, s_item, vb);
    if (ph + 1 < p.ph_end) xcd_barrier(b);
  }
}

extern "C" void kernel_launch(void* const* d_in, const int* in_sizes, int n_in, void* d_out, int out_size, void* d_ws, size_t ws_size, hipStream_t stream) {
  static int grid_blocks = 0;
  if (!grid_blocks) {
    int dev = 0, cus = 0, per_cu = 0;
    (void)hipGetDevice(&dev);
    (void)hipDeviceGetAttribute(&cus, hipDeviceAttributeMultiprocessorCount, dev);
    (void)hipOccupancyMaxActiveBlocksPerMultiprocessor(&per_cu, fwd_megakernel, 512, 0);
    if (per_cu > 1) per_cu = 1;
    if (per_cu < 1) per_cu = 1;
    grid_blocks = cus * per_cu;
  }
  Params p{};
  for (int i = 0; i < 36; ++i) p.in[i] = (const float*)d_in[i];
  p.out = (float*)d_out;
  p.ws = (char*)d_ws;
  (void)hipMemsetAsync(d_ws, 0, 16384, stream);
#if MULTI_LAUNCH
  for (int ph = 0; ph < N_PHASES; ++ph) {
    p.ph_begin = ph; p.ph_end = ph + 1;
    hipLaunchKernelGGL(fwd_megakernel, dim3(grid_blocks), dim3(512), 0, stream, p);
  }
#else
  p.ph_begin = 0; p.ph_end = N_PHASES;
  void* args[] = {&p};
  hipError_t e = hipLaunchCooperativeKernel((void*)fwd_megakernel, dim3(grid_blocks), dim3(512), args, 0, stream);
  if (e != hipSuccess) fprintf(stderr, "cooperative launch failed: %s (grid %d)\n", hipGetErrorString(e), grid_blocks);
#endif
}
```

```cpp
#include <hip/hip_runtime.h>
#include <hip/hip_cooperative_groups.h>
#include <stdint.h>
#include <stdio.h>
namespace cg = cooperative_groups;

#ifndef MULTI_LAUNCH
#define MULTI_LAUNCH 0
#endif

#define DI __device__ __forceinline__
#define LAS __attribute__((address_space(3)))
typedef unsigned short bf16_t;
typedef short bf16x8 __attribute__((ext_vector_type(8)));
typedef short s16x4 __attribute__((ext_vector_type(4)));
typedef float f32x16 __attribute__((ext_vector_type(16)));
typedef float f32x4 __attribute__((ext_vector_type(4)));
typedef unsigned u32x4 __attribute__((ext_vector_type(4)));
typedef unsigned u32x2 __attribute__((ext_vector_type(2)));
#define MFMA32(a, b, c) __builtin_amdgcn_mfma_f32_32x32x16_bf16((a), (b), (c), 0, 0, 0)

constexpr int D = 1024, TP = 4096, TS = 8192, T = 12288, DEPTH = 4, PAST = 256;
constexpr int NPROJ = 2480, NPROJP = 2560, DFF = 4096;
constexpr int NKEY = 4096 + 4 * 2304;
constexpr int C_CQ = 0, C_CKV = 256, C_KR = 384, C_DQ = 416, C_DK = 672, C_DV = 928, C_Z = 1184, C_XBC = 1696, C_DT = 2464;
constexpr float EPS = 1e-6f;
constexpr int NCHUNK = 96;

constexpr size_t O_Y = 0, O_CKV = 12582912, O_KROPE = 14680064, O_DK = 15204352, O_DV = 19398656, O_SSM = 23592960;

constexpr size_t OFF_BAR = 0;
constexpr size_t OFF_XRANK = 14080;
constexpr size_t OFF_CTR = 14336;
constexpr size_t OFF_LAM = 15360;
constexpr size_t OFF_MOD = 16384;
constexpr size_t OFF_ROPE = OFF_MOD + 4ull * 5 * 6144 * 4;
constexpr size_t OFF_WIN = OFF_ROPE + 2048ull * 32 * 4;
constexpr size_t OFF_WOUT = OFF_WIN + 4ull * NPROJP * 1024 * 2;
constexpr size_t OFF_WFF1 = OFF_WOUT + 4ull * 1024 * 1024 * 2;
constexpr size_t OFF_WFF2 = OFF_WFF1 + 4ull * 4096 * 1024 * 2;
constexpr size_t OFF_WUQ = OFF_WFF2 + 4ull * 4096 * 1024 * 2;
constexpr size_t OFF_WUKV = OFF_WUQ + 4ull * 384 * 256 * 2;
constexpr size_t OFF_HBUF = OFF_WUKV + 4ull * 512 * 128 * 2;
constexpr size_t OFF_MIX = OFF_HBUF + (size_t)T * 1024 * 2;
constexpr size_t OFF_DT = OFF_MIX + (size_t)T * 1024 * 2;
constexpr size_t OFF_R = OFF_DT + (size_t)T * 16 * 4;
constexpr size_t OFF_UBUF = OFF_R;
constexpr size_t OFF_PROJ = OFF_R;
constexpr size_t OFF_QA = OFF_PROJ + (size_t)T * NPROJP * 2;
constexpr size_t OFF_KA = OFF_QA + (size_t)T * 384 * 2;
constexpr size_t OFF_VAT = OFF_KA + (size_t)NKEY * 384 * 2;
constexpr size_t OFF_QD = OFF_VAT + 256ull * NKEY * 2;
constexpr size_t OFF_KD = OFF_QD + (size_t)T * 256 * 2;
constexpr size_t OFF_VDT = OFF_KD + (size_t)NKEY * 256 * 2;
constexpr size_t OFF_XBC = OFF_VDT + 256ull * NKEY * 2;
constexpr size_t OFF_ST = OFF_XBC + (size_t)T * 768 * 2;
constexpr size_t OFF_HP = OFF_ST + 96ull * 8 * 2 * 4096 * 4;
constexpr size_t OFF_CDEC = OFF_HP + 96ull * 8 * 2 * 4096 * 2;
constexpr size_t OFF_XB = OFF_CDEC + 96ull * 16 * 4;
constexpr size_t WS_END = OFF_XB + (size_t)T * 1024 * 2;

struct Params {
  const float* in[36];
  float* out;
  char* ws;
  int ph_begin, ph_end;
};

DI unsigned pk2(float lo, float hi) { unsigned r; asm("v_cvt_pk_bf16_f32 %0, %1, %2" : "=v"(r) : "v"(lo), "v"(hi)); return r; }
DI float bflo(unsigned u) { return __uint_as_float(u << 16); }
DI float bfhi(unsigned u) { return __uint_as_float(u & 0xffff0000u); }
DI float bf1(bf16_t h) { return __uint_as_float(((unsigned)h) << 16); }
DI bf16_t f2bf(float x) { return (bf16_t)(pk2(x, 0.f) & 0xffffu); }
DI int crow(int r, int half) { return (r & 3) + 8 * (r >> 2) + 4 * half; }
DI float xor32(float v) { return __shfl_xor(v, 32); }
DI float wave_sum(float v) {
#pragma unroll
  for (int o = 32; o > 0; o >>= 1) v += __shfl_xor(v, o);
  return v;
}
DI f32x16 zero16() { f32x16 z; for (int i = 0; i < 16; ++i) z[i] = 0.f; return z; }
DI int get_tid() { int t = threadIdx.x; asm volatile("" : "+v"(t)); return t; }
DI int get_tid4() { return get_tid() & 255; }
DI int get_hb() { return get_tid() >> 8; }
DI int modrow_of(int m) { return m < TP ? 0 : 1 + ((m - TP) >> 11); }

#define XB_TMO      128
#define XB_XCNT(j)  (256  + 64 * (j))
#define XB_XSUB(j)  (1280 + 64 * (j))
#define XB_XGEN(j)  (2304 + 64 * (j))
#define XB_TOP      3328
#define XB_TOPGEN   3392
#define XCD_BAR_WORDS 3456
#define XB_SPIN_CAP (1u << 22)
DI unsigned xb_ld(unsigned* p) { return __hip_atomic_load(p, __ATOMIC_RELAXED, __HIP_MEMORY_SCOPE_AGENT); }
DI unsigned xb_add(unsigned* p, unsigned v) { return __hip_atomic_fetch_add(p, v, __ATOMIC_RELAXED, __HIP_MEMORY_SCOPE_AGENT); }
DI unsigned xb_xcc_id() { return (unsigned)__builtin_amdgcn_s_getreg((3 << 11) | 20) & 0xFu; }
#define XB_SPIN(cond, bar) do { unsigned _sp = 0; while (cond) { __builtin_amdgcn_s_sleep(1); \
    if ((++_sp & 255u) == 0u) { if (xb_ld(&(bar)[XB_TMO])) break; if (_sp > XB_SPIN_CAP) { atomicAdd(&(bar)[XB_TMO], 1u); break; } } } } while (0)
struct XcdBarrier { unsigned* bar; unsigned x; volatile LAS unsigned* st; };
DI XcdBarrier xcd_barrier_post(unsigned* bar, volatile LAS unsigned* st) {
  XcdBarrier b; b.bar = bar; b.x = xb_xcc_id(); b.st = st;
  if (threadIdx.x == 0) (void)xb_add(&bar[XB_XCNT(b.x)], 1u);
  return b;
}
DI void xcd_barrier_complete(unsigned* bar, unsigned x, unsigned& nloc, unsigned& nx) {
  const unsigned G = gridDim.x * gridDim.y * gridDim.z;
  unsigned sum, cnt, mine, sp = 0u;
  for (;;) {
    sum = 0u; cnt = 0u; mine = 0u;
#pragma unroll
    for (unsigned j = 0; j < 16; ++j) { const unsigned c = xb_ld(&bar[XB_XCNT(j)]); sum += c; cnt += (c > 0u) ? 1u : 0u; mine = (j == x) ? c : mine; }
    if (sum == G) break;
    __builtin_amdgcn_s_sleep(1);
    if ((++sp & 255u) == 0u) { if (xb_ld(&bar[XB_TMO])) break; if (sp > XB_SPIN_CAP) { atomicAdd(&bar[XB_TMO], 1u); break; } }
  }
  nloc = mine > 0u ? mine : 1u; nx = cnt > 0u ? cnt : 1u;
}
DI void xcd_barrier(const XcdBarrier& b) {
  asm volatile("s_waitcnt vmcnt(0)" ::: "memory");
  __syncthreads();
  if (threadIdx.x == 0) {
    unsigned* bar = b.bar;
    __builtin_amdgcn_s_waitcnt(0);
    unsigned nloc = b.st[0], nx = b.st[1];
    if (nloc == 0u) { xcd_barrier_complete(bar, b.x, nloc, nx); b.st[0] = nloc; b.st[1] = nx; }
    const unsigned old = xb_add(&bar[XB_XSUB(b.x)], 1u);
    const unsigned gen = old / nloc;
    if (old + 1u == (gen + 1u) * nloc) {
      __builtin_amdgcn_fence(__ATOMIC_RELEASE, "agent");
      asm volatile("s_waitcnt vmcnt(0)" ::: "memory");
      const unsigned og = xb_add(&bar[XB_TOP], 1u);
      const unsigned tg = og / nx;
      if (og + 1u == (tg + 1u) * nx) xb_add(&bar[XB_TOPGEN], 1u);
      else XB_SPIN(xb_ld(&bar[XB_TOPGEN]) == tg, bar);
      __builtin_amdgcn_fence(__ATOMIC_ACQUIRE, "agent");
      xb_add(&bar[XB_XGEN(b.x)], 1u);
      asm volatile("s_waitcnt vmcnt(0)" ::: "memory");
    } else {
      XB_SPIN(xb_ld(&bar[XB_XGEN(b.x)]) == gen, bar);
      __builtin_amdgcn_fence(__ATOMIC_ACQUIRE, "agent");
      asm volatile("s_waitcnt vmcnt(0)" ::: "memory");
    }
  }
  __syncthreads();
}

constexpr int HALF_LDS = 75776;
constexpr int LDS_BYTES = 2 * HALF_LDS;
constexpr int PITCH64 = 144;
constexpr int PITCH128 = 272;
constexpr int PITCH96 = 208;

DI void transpose_tile4(const float* src, int K, int N, bf16_t* dst, int t0, int ncols, char* lds) {
  float* tile = (float*)lds;
  const int tid = get_tid4();
  f32x4 v[4][4];
#pragma unroll
  for (int q = 0; q < 4; ++q) {
    const int k0 = ((t0 + q) / ncols) * 64, n0 = ((t0 + q) % ncols) * 64;
#pragma unroll
    for (int i = 0; i < 4; ++i) {
      const int r = (tid >> 4) + 16 * i, c4 = (tid & 15) * 4;
      v[q][i] = (f32x4){0.f, 0.f, 0.f, 0.f};
      if (n0 + c4 < N) v[q][i] = *(const f32x4*)(src + (size_t)(k0 + r) * N + n0 + c4);
    }
  }
  __syncthreads();
#pragma unroll
  for (int q = 0; q < 4; ++q)
#pragma unroll
    for (int i = 0; i < 4; ++i) {
      const int r = (tid >> 4) + 16 * i, c4 = (tid & 15) * 4;
      float* t = tile + q * (64 * 65) + r * 65 + c4;
      t[0] = v[q][i][0]; t[1] = v[q][i][1]; t[2] = v[q][i][2]; t[3] = v[q][i][3];
    }
  __syncthreads();
#pragma unroll
  for (int q = 0; q < 4; ++q) {
    const int k0 = ((t0 + q) / ncols) * 64, n0 = ((t0 + q) % ncols) * 64;
    const float* tq = tile + q * (64 * 65);
#pragma unroll
    for (int i = 0; i < 2; ++i) {
      const int n = (tid >> 3) + 32 * i, kc = (tid & 7) * 8;
      u32x4 w;
      w[0] = pk2(tq[(kc + 0) * 65 + n], tq[(kc + 1) * 65 + n]);
      w[1] = pk2(tq[(kc + 2) * 65 + n], tq[(kc + 3) * 65 + n]);
      w[2] = pk2(tq[(kc + 4) * 65 + n], tq[(kc + 5) * 65 + n]);
      w[3] = pk2(tq[(kc + 6) * 65 + n], tq[(kc + 7) * 65 + n]);
      *(u32x4*)(dst + (size_t)(n0 + n) * K + k0 + kc) = w;
    }
  }
}

DI void mod_item(const Params& p, int item, char* lds) {
  float* sc = (float*)lds;
  float* red = sc + 5 * 1024;
  const int tid = get_tid4(), lane = tid & 63, w = tid >> 6;
  const int l = item / 96, j0 = (item % 96) * 64;
  __syncthreads();
  for (int i = tid; i < 5 * 1024; i += 256) {
    const int r = i >> 10, k = i & 1023;
    const float v = (r == 0) ? p.in[8][k] : p.in[7][(r - 1) * 1024 + k];
    sc[i] = v / (1.f + __expf(-v));
  }
  __syncthreads();
  const float* W = p.in[11] + (size_t)l * 1024 * 6144 + j0 + lane;
  float a0 = 0.f, a1 = 0.f, a2 = 0.f, a3 = 0.f, a4 = 0.f;
  const int kb = w * 256;
#pragma unroll 32
  for (int k = 0; k < 256; ++k) {
    const float wv = W[(size_t)(kb + k) * 6144];
    a0 += sc[kb + k] * wv; a1 += sc[1024 + kb + k] * wv; a2 += sc[2048 + kb + k] * wv; a3 += sc[3072 + kb + k] * wv; a4 += sc[4096 + kb + k] * wv;
  }
  red[(w * 5 + 0) * 64 + lane] = a0; red[(w * 5 + 1) * 64 + lane] = a1; red[(w * 5 + 2) * 64 + lane] = a2;
  red[(w * 5 + 3) * 64 + lane] = a3; red[(w * 5 + 4) * 64 + lane] = a4;
  __syncthreads();
  for (int i = tid; i < 320; i += 256) {
    const int r = i / 64, c = i % 64;
    const float s = red[(0 * 5 + r) * 64 + c] + red[(1 * 5 + r) * 64 + c] + red[(2 * 5 + r) * 64 + c] + red[(3 * 5 + r) * 64 + c];
    float* mod = (float*)(p.ws + OFF_MOD);
    mod[((size_t)l * 5 + r) * 6144 + j0 + c] = s + p.in[12][(size_t)l * 6144 + j0 + c];
  }
}

DI void setup_phase(const Params& p, char* lds) {
  constexpr int N_IN = 16 * 40 / 4, N_OUT = 16 * 16 / 4, N_F1 = 16 * 64 / 4, N_F2 = 64 * 16 / 4, N_UQ = 4 * 6 / 4, N_UKV = 2 * 8 / 4;
  constexpr int PER_L = N_IN + N_OUT + N_F1 + N_F2 + N_UQ + N_UKV;
  constexpr int N_TR = PER_L * 4, N_MOD = 384, N_ROPE = 64;
  static_assert((N_MOD + N_TR) % 2 == 0, "pairing");
  if (blockIdx.x == 0 && get_tid() < 4) {
    const int l = get_tid();
    float d1 = 0.f, d2 = 0.f;
    for (int k = 0; k < 32; ++k) { d1 += p.in[23][l * 32 + k] * p.in[24][l * 32 + k]; d2 += p.in[25][l * 32 + k] * p.in[26][l * 32 + k]; }
    const float lam_init = 0.8f - 0.6f * expf(-0.3f * (float)l);
    float* lamp = (float*)(p.ws + OFF_LAM);
    lamp[l * 2] = expf(d1) - expf(d2) + lam_init; lamp[l * 2 + 1] = lam_init;
  }
  const int hb = get_hb();
  lds += hb * HALF_LDS;
  for (int pair = blockIdx.x; pair < (N_MOD + N_TR) / 2; pair += gridDim.x) {
    const int item = pair * 2 + hb;
    if (item < N_MOD) { mod_item(p, item, lds); continue; }
    int it = item - N_MOD;
    {
      const int l = it / PER_L; int r = it % PER_L;
      if (r < N_IN) { transpose_tile4(p.in[13] + (size_t)l * 1024 * NPROJ, 1024, NPROJ, (bf16_t*)(p.ws + OFF_WIN) + (size_t)l * NPROJP * 1024, r * 4, 40, lds); continue; }
      r -= N_IN;
      if (r < N_OUT) { transpose_tile4(p.in[14] + (size_t)l * 1024 * 1024, 1024, 1024, (bf16_t*)(p.ws + OFF_WOUT) + (size_t)l * 1024 * 1024, r * 4, 16, lds); continue; }
      r -= N_OUT;
      if (r < N_F1) { transpose_tile4(p.in[34] + (size_t)l * 1024 * 4096, 1024, 4096, (bf16_t*)(p.ws + OFF_WFF1) + (size_t)l * 4096 * 1024, r * 4, 64, lds); continue; }
      r -= N_F1;
      if (r < N_F2) { transpose_tile4(p.in[35] + (size_t)l * 4096 * 1024, 4096, 1024, (bf16_t*)(p.ws + OFF_WFF2) + (size_t)l * 1024 * 4096, r * 4, 16, lds); continue; }
      r -= N_F2;
      if (r < N_UQ) { transpose_tile4(p.in[17] + (size_t)l * 256 * 384, 256, 384, (bf16_t*)(p.ws + OFF_WUQ) + (size_t)l * 384 * 256, r * 4, 6, lds); continue; }
      r -= N_UQ;
      transpose_tile4(p.in[18] + (size_t)l * 128 * 512, 128, 512, (bf16_t*)(p.ws + OFF_WUKV) + (size_t)l * 512 * 128, r * 4, 8, lds);
    }
  }
  for (int it = blockIdx.x; it < N_ROPE; it += gridDim.x) {
    {
      const int idx = it * 512 + get_tid();
      const int pos = idx >> 4, j = idx & 15;
      const float fr = __builtin_amdgcn_exp2f(-(float)(j & 7) * (13.287712379549449f / 8.f));
      const float base = (j < 8) ? (float)(pos >> 6) : (float)(pos & 63);
      float rev = base * fr * 0.15915494309189535f;
      rev -= floorf(rev);
      float* tab = (float*)(p.ws + OFF_ROPE);
      tab[idx * 2 + 0] = __builtin_amdgcn_cosf(rev);
      tab[idx * 2 + 1] = __builtin_amdgcn_sinf(rev);
    }
  }
}

DI const float* x_row_in(const Params& p, int l, int m) {
  if (l == 0) return m < TP ? p.in[0] + (size_t)m * D : p.in[1] + (size_t)(m - TP) * D;
  return p.out + (size_t)m * D;
}
DI void norm_phase(const Params& p, int l, int which) {
  const int tid = get_tid(), lane = tid & 63, w = tid >> 6;
  const float* g = p.in[which == 0 ? 9 : 10] + (size_t)l * D;
  const float* modl = (const float*)(p.ws + OFF_MOD) + (size_t)l * 5 * 6144;
  bf16_t* hbuf = (bf16_t*)(p.ws + OFF_HBUF);
  constexpr int RW = 6;
  for (int item = blockIdx.x; item < T / (8 * RW); item += gridDim.x) {
    const int m0 = item * 8 * RW + w * RW;
    f32x4 v[RW][4];
#pragma unroll
    for (int rr = 0; rr < RW; ++rr) {
      if (which == 0 && l == 0) {
        const float* x = x_row_in(p, 0, m0 + rr);
#pragma unroll
        for (int i = 0; i < 4; ++i) v[rr][i] = *(const f32x4*)(x + (i >> 1) * 512 + lane * 8 + (i & 1) * 4);
      } else {
        const bf16_t* x = (const bf16_t*)(p.ws + OFF_XB) + (size_t)(m0 + rr) * D;
#pragma unroll
        for (int j = 0; j < 2; ++j) { const u32x4 r = *(const u32x4*)(x + j * 512 + lane * 8);
          v[rr][2 * j] = (f32x4){bflo(r[0]), bfhi(r[0]), bflo(r[1]), bfhi(r[1])}; v[rr][2 * j + 1] = (f32x4){bflo(r[2]), bfhi(r[2]), bflo(r[3]), bfhi(r[3])}; }
      }
    }
    f32x4 gg[4];
#pragma unroll
    for (int i = 0; i < 4; ++i) gg[i] = *(const f32x4*)(g + (i >> 1) * 512 + lane * 8 + (i & 1) * 4);
#pragma unroll
    for (int rr = 0; rr < RW; ++rr) {
      const int m = m0 + rr;
      const float* mod = modl + (size_t)modrow_of(m) * 6144 + (which == 0 ? 0 : 3072);
      float ss = 0.f;
#pragma unroll
      for (int i = 0; i < 4; ++i) ss += v[rr][i][0] * v[rr][i][0] + v[rr][i][1] * v[rr][i][1] + v[rr][i][2] * v[rr][i][2] + v[rr][i][3] * v[rr][i][3];
      ss = wave_sum(ss);
      const float rstd = rsqrtf(ss * (1.f / D) + EPS);
#pragma unroll
      for (int j = 0; j < 2; ++j) {
        u32x4 wv;
#pragma unroll
        for (int ii = 0; ii < 2; ++ii) {
          const int i = 2 * j + ii, c = j * 512 + lane * 8 + ii * 4;
          const f32x4 sh = *(const f32x4*)(mod + c), scl = *(const f32x4*)(mod + 1024 + c);
          float o[4];
#pragma unroll
          for (int e = 0; e < 4; ++e) o[e] = v[rr][i][e] * rstd * gg[i][e] * (1.f + scl[e]) + sh[e];
          wv[2 * ii] = pk2(o[0], o[1]); wv[2 * ii + 1] = pk2(o[2], o[3]);
        }
        *(u32x4*)(hbuf + (size_t)m * D + j * 512 + lane * 8) = wv;
      }
    }
  }
}

DI int lds_byte2(int r, int c) { const int st = (r >> 4) * 2 + (c >> 5), ob = (r & 15) * 64 + (c & 31) * 2; return st * 1024 + (ob ^ (((ob >> 9) & 1) << 5)); }
DI void stage_rc2(int b, int& R, int& C) { const int st = b >> 10, sb = b & 1023, swz = sb ^ (((sb >> 9) & 1) << 5); R = (st >> 1) * 16 + swz / 64; C = (st & 1) * 32 + (swz % 64) / 2; }
#define WAIT_V0() asm volatile("s_waitcnt vmcnt(0)" ::: "memory")
DI bool unit_next(int vb, int i, int nM, int nN, int& pm, int& pn) {
  const int nwg = nM * nN;
  const long L = (long)i * gridDim.x + vb; if (L >= nwg) return false;
  int wgid = (int)L; { const int q = nwg / 8, r = nwg % 8, xcd = wgid % 8, off = wgid / 8; wgid = (xcd < r ? xcd * (q + 1) : r * (q + 1) + (xcd - r) * q) + off; }
  const int nig = 8 * nN, gid = wgid / nig, fm = gid * 8, gsz = (nM - fm) < 8 ? (nM - fm) : 8;
  pm = fm + ((wgid % nig) % gsz); pn = (wgid % nig) / gsz; return true;
}
template <int BM, class Epi>
DI void gemm_phase(const bf16_t* __restrict__ A, int lda, const bf16_t* __restrict__ Bt, int ldb, int K, int nM, int nN, char* shm, int vb, Epi epi) {
  constexpr int BK = 64, TILE_B = 256 * BK * 2, GL = 4, STAGE_B = 2 * TILE_B, GLA = BM / 64, MB = BM / 32;
  const int tid = get_tid(), wid = tid >> 6, lane = tid & 63, wr = wid >> 2, wc = wid & 3, fr = lane & 15, fq = lane >> 4;
  int sR[GL], sC[GL];
#pragma unroll
  for (int i = 0; i < GL; ++i) stage_rc2(wid * 1024 + i * 8192 + lane * 16, sR[i], sC[i]);
  const int lo_ = (fr * 64 + fq * 16) ^ ((fr >> 3) << 5);
  const int aoff = wr * (BM / 32) * 2048 + lo_, boff = TILE_B + wc * 8192 + lo_;
  int sRB[GL];
#pragma unroll
  for (int i = 0; i < GL; ++i) { const int rho = sR[i] & 31, nn = rho >> 4, ii = rho & 15; sRB[i] = (sR[i] & ~31) + 8 * (ii >> 2) + 4 * nn + (ii & 3); }
#define SA_(b) (shm + (b) * STAGE_B)
#define SB_(b) (shm + (b) * STAGE_B + TILE_B)
#define GLDS_STAGE(buf, Ab_, Bb_, kt) do { _Pragma("unroll") for (int i = 0; i < GL; ++i) { \
    if (i < GLA) __builtin_amdgcn_global_load_lds((const unsigned*)((Ab_) + (size_t)sR[i] * lda + (kt) * BK + sC[i]), (LAS unsigned*)(SA_(buf) + wid * 1024 + i * 8192), 16, 0, 0); \
    __builtin_amdgcn_global_load_lds((const unsigned*)((Bb_) + (size_t)sRB[i] * ldb + (kt) * BK + sC[i]), (LAS unsigned*)(SB_(buf) + wid * 1024 + i * 8192), 16, 0, 0); } } while (0)
  int pm, pn;
  if (!unit_next(vb, 0, nM, nN, pm, pn)) return;
  const int nt = K / BK;
  GLDS_STAGE(0, A + (size_t)pm * BM * lda, Bt + (size_t)pn * 256 * ldb, 0);
#pragma unroll 1
  for (int ui = 0;; ++ui) {
    int npm = 0, npn = 0;
    const bool hn = unit_next(vb, ui + 1, nM, nN, npm, npn);
    f32x4 acc[MB][4];
#pragma unroll
    for (int m = 0; m < MB; ++m)
#pragma unroll
      for (int n = 0; n < 4; ++n) acc[m][n] = (f32x4){0.f, 0.f, 0.f, 0.f};
    WAIT_V0(); __syncthreads();
#pragma unroll 1
    for (int t = 0; t < nt; ++t) {
      const int cur = t & 1;
      {
        const bool last = t + 1 >= nt;
        if (!last || hn) {
          const bf16_t* Ab = A + (size_t)(last ? npm : pm) * BM * lda + (last ? 0 : (t + 1) * BK);
          const bf16_t* Bb = Bt + (size_t)(last ? npn : pn) * 256 * ldb + (last ? 0 : (t + 1) * BK);
          GLDS_STAGE(cur ^ 1, Ab, Bb, 0);
        }
      }
      if constexpr (BM == 192) {
        bf16x8 At[2][MB], Bf[2][4];
#pragma unroll
        for (int ks = 0; ks < 2; ++ks) {
#pragma unroll
          for (int n = 0; n < 4; ++n) Bf[ks][n] = *(const bf16x8*)(shm + cur * STAGE_B + boff + (n * 2 + ks) * 1024);
#pragma unroll
          for (int m = 0; m < MB; ++m) At[ks][m] = *(const bf16x8*)(shm + cur * STAGE_B + aoff + (m * 2 + ks) * 1024);
          __builtin_amdgcn_sched_barrier(0);
        }
#pragma unroll
        for (int ks = 0; ks < 2; ++ks) {
#pragma unroll
          for (int m = 0; m < MB; ++m)
#pragma unroll
            for (int n = 0; n < 4; ++n) acc[m][n] = __builtin_amdgcn_mfma_f32_16x16x32_bf16(Bf[ks][n], At[ks][m], acc[m][n], 0, 0, 0);
          __builtin_amdgcn_sched_barrier(0);
        }
      } else {
#pragma unroll
        for (int ks = 0; ks < 2; ++ks) {
          bf16x8 At[MB], Bf[4];
#pragma unroll
          for (int n = 0; n < 4; ++n) Bf[n] = *(const bf16x8*)(shm + cur * STAGE_B + boff + (n * 2 + ks) * 1024);
#pragma unroll
          for (int m = 0; m < MB; ++m) At[m] = *(const bf16x8*)(shm + cur * STAGE_B + aoff + (m * 2 + ks) * 1024);
          __builtin_amdgcn_sched_barrier(0);
#pragma unroll
          for (int m = 0; m < MB; ++m)
#pragma unroll
            for (int n = 0; n < 4; ++n) acc[m][n] = __builtin_amdgcn_mfma_f32_16x16x32_bf16(Bf[n], At[m], acc[m][n], 0, 0, 0);
          __builtin_amdgcn_sched_barrier(0);
        }
      }
      if (t + 1 < nt) { WAIT_V0(); __syncthreads(); }
    }
    const int brow = pm * BM, bcol = pn * 256;
    if constexpr (Epi::PRELOAD) {
      u32x4 xr[MB][2];
#pragma unroll
      for (int m = 0; m < MB; ++m)
#pragma unroll
        for (int g2 = 0; g2 < 2; ++g2) xr[m][g2] = epi.preload(brow + wr * (BM / 2) + m * 16 + fr, bcol + wc * 64 + g2 * 32 + fq * 8);
#pragma unroll
      for (int m = 0; m < MB; ++m)
#pragma unroll
        for (int g2 = 0; g2 < 2; ++g2) epi(brow + wr * (BM / 2) + m * 16 + fr, bcol + wc * 64 + g2 * 32 + fq * 8, acc[m][2 * g2], acc[m][2 * g2 + 1], xr[m][g2]);
    } else {
#pragma unroll
      for (int m = 0; m < MB; ++m)
#pragma unroll
        for (int g2 = 0; g2 < 2; ++g2) epi(brow + wr * (BM / 2) + m * 16 + fr, bcol + wc * 64 + g2 * 32 + fq * 8, acc[m][2 * g2], acc[m][2 * g2 + 1]);
    }
    if (!hn) break;
    pm = npm; pn = npn;
  }
  __syncthreads();
#undef SA_
#undef SB_
#undef GLDS_STAGE
}

struct EpiInProj {
  static constexpr bool PRELOAD = false;
  bf16_t* proj; float* dt;
  DI void operator()(int m, int n, const f32x4& v0, const f32x4& v1) const {
    u32x4 o; o[0] = pk2(v0[0], v0[1]); o[1] = pk2(v0[2], v0[3]); o[2] = pk2(v1[0], v1[1]); o[3] = pk2(v1[2], v1[3]);
    *(u32x4*)(proj + (size_t)m * NPROJP + n) = o;
    if (n >= C_DT && n < NPROJ) { float* d = dt + (size_t)m * 16 + (n - C_DT); *(f32x4*)d = v0; *(f32x4*)(d + 4) = v1; }
  }
};
struct EpiResid {
  static constexpr bool PRELOAD = true;
  const float* xin_p; const float* xin_s;
  bf16_t* xb; float* xout_f;
  const float* gate;
  DI u32x4 preload(int m, int n) const { return xin_p ? (u32x4){0u, 0u, 0u, 0u} : *(const u32x4*)(xb + (size_t)m * D + n); }
  DI void operator()(int m, int n, const f32x4& v0, const f32x4& v1, const u32x4& r) const {
    const float* gp = gate + (size_t)modrow_of(m) * 6144 + n;
    const f32x4 g0 = *(const f32x4*)gp, g1 = *(const f32x4*)(gp + 4);
    f32x4 x0, x1;
    if (xin_p) { const float* xi = ((m < TP) ? xin_p + (size_t)m * D : xin_s + (size_t)(m - TP) * D) + n; x0 = *(const f32x4*)xi; x1 = *(const f32x4*)(xi + 4); }
    else { x0 = (f32x4){bflo(r[0]), bfhi(r[0]), bflo(r[1]), bfhi(r[1])}; x1 = (f32x4){bflo(r[2]), bfhi(r[2]), bflo(r[3]), bfhi(r[3])}; }
    const f32x4 y0 = x0 + g0 * v0, y1 = x1 + g1 * v1;
    if (xout_f) { float* o = xout_f + (size_t)m * D + n; *(f32x4*)o = y0; *(f32x4*)(o + 4) = y1; }
    else { u32x4 o; o[0] = pk2(y0[0], y0[1]); o[1] = pk2(y0[2], y0[3]); o[2] = pk2(y1[0], y1[1]); o[3] = pk2(y1[2], y1[3]); *(u32x4*)(xb + (size_t)m * D + n) = o; }
  }
};
struct EpiFF1 {
  static constexpr bool PRELOAD = false;
  bf16_t* u;
  DI void operator()(int m, int n, const f32x4& v0, const f32x4& v1) const {
    float r[8];
#pragma unroll
    for (int e = 0; e < 4; ++e) { const float t0 = v0[e] > 0.f ? v0[e] : 0.f, t1 = v1[e] > 0.f ? v1[e] : 0.f; r[e] = t0 * t0; r[4 + e] = t1 * t1; }
    u32x4 o; o[0] = pk2(r[0], r[1]); o[1] = pk2(r[2], r[3]); o[2] = pk2(r[4], r[5]); o[3] = pk2(r[6], r[7]);
    *(u32x4*)(u + (size_t)m * DFF + n) = o;
  }
};

DI void rope_block(f32x16& v, const float* tab, int pos, int half) {
  const float* t = tab + (size_t)pos * 32;
#pragma unroll
  for (int q = 0; q < 2; ++q)
#pragma unroll
    for (int r = 0; r < 4; ++r) {
      const int fi = q * 8 + r + 4 * half;
      const float c = t[fi * 2], s = t[fi * 2 + 1];
      const float x1 = v[q * 8 + r], x2 = v[q * 8 + r + 4];
      v[q * 8 + r] = x1 * c - x2 * s;
      v[q * 8 + r + 4] = x2 * c + x1 * s;
    }
}
DI void store_block_bf16(bf16_t* dst, const f32x16& v, int half) {
#pragma unroll
  for (int q = 0; q < 4; q += 2) {
    unsigned ax = pk2(v[4 * q], v[4 * q + 1]), ay = pk2(v[4 * q + 2], v[4 * q + 3]);
    unsigned bx = pk2(v[4 * q + 4], v[4 * q + 5]), by = pk2(v[4 * q + 6], v[4 * q + 7]);
    { auto r = __builtin_amdgcn_permlane32_swap(ax, bx, false, false); ax = r[0]; bx = r[1]; }
    { auto r = __builtin_amdgcn_permlane32_swap(ay, by, false, false); ay = r[0]; by = r[1]; }
    u32x4 wv; wv[0] = ax; wv[1] = ay; wv[2] = bx; wv[3] = by;
    *(u32x4*)(dst + 8 * q + 8 * half) = wv;
  }
}
DI f32x16 gain_block(const float* g, int half) {
  f32x16 o;
#pragma unroll
  for (int q = 0; q < 4; ++q) { const f32x4 v = *(const f32x4*)(g + 8 * q + 4 * half); o[4 * q] = v[0]; o[4 * q + 1] = v[1]; o[4 * q + 2] = v[2]; o[4 * q + 3] = v[3]; }
  return o;
}
DI float sumsq16(const f32x16& v) { float s = 0.f;
#pragma unroll
  for (int i = 0; i < 16; ++i) s += v[i] * v[i];
  return s; }

DI void mla_q_item(const Params& p, int l, int item4, char* lds) {
  const int item = item4 >> 2, head0 = item4 & 3;
  const int lane = get_tid() & 63, w = get_tid() >> 6, l32 = lane & 31, half = lane >> 5;
  {
    const bf16_t* Wg = (const bf16_t*)(p.ws + OFF_WUQ) + ((size_t)l * 384 + head0 * 96) * 256;
    u32x4 t[6];
#pragma unroll
    for (int i = 0; i < 6; ++i) { const int c = get_tid() + 512 * i; t[i] = *(const u32x4*)(Wg + (size_t)(c >> 5) * 256 + (c & 31) * 8); }
    __syncthreads();
#pragma unroll
    for (int i = 0; i < 6; ++i) { const int c = get_tid() + 512 * i; *(u32x4*)(lds + (c >> 5) * 528 + (c & 31) * 16) = t[i]; }
    if (get_tid() < 64) *(f32x4*)(lds + 50688 + get_tid() * 16) = *(const f32x4*)(p.in[15] + (size_t)l * 256 + get_tid() * 4);
  }
  const int tok = item * 256 + w * 32 + l32;
  const bf16_t* proj = (const bf16_t*)(p.ws + OFF_PROJ) + (size_t)tok * NPROJP + C_CQ;
  const float* gq = p.in[15] + (size_t)l * 256;
  float ss = 0.f;
  u32x4 raw[16];
#pragma unroll
  for (int s = 0; s < 16; ++s) raw[s] = *(const u32x4*)(proj + 16 * s + 8 * half);
#pragma unroll
  for (int s = 0; s < 16; ++s) {
#pragma unroll
    for (int e = 0; e < 4; ++e) { const float a = bflo(raw[s][e]), b = bfhi(raw[s][e]); ss += a * a + b * b; }
  }
  ss += xor32(ss);
  const float rstd = rsqrtf(ss * (1.f / 256.f) + EPS);
  __syncthreads();
  bf16x8 fr[16];
#pragma unroll
  for (int s = 0; s < 16; ++s) {
    const f32x4 g0 = *(const f32x4*)(lds + 50688 + (16 * s + 8 * half) * 4), g1 = *(const f32x4*)(lds + 50688 + (16 * s + 8 * half + 4) * 4);
    u32x4 o;
    o[0] = pk2(bflo(raw[s][0]) * rstd * g0[0], bfhi(raw[s][0]) * rstd * g0[1]);
    o[1] = pk2(bflo(raw[s][1]) * rstd * g0[2], bfhi(raw[s][1]) * rstd * g0[3]);
    o[2] = pk2(bflo(raw[s][2]) * rstd * g1[0], bfhi(raw[s][2]) * rstd * g1[1]);
    o[3] = pk2(bflo(raw[s][3]) * rstd * g1[2], bfhi(raw[s][3]) * rstd * g1[3]);
    fr[s] = __builtin_bit_cast(bf16x8, o);
  }
  const bf16_t* W = (const bf16_t*)(p.ws + OFF_WUQ) + (size_t)l * 384 * 256;
  const float* gqk = p.in[19] + (size_t)l * 96;
  const float* tab = (const float*)(p.ws + OFF_ROPE);
  const bool rope = tok >= TP;
  const int pos = rope ? ((tok - TP) & 2047) : 0;
  const float qscale = 0.10206207261596577f * 1.4426950408889634f;
  bf16_t* qa = (bf16_t*)(p.ws + OFF_QA) + (size_t)tok * 384;
#pragma unroll 1
  for (int head = head0; head < head0 + 1; ++head) {
    f32x16 acc[3];
#pragma unroll
    for (int db = 0; db < 3; ++db) acc[db] = zero16();
#pragma unroll
    for (int db = 0; db < 3; ++db) {
      bf16x8 a[16];
      const char* wrow = lds + (db * 32 + l32) * 528 + 16 * half;
#pragma unroll
      for (int s = 0; s < 16; ++s) a[s] = *(const bf16x8*)(wrow + 32 * s);
      __builtin_amdgcn_sched_barrier(0);
#pragma unroll
      for (int s = 0; s < 16; ++s) acc[db] = MFMA32(a[s], fr[s], acc[db]);
      __builtin_amdgcn_sched_barrier(0);
    }
    float s2 = sumsq16(acc[0]) + sumsq16(acc[1]) + sumsq16(acc[2]);
    s2 += xor32(s2);
    const float r2 = rsqrtf(s2 * (1.f / 96.f) + EPS);
#pragma unroll
    for (int db = 0; db < 3; ++db) {
      const f32x16 gb = gain_block(gqk + db * 32, half);
#pragma unroll
      for (int r = 0; r < 16; ++r) acc[db][r] *= r2 * gb[r];
    }
    if (rope) rope_block(acc[2], tab, pos, half);
#pragma unroll
    for (int db = 0; db < 3; ++db) {
#pragma unroll
      for (int r = 0; r < 16; ++r) acc[db][r] *= qscale;
      store_block_bf16(qa + head * 96 + db * 32, acc[db], half);
    }
  }
}

DI void mla_kv_item(const Params& p, int l, int item4, char* lds) {
  const int item = item4 >> 2, head0 = item4 & 3;
  const int lane = get_tid() & 63, w = get_tid() >> 6, l32 = lane & 31, half = lane >> 5;
  {
    const bf16_t* Wg = (const bf16_t*)(p.ws + OFF_WUKV) + ((size_t)l * 512 + head0 * 128) * 128;
    u32x4 t[4];
#pragma unroll
    for (int i = 0; i < 4; ++i) { const int c = get_tid() + 512 * i; t[i] = *(const u32x4*)(Wg + (size_t)(c >> 4) * 128 + (c & 15) * 8); }
    __syncthreads();
#pragma unroll
    for (int i = 0; i < 4; ++i) { const int c = get_tid() + 512 * i; *(u32x4*)(lds + (c >> 4) * PITCH128 + (c & 15) * 16) = t[i]; }
  }
  const int kr = item * 256 + w * 32 + l32;
  int tok = -1, b = 0, j = 0; bool cached = false, rope = false; int pos = 0;
  if (kr < TP) { tok = kr; }
  else { b = (kr - TP) / 2304; j = (kr - TP) % 2304; if (j < PAST) cached = true; else { tok = TP + b * 2048 + (j - PAST); rope = true; pos = j - PAST; } }
  bf16x8 fr[8];
  f32x16 krb;
  if (!cached) {
    const bf16_t* proj = (const bf16_t*)(p.ws + OFF_PROJ) + (size_t)tok * NPROJP;
    const float* gkv = p.in[16] + (size_t)l * 128;
    u32x4 raw[8]; float ss = 0.f;
    f32x4 gv0[8], gv1[8]; u32x2 rvv[4];
#pragma unroll
    for (int s = 0; s < 8; ++s) raw[s] = *(const u32x4*)(proj + C_CKV + 16 * s + 8 * half);
#pragma unroll
    for (int s = 0; s < 8; ++s) { gv0[s] = *(const f32x4*)(gkv + 16 * s + 8 * half); gv1[s] = *(const f32x4*)(gkv + 16 * s + 8 * half + 4); }
#pragma unroll
    for (int q = 0; q < 4; ++q) rvv[q] = *(const u32x2*)(proj + C_KR + 8 * q + 4 * half);
#pragma unroll
    for (int s = 0; s < 8; ++s) {
#pragma unroll
      for (int e = 0; e < 4; ++e) { const float a = bflo(raw[s][e]), bb = bfhi(raw[s][e]); ss += a * a + bb * bb; }
    }
    ss += xor32(ss);
    const float rstd = rsqrtf(ss * (1.f / 128.f) + EPS);
#pragma unroll
    for (int s = 0; s < 8; ++s) {
      const f32x4 g0 = gv0[s], g1 = gv1[s];
      f32x4 o0, o1;
      o0[0] = bflo(raw[s][0]) * rstd * g0[0]; o0[1] = bfhi(raw[s][0]) * rstd * g0[1]; o0[2] = bflo(raw[s][1]) * rstd * g0[2]; o0[3] = bfhi(raw[s][1]) * rstd * g0[3];
      o1[0] = bflo(raw[s][2]) * rstd * g1[0]; o1[1] = bfhi(raw[s][2]) * rstd * g1[1]; o1[2] = bflo(raw[s][3]) * rstd * g1[2]; o1[3] = bfhi(raw[s][3]) * rstd * g1[3];
      u32x4 o; o[0] = pk2(o0[0], o0[1]); o[1] = pk2(o0[2], o0[3]); o[2] = pk2(o1[0], o1[1]); o[3] = pk2(o1[2], o1[3]);
      fr[s] = __builtin_bit_cast(bf16x8, o);
      if (tok < TP && head0 == 0) {
        float* dst = p.out + O_CKV + (((size_t)(tok >> 8) * DEPTH + l) * 256 + (tok & 255)) * 128 + 16 * s + 8 * half;
        *(f32x4*)dst = o0; *(f32x4*)(dst + 4) = o1;
      }
    }
#pragma unroll
    for (int q = 0; q < 4; ++q) {
      const u32x2 rv = rvv[q];
      krb[4 * q] = bflo(rv[0]); krb[4 * q + 1] = bfhi(rv[0]); krb[4 * q + 2] = bflo(rv[1]); krb[4 * q + 3] = bfhi(rv[1]);
      if (tok < TP && head0 == 0) {
        float* dst = p.out + O_KROPE + (((size_t)(tok >> 8) * DEPTH + l) * 256 + (tok & 255)) * 32 + 8 * q + 4 * half;
        f32x4 o = {krb[4 * q], krb[4 * q + 1], krb[4 * q + 2], krb[4 * q + 3]};
        *(f32x4*)dst = o;
      }
    }
  } else {
    const float* src = p.in[2] + (((size_t)b * DEPTH + l) * PAST + j) * 128;
#pragma unroll
    for (int s = 0; s < 8; ++s) {
      const f32x4 v0 = *(const f32x4*)(src + 16 * s + 8 * half), v1 = *(const f32x4*)(src + 16 * s + 8 * half + 4);
      u32x4 o; o[0] = pk2(v0[0], v0[1]); o[1] = pk2(v0[2], v0[3]); o[2] = pk2(v1[0], v1[1]); o[3] = pk2(v1[2], v1[3]);
      fr[s] = __builtin_bit_cast(bf16x8, o);
    }
    const float* ks = p.in[3] + (((size_t)b * DEPTH + l) * PAST + j) * 32;
#pragma unroll
    for (int q = 0; q < 4; ++q) {
      const f32x4 v = *(const f32x4*)(ks + 8 * q + 4 * half);
      krb[4 * q] = v[0]; krb[4 * q + 1] = v[1]; krb[4 * q + 2] = v[2]; krb[4 * q + 3] = v[3];
    }
  }
  const bf16_t* W = (const bf16_t*)(p.ws + OFF_WUKV) + (size_t)l * 512 * 128;
  const float* gk = p.in[20] + (size_t)l * 96;
  const float* tab = (const float*)(p.ws + OFF_ROPE);
  bf16_t* ka = (bf16_t*)(p.ws + OFF_KA) + (size_t)kr * 384;
  bf16_t* vat = (bf16_t*)(p.ws + OFF_VAT);
  const float ssr = sumsq16(krb);
  __syncthreads();
#pragma unroll 1
  for (int head = head0; head < head0 + 1; ++head) {
    f32x16 acc[4];
#pragma unroll
    for (int db = 0; db < 4; ++db) acc[db] = zero16();
#pragma unroll
    for (int dp = 0; dp < 2; ++dp) {
      bf16x8 a[2][8];
#pragma unroll
      for (int d2 = 0; d2 < 2; ++d2)
#pragma unroll
        for (int s = 0; s < 8; ++s) a[d2][s] = *(const bf16x8*)(lds + ((dp * 2 + d2) * 32 + l32) * PITCH128 + 32 * s + 16 * half);
      __builtin_amdgcn_sched_barrier(0);
#pragma unroll
      for (int d2 = 0; d2 < 2; ++d2)
#pragma unroll
        for (int s = 0; s < 8; ++s) acc[dp * 2 + d2] = MFMA32(a[d2][s], fr[s], acc[dp * 2 + d2]);
      __builtin_amdgcn_sched_barrier(0);
    }
    float s2 = sumsq16(acc[0]) + sumsq16(acc[1]) + ssr;
    s2 += xor32(s2);
    const float r2 = rsqrtf(s2 * (1.f / 96.f) + EPS);
    f32x16 k2;
    {
      const f32x16 g0 = gain_block(gk, half), g1 = gain_block(gk + 32, half), g2 = gain_block(gk + 64, half);
#pragma unroll
      for (int r = 0; r < 16; ++r) { acc[0][r] *= r2 * g0[r]; acc[1][r] *= r2 * g1[r]; k2[r] = krb[r] * r2 * g2[r]; }
    }
    if (rope) rope_block(k2, tab, pos, half);
    store_block_bf16(ka + head * 96, acc[0], half);
    store_block_bf16(ka + head * 96 + 32, acc[1], half);
    store_block_bf16(ka + head * 96 + 64, k2, half);
    {
      char* ldsw = lds + 53248 + w * 9216;
#pragma unroll
      for (int db = 2; db < 4; ++db)
#pragma unroll
        for (int r = 0; r < 16; ++r) *(bf16_t*)(ldsw + ((db - 2) * 32 + crow(r, half)) * 80 + l32 * 2) = f2bf(acc[db][r]);
      const int kr0w = kr - l32;
#pragma unroll
      for (int c = 0; c < 4; ++c) {
        const int ch = c * 64 + lane, dv = ch >> 2, cc = ch & 3;
        *(u32x4*)(vat + ((size_t)head * 64 + dv) * NKEY + kr0w + cc * 8) = *(const u32x4*)(ldsw + dv * 80 + cc * 16);
      }
    }
  }
}

DI void diff_qk_thread(const Params& p, int l, int idx, bool isk) {
  const float* tab = (const float*)(p.ws + OFF_ROPE);
  const int hm = idx & 7, row = idx >> 3;
  float x[32];
  int tok = -1, pos = 0; bool rope = false, cached = false;
  if (!isk) { tok = row; if (tok >= TP) { rope = true; pos = (tok - TP) & 2047; } }
  else {
    if (row < TP) tok = row;
    else { const int b = (row - TP) / 2304, j = (row - TP) % 2304;
      if (j < PAST) { cached = true;
        const float* src = p.in[4] + ((((size_t)b * DEPTH + l) * PAST + j) * 8 + hm) * 32;
#pragma unroll
        for (int i = 0; i < 8; ++i) { const f32x4 v = *(const f32x4*)(src + 4 * i); x[4 * i] = v[0]; x[4 * i + 1] = v[1]; x[4 * i + 2] = v[2]; x[4 * i + 3] = v[3]; }
      } else { tok = TP + b * 2048 + (j - PAST); rope = true; pos = j - PAST; } }
  }
  if (!cached) {
    const bf16_t* src = (const bf16_t*)(p.ws + OFF_PROJ) + (size_t)tok * NPROJP + (isk ? C_DK : C_DQ) + hm * 32;
    float ss = 0.f;
#pragma unroll
    for (int i = 0; i < 4; ++i) {
      const u32x4 v = *(const u32x4*)(src + 8 * i);
#pragma unroll
      for (int e = 0; e < 4; ++e) { x[8 * i + 2 * e] = bflo(v[e]); x[8 * i + 2 * e + 1] = bfhi(v[e]); }
    }
#pragma unroll
    for (int i = 0; i < 32; ++i) ss += x[i] * x[i];
    const float rstd = rsqrtf(ss * (1.f / 32.f) + EPS);
    const float* g = p.in[isk ? 22 : 21] + (size_t)l * 32;
#pragma unroll
    for (int i = 0; i < 32; ++i) x[i] *= rstd * g[i];
    if (isk && tok < TP) {
      float* dst = p.out + O_DK + (((size_t)(tok >> 8) * DEPTH + l) * 256 + (tok & 255)) * 256 + hm * 32;
#pragma unroll
      for (int i = 0; i < 8; ++i) { f32x4 o = {x[4 * i], x[4 * i + 1], x[4 * i + 2], x[4 * i + 3]}; *(f32x4*)(dst + 4 * i) = o; }
    }
    if (rope) {
      const float* t = tab + (size_t)pos * 32;
#pragma unroll
      for (int q = 0; q < 2; ++q)
#pragma unroll
        for (int m = 0; m < 8; ++m) {
          const float c = t[(q * 8 + m) * 2], s = t[(q * 8 + m) * 2 + 1];
          const float x1 = x[q * 16 + m], x2 = x[q * 16 + 8 + m];
          x[q * 16 + m] = x1 * c - x2 * s; x[q * 16 + 8 + m] = x2 * c + x1 * s;
        }
    }
  }
  const float sc = isk ? 1.f : 0.17677669529663687f * 1.4426950408889634f;
  bf16_t* dst = (bf16_t*)(p.ws + (isk ? OFF_KD : OFF_QD)) + (size_t)row * 256 + hm * 32;
#pragma unroll
  for (int i = 0; i < 4; ++i) {
    u32x4 o;
#pragma unroll
    for (int e = 0; e < 4; ++e) o[e] = pk2(x[8 * i + 2 * e] * sc, x[8 * i + 2 * e + 1] * sc);
    *(u32x4*)(dst + 8 * i) = o;
  }
}
DI void diff_v_thread(const Params& p, int l, int idx, char* ldsw) {
  const int lane = get_tid() & 63;
  const int head = idx / NKEY, kr = idx % NKEY, kr0 = kr - lane;
  constexpr int VP = 144;
  int tok = -1;
  if (kr < TP) tok = kr;
  else { const int b = (kr - TP) / 2304, j = (kr - TP) % 2304;
    if (j < PAST) {
      const float* src = p.in[5] + ((((size_t)b * DEPTH + l) * PAST + j) * 4 + head) * 64;
#pragma unroll
      for (int i = 0; i < 16; ++i) { const f32x4 v = *(const f32x4*)(src + 4 * i);
#pragma unroll
        for (int e = 0; e < 4; ++e) *(bf16_t*)(ldsw + (4 * i + e) * VP + lane * 2) = f2bf(v[e]); }
      tok = -2;
    } else tok = TP + b * 2048 + (j - PAST);
  }
  if (tok >= 0) {
    const bf16_t* src = (const bf16_t*)(p.ws + OFF_PROJ) + (size_t)tok * NPROJP + C_DV + head * 64;
    float* od = (tok < TP) ? p.out + O_DV + (((size_t)(tok >> 8) * DEPTH + l) * 256 + (tok & 255)) * 256 + head * 64 : nullptr;
#pragma unroll
    for (int i = 0; i < 8; ++i) {
      const u32x4 v = *(const u32x4*)(src + 8 * i);
#pragma unroll
      for (int e = 0; e < 4; ++e) {
        *(bf16_t*)(ldsw + (8 * i + 2 * e) * VP + lane * 2) = (bf16_t)(v[e] & 0xffffu);
        *(bf16_t*)(ldsw + (8 * i + 2 * e + 1) * VP + lane * 2) = (bf16_t)(v[e] >> 16);
      }
      if (od) {
        f32x4 o0 = {bflo(v[0]), bfhi(v[0]), bflo(v[1]), bfhi(v[1])}, o1 = {bflo(v[2]), bfhi(v[2]), bflo(v[3]), bfhi(v[3])};
        *(f32x4*)(od + 8 * i) = o0; *(f32x4*)(od + 8 * i + 4) = o1;
      }
    }
  }
  bf16_t* vdt = (bf16_t*)(p.ws + OFF_VDT) + (size_t)head * 64 * NKEY + kr0;
#pragma unroll
  for (int c = 0; c < 8; ++c) {
    const int ch = c * 64 + lane, dv = ch >> 3, cc = ch & 7;
    *(u32x4*)(vdt + (size_t)dv * NKEY + cc * 8) = *(const u32x4*)(ldsw + dv * VP + cc * 16);
  }
}
template <int CU>
DI void conv_threads(const Params& p, int l, int idx0, int stride) {
  u32x4 v[CU][5]; f32x4 bia[CU][2];
  int tokv[CU], c0v[CU];
#pragma unroll
  for (int u = 0; u < CU; ++u) {
    const int idx = idx0 + u * stride;
    const int tok = idx / 96, c0 = (idx % 96) * 8;
    tokv[u] = tok; c0v[u] = c0;
    int pos, L;
    if (tok < TP) { pos = tok & 255; L = 256; } else { pos = (tok - TP) & 2047; L = 2048; }
    const bf16_t* src = (const bf16_t*)(p.ws + OFF_PROJ) + (size_t)tok * NPROJP + C_XBC + c0;
#pragma unroll
    for (int k = 0; k < 5; ++k) {
      const int pp = pos + k - 2;
      v[u][k] = (u32x4){0u, 0u, 0u, 0u};
      if (pp >= 0 && pp < L) v[u][k] = *(const u32x4*)(src + (ptrdiff_t)(k - 2) * NPROJP);
    }
    const float* cb = p.in[29] + (size_t)l * 768 + c0;
    bia[u][0] = *(const f32x4*)cb; bia[u][1] = *(const f32x4*)(cb + 4);
  }
#pragma unroll
  for (int u = 0; u < CU; ++u) {
    const float* cw = p.in[28] + (size_t)l * 5 * 768 + c0v[u];
    float acc[8] = {bia[u][0][0], bia[u][0][1], bia[u][0][2], bia[u][0][3], bia[u][1][0], bia[u][1][1], bia[u][1][2], bia[u][1][3]};
#pragma unroll
    for (int k = 0; k < 5; ++k) {
      const f32x4 w0 = *(const f32x4*)(cw + k * 768), w1 = *(const f32x4*)(cw + k * 768 + 4);
      const u32x4 x = v[u][k];
      acc[0] += w0[0] * bflo(x[0]); acc[1] += w0[1] * bfhi(x[0]); acc[2] += w0[2] * bflo(x[1]); acc[3] += w0[3] * bfhi(x[1]);
      acc[4] += w1[0] * bflo(x[2]); acc[5] += w1[1] * bfhi(x[2]); acc[6] += w1[2] * bflo(x[3]); acc[7] += w1[3] * bfhi(x[3]);
    }
#pragma unroll
    for (int e = 0; e < 8; ++e) acc[e] = acc[e] / (1.f + __expf(-acc[e]));
    u32x4 o; o[0] = pk2(acc[0], acc[1]); o[1] = pk2(acc[2], acc[3]); o[2] = pk2(acc[4], acc[5]); o[3] = pk2(acc[6], acc[7]);
    *(u32x4*)((bf16_t*)(p.ws + OFF_XBC) + (size_t)tokv[u] * 768 + c0v[u]) = o;
  }
}
DI void dt_thread(const Params& p, int l, int idx) {
  float* dt = (float*)(p.ws + OFF_DT);
  const float v = dt[idx] + p.in[31][(size_t)l * 16 + (idx & 15)];
  dt[idx] = fmaxf(v, 0.f) + log1pf(__expf(-fabsf(v)));
}

DI void prep_phase(const Params& p, int l, char* lds) {
  constexpr int N_Q = 48 * 4, N_KV = 52 * 4, N_DQ = T * 8 / 512, N_DKK = NKEY * 8 / 512, N_DV = NKEY * 4 / 512, N_CONV = T * 96 / 512 / 3, N_DTT = T * 16 / 512;
  constexpr int TOT = N_Q + N_KV + N_DQ + N_DKK + N_DV + N_CONV + N_DTT;
  for (int item = blockIdx.x; item < TOT; item += gridDim.x) {
    int it = item;
    if (it < N_Q) { mla_q_item(p, l, it, lds); continue; }
    it -= N_Q;
    if (it < N_KV) { mla_kv_item(p, l, it, lds); continue; }
    it -= N_KV;
    if (it < N_DQ) { diff_qk_thread(p, l, it * 512 + get_tid(), false); continue; }
    it -= N_DQ;
    if (it < N_DKK) { diff_qk_thread(p, l, it * 512 + get_tid(), true); continue; }
    it -= N_DKK;
    if (it < N_DV) { diff_v_thread(p, l, it * 512 + get_tid(), lds + 53248 + (get_tid() >> 6) * 9216); continue; }
    it -= N_DV;
    if (it < N_CONV) { conv_threads<3>(p, l, it * 512 + get_tid(), N_CONV * 512); continue; }
    it -= N_CONV;
    dt_thread(p, l, it * 512 + get_tid());
  }
}

DI void wave_scan2(float e0, float e1, float& o0, float& o1) {
  const int lane = get_tid() & 63;
  const float s = e0 + e1;
  float inc = s;
#pragma unroll
  for (int o = 1; o < 64; o <<= 1) { const float t = __shfl_up(inc, o); if (lane >= o) inc += t; }
  const float excl = inc - s;
  o0 = excl + e0; o1 = excl + s;
}
DI void ssd_dt_load(const Params& p, int cg_, int h, float& d0, float& d1) {
  const int lane = get_tid() & 63, w = get_tid4() >> 6;
  const float* dt = (const float*)(p.ws + OFF_DT) + (size_t)cg_ * 128 * 16;
  d0 = 0.f; d1 = 0.f;
  if (w == 0) { d0 = dt[(2 * lane) * 16 + h]; d1 = dt[(2 * lane + 1) * 16 + h]; }
  else if (w == 1) { d0 = dt[(127 - 2 * lane) * 16 + 8 + h]; d1 = dt[(126 - 2 * lane) * 16 + 8 + h]; }
}
DI void ssd_scalars_from(const Params& p, int l, int h, float d0, float d1, float* acf, float* sb, float* dtf, float* dtb) {
  const int lane = get_tid() & 63, w = get_tid4() >> 6;
  if (w == 0) {
    const float a = -__expf(p.in[30][(size_t)l * 16 + h]);
    float o0, o1; wave_scan2(d0 * a, d1 * a, o0, o1);
    acf[2 * lane] = o0; acf[2 * lane + 1] = o1; dtf[2 * lane] = d0; dtf[2 * lane + 1] = d1;
  } else if (w == 1) {
    const float a = -__expf(p.in[30][(size_t)l * 16 + 8 + h]);
    const int j0 = 127 - 2 * lane, j1 = 126 - 2 * lane;
    float o0, o1; wave_scan2(d0 * a, d1 * a, o0, o1);
    sb[j0] = o0; sb[j1] = o1; dtb[j0] = d0; dtb[j1] = d1;
  }
}
DI void ssd_scalars(const Params& p, int l, int cg_, int h, float* acf, float* sb, float* dtf, float* dtb) {
  const int lane = get_tid() & 63, w = get_tid4() >> 6;
  const float* dt = (const float*)(p.ws + OFF_DT) + (size_t)cg_ * 128 * 16;
  if (w == 0) {
    const float a = -__expf(p.in[30][(size_t)l * 16 + h]);
    const float d0 = dt[(2 * lane) * 16 + h], d1 = dt[(2 * lane + 1) * 16 + h];
    float o0, o1; wave_scan2(d0 * a, d1 * a, o0, o1);
    acf[2 * lane] = o0; acf[2 * lane + 1] = o1; dtf[2 * lane] = d0; dtf[2 * lane + 1] = d1;
  } else if (w == 1) {
    const float a = -__expf(p.in[30][(size_t)l * 16 + 8 + h]);
    const int j0 = 127 - 2 * lane, j1 = 126 - 2 * lane;
    const float d0 = dt[j0 * 16 + 8 + h], d1 = dt[j1 * 16 + 8 + h];
    float o0, o1; wave_scan2(d0 * a, d1 * a, o0, o1);
    sb[j0] = o0; sb[j1] = o1; dtb[j0] = d0; dtb[j1] = d1;
  }
}

DI void ssd_states_item(const Params& p, int l, int item, char* lds) {
  const int tid = get_tid4(), lane = tid & 63, w = tid >> 6, l32 = lane & 31, half = lane >> 5;
  const int cg_ = item >> 3, h = item & 7, g = h >> 2;
  char* XF = lds; char* XB = lds + 64 * PITCH128; char* BT = lds + 2 * 64 * PITCH128;
  float* sc = (float*)(lds + 3 * 64 * PITCH128);
  float* acf = sc, *sb = sc + 128, *dtf = sc + 256, *dtb = sc + 384;
  __syncthreads();
  ssd_scalars(p, l, cg_, h, acf, sb, dtf, dtb);
  __syncthreads();
  const bf16_t* xbc = (const bf16_t*)(p.ws + OFF_XBC) + (size_t)cg_ * 128 * 768;
  const float aL = acf[127], s0 = sb[0];
#pragma unroll
  for (int it = 0; it < 2; ++it) {
    const int t = tid + 256 * it, jp = t & 63, pc = t >> 6, j0 = 2 * jp;
    const u32x4 x0 = *(const u32x4*)(xbc + (size_t)j0 * 768 + h * 64 + pc * 8), x1 = *(const u32x4*)(xbc + (size_t)(j0 + 1) * 768 + h * 64 + pc * 8);
    const u32x4 b0 = *(const u32x4*)(xbc + (size_t)j0 * 768 + 512 + g * 64 + pc * 8), b1 = *(const u32x4*)(xbc + (size_t)(j0 + 1) * 768 + 512 + g * 64 + pc * 8);
    const float wf0 = __expf(aL - acf[j0]) * dtf[j0], wf1 = __expf(aL - acf[j0 + 1]) * dtf[j0 + 1];
    const float wb0 = __expf(s0 - sb[j0]) * dtb[j0], wb1 = __expf(s0 - sb[j0 + 1]) * dtb[j0 + 1];
#pragma unroll
    for (int e = 0; e < 4; ++e) {
      const float a0 = bflo(x0[e]), a1 = bfhi(x0[e]), c0 = bflo(x1[e]), c1 = bfhi(x1[e]);
      const int pr = pc * 8 + 2 * e;
      *(unsigned*)(XF + pr * PITCH128 + j0 * 2) = pk2(a0 * wf0, c0 * wf1);
      *(unsigned*)(XF + (pr + 1) * PITCH128 + j0 * 2) = pk2(a1 * wf0, c1 * wf1);
      *(unsigned*)(XB + pr * PITCH128 + j0 * 2) = pk2(a0 * wb0, c0 * wb1);
      *(unsigned*)(XB + (pr + 1) * PITCH128 + j0 * 2) = pk2(a1 * wb0, c1 * wb1);
      *(unsigned*)(BT + pr * PITCH128 + j0 * 2) = (b0[e] & 0xffffu) | (b1[e] << 16);
      *(unsigned*)(BT + (pr + 1) * PITCH128 + j0 * 2) = (b0[e] >> 16) | (b1[e] & 0xffff0000u);
    }
  }
  __syncthreads();
  const int dir = w >> 1, pb = w & 1;
  const char* Xs = (dir ? XB : XF) + (pb * 32 + l32) * PITCH128 + half * 16;
  const char* Bsrc = BT + l32 * PITCH128 + half * 16;
  f32x16 acc[2] = {zero16(), zero16()};
#pragma unroll
  for (int s = 0; s < 8; ++s) {
    const bf16x8 a = *(const bf16x8*)(Xs + s * 32);
    const bf16x8 b0 = *(const bf16x8*)(Bsrc + s * 32), b1 = *(const bf16x8*)(Bsrc + 32 * PITCH128 + s * 32);
    acc[0] = MFMA32(a, b0, acc[0]); acc[1] = MFMA32(a, b1, acc[1]);
  }
  float* ST = (float*)(p.ws + OFF_ST) + ((size_t)(cg_ * 8 + h) * 2 + dir) * 4096;
#pragma unroll
  for (int nb = 0; nb < 2; ++nb)
#pragma unroll
    for (int r = 0; r < 16; ++r) ST[(pb * 32 + crow(r, half)) * 64 + nb * 32 + l32] = acc[nb][r];
  if (tid == 0) { float* cd = (float*)(p.ws + OFF_CDEC) + (size_t)(cg_ * 8 + h) * 2; cd[0] = __expf(aL); cd[1] = __expf(s0); }
}

template <int NC>
DI void ssd_scan_thread(const Params& p, int l, int seq, int r, int cg0, f32x4 hs) {
  const float* ST = (const float*)(p.ws + OFF_ST);
  bf16_t* HP = (bf16_t*)(p.ws + OFF_HP);
  const float* CD = (const float*)(p.ws + OFF_CDEC);
  const int h = r >> 11, dir = (r >> 10) & 1, pn = r & 1023;
  f32x4 st[NC]; float dec[NC];
#pragma unroll
  for (int c = 0; c < NC; ++c) {
    const int cgi = cg0 + (dir ? NC - 1 - c : c);
    st[c] = *(const f32x4*)(ST + ((size_t)(cgi * 8 + h) * 2 + dir) * 4096 + pn * 4);
    dec[c] = CD[(size_t)(cgi * 8 + h) * 2 + dir];
  }
#pragma unroll
  for (int c = 0; c < NC; ++c) {
    const int cgi = cg0 + (dir ? NC - 1 - c : c);
    u32x2 hv; hv[0] = pk2(hs[0], hs[1]); hv[1] = pk2(hs[2], hs[3]);
    *(u32x2*)(HP + ((size_t)(cgi * 8 + h) * 2 + dir) * 4096 + pn * 4) = hv;
    hs = dec[c] * hs + st[c];
  }
  if (seq < 16) *(f32x4*)(p.out + O_SSM + ((((size_t)seq * DEPTH + l) * 2 + dir) * 8 + h) * 4096 + pn * 4) = hs;
}
DI void ssd_scan_phase(const Params& p, int l) {
  constexpr int PER_SEQ = 8 * 2 * 64 * 16;
  for (int item = blockIdx.x; item < 20 * PER_SEQ / 512; item += gridDim.x) {
    const int idx = item * 512 + get_tid();
    const int sq = idx / PER_SEQ; const int r = idx % PER_SEQ;
    const int seq = (sq < 4) ? 16 + sq : sq - 4;
    if (seq < 16) ssd_scan_thread<2>(p, l, seq, r, 2 * seq, (f32x4){0.f, 0.f, 0.f, 0.f});
    else {
      const int dir = (r >> 10) & 1, h = r >> 11, pn = r & 1023;
      const f32x4 h0 = *(const f32x4*)(p.in[6] + ((((size_t)(seq - 16) * DEPTH + l) * 2 + dir) * 8 + h) * 4096 + pn * 4);
      ssd_scan_thread<16>(p, l, seq, r, 32 + 16 * (seq - 16), h0);
    }
  }
}

DI void ssd_y_item(const Params& p, int l, int cg_, char* lds_blk) {
  const int tid = get_tid4(), lane = tid & 63, w = tid >> 6, l32 = lane & 31, half = lane >> 5;
  const int g = get_hb();
  char* lds = lds_blk + g * HALF_LDS;
  char* Bs = lds; char* Cs = lds + 128 * PITCH64; char* XT = lds + 2 * 128 * PITCH64;
  char* Hf = XT + 64 * PITCH128; char* Hb = Hf + 64 * PITCH64;
  float* sc = (float*)(Hb + 64 * PITCH64);
  float* acf = sc, *sb = sc + 128, *dtf = sc + 256, *dtb = sc + 384;
  const int tok0 = cg_ * 128;
  const int i = w * 32 + l32, tok = tok0 + i;
  const bf16_t* xbc = (const bf16_t*)(p.ws + OFF_XBC) + (size_t)tok0 * 768;
  const bf16_t* proj = (const bf16_t*)(p.ws + OFF_PROJ);
  bf16_t* mix = (bf16_t*)(p.ws + OFF_MIX);
  float ssq = 0.f;
  {
    __syncthreads();
#pragma unroll
    for (int it = 0; it < 4; ++it) {
      const int t = tid + 256 * it, r = t >> 3, c = (t & 7) * 8;
      *(u32x4*)(Bs + r * PITCH64 + c * 2) = *(const u32x4*)(xbc + (size_t)r * 768 + 512 + g * 64 + c);
      *(u32x4*)(Cs + r * PITCH64 + c * 2) = *(const u32x4*)(xbc + (size_t)r * 768 + 640 + g * 64 + c);
    }
    __syncthreads();
    u32x4 xr[2][2]; float dpre0, dpre1;
    auto head_loads = [&](int h) {
#pragma unroll
      for (int it = 0; it < 2; ++it) {
        const int t = tid + 256 * it, jp = t & 63, pc = t >> 6, j0 = 2 * jp;
        xr[it][0] = *(const u32x4*)(xbc + (size_t)j0 * 768 + h * 64 + pc * 8);
        xr[it][1] = *(const u32x4*)(xbc + (size_t)(j0 + 1) * 768 + h * 64 + pc * 8);
      }
      ssd_dt_load(p, cg_, h, dpre0, dpre1);
    };
    head_loads(g * 4);
#pragma unroll 1
    for (int hh = 0; hh < 4; ++hh) {
      const int h = g * 4 + hh;
      u32x4 hr[2][2];
      {
        const bf16_t* hp = (const bf16_t*)(p.ws + OFF_HP) + (size_t)(cg_ * 8 + h) * 2 * 4096;
#pragma unroll
        for (int it = 0; it < 2; ++it) { const int t = tid + 256 * it, r = t >> 3, c = (t & 7) * 8; hr[it][0] = *(const u32x4*)(hp + r * 64 + c); hr[it][1] = *(const u32x4*)(hp + 4096 + r * 64 + c); }
      }
      __syncthreads();
#pragma unroll
      for (int it = 0; it < 2; ++it) {
        const int t = tid + 256 * it, jp = t & 63, pc = t >> 6, j0 = 2 * jp;
        const u32x4 x0 = xr[it][0], x1 = xr[it][1];
#pragma unroll
        for (int e = 0; e < 4; ++e) {
          const int pr = pc * 8 + 2 * e;
          *(unsigned*)(XT + pr * PITCH128 + j0 * 2) = (x0[e] & 0xffffu) | (x1[e] << 16);
          *(unsigned*)(XT + (pr + 1) * PITCH128 + j0 * 2) = (x0[e] >> 16) | (x1[e] & 0xffff0000u);
        }
        const int r = t >> 3, c = (t & 7) * 8;
        *(u32x4*)(Hf + r * PITCH64 + c * 2) = hr[it][0];
        *(u32x4*)(Hb + r * PITCH64 + c * 2) = hr[it][1];
      }
      ssd_scalars_from(p, l, h, dpre0, dpre1, acf, sb, dtf, dtb);
      __syncthreads();
      if (hh < 3) head_loads(h + 1);
      const float aif = acf[i], aib = sb[i];
      f32x16 Y[2] = {zero16(), zero16()};
      int iv = i, hv = half;
      asm volatile("" : "+v"(iv), "+v"(hv));
      bf16x8 cfr[4];
#pragma unroll
      for (int s = 0; s < 4; ++s) cfr[s] = *(const bf16x8*)(Cs + i * PITCH64 + s * 32 + hv * 16);
      u32x2 xpre[8], zpre[8];
#pragma unroll
      for (int q8 = 0; q8 < 8; ++q8) {
        const int pc = (q8 >> 2) * 32 + 8 * (q8 & 3) + 4 * hv;
        xpre[q8] = *(const u32x2*)(xbc + (size_t)i * 768 + h * 64 + pc);
        zpre[q8] = *(const u32x2*)(proj + (size_t)tok * NPROJP + C_Z + h * 64 + pc);
      }
#pragma unroll 1
      for (int jb = 0; jb < 4; ++jb) {
        f32x16 G = zero16();
#pragma unroll
        for (int s = 0; s < 4; ++s) {
          const bf16x8 a = *(const bf16x8*)(Bs + (jb * 32 + l32) * PITCH64 + s * 32 + hv * 16);
          G = MFMA32(a, cfr[s], G);
        }
        f32x16 m;
#pragma unroll
        for (int q = 0; q < 4; ++q) {
          const int jq = jb * 32 + 8 * q + 4 * hv;
          const f32x4 af4 = *(const f32x4*)(acf + jq), sb4 = *(const f32x4*)(sb + jq), df4 = *(const f32x4*)(dtf + jq), db4 = *(const f32x4*)(dtb + jq);
#pragma unroll
          for (int e = 0; e < 4; ++e) {
            const int j = jq + e;
            const bool lo_ = j < iv;
            const float arg = lo_ ? (aif - af4[e]) : (aib - sb4[e]);
            const float dsel = lo_ ? df4[e] : db4[e];
            float wgt = __expf(arg) * dsel;
            wgt = (j == iv) ? (df4[e] + db4[e]) : wgt;
            m[4 * q + e] = G[4 * q + e] * wgt;
          }
        }
#pragma unroll
        for (int s = 0; s < 2; ++s) {
          u32x4 mf; mf[0] = pk2(m[8 * s], m[8 * s + 1]); mf[1] = pk2(m[8 * s + 2], m[8 * s + 3]); mf[2] = pk2(m[8 * s + 4], m[8 * s + 5]); mf[3] = pk2(m[8 * s + 6], m[8 * s + 7]);
          const bf16x8 mfr = __builtin_bit_cast(bf16x8, mf);
#pragma unroll
          for (int pb = 0; pb < 2; ++pb) {
            const char* xa = XT + (pb * 32 + l32) * PITCH128 + (jb * 32 + 16 * s + 4 * hv) * 2;
            u32x4 av; const u32x2 lo = *(const u32x2*)xa, hi = *(const u32x2*)(xa + 16);
            av[0] = lo[0]; av[1] = lo[1]; av[2] = hi[0]; av[3] = hi[1];
            Y[pb] = MFMA32(__builtin_bit_cast(bf16x8, av), mfr, Y[pb]);
          }
        }
      }
      {
        const float ef = __expf(aif), eb = __expf(aib);
#pragma unroll
        for (int pb = 0; pb < 2; ++pb) {
#pragma unroll
          for (int d = 0; d < 2; ++d) {
            f32x16 tf = zero16();
            const char* Hs = d ? Hb : Hf;
#pragma unroll
            for (int s = 0; s < 4; ++s) {
              const bf16x8 a = *(const bf16x8*)(Hs + (pb * 32 + l32) * PITCH64 + s * 32 + hv * 16);
              tf = MFMA32(a, cfr[s], tf);
            }
            const float ee = d ? eb : ef;
#pragma unroll
            for (int r = 0; r < 16; ++r) Y[pb][r] += ee * tf[r];
          }
        }
      }
      const float Dh = p.in[32][(size_t)l * 8 + h];
#pragma unroll
      for (int pb = 0; pb < 2; ++pb) {
        f32x16 yb;
#pragma unroll
        for (int q = 0; q < 4; ++q) {
          const u32x2 xv = xpre[pb * 4 + q];
          const u32x2 zv = zpre[pb * 4 + q];
          float y[4] = {Y[pb][4 * q] + Dh * bflo(xv[0]), Y[pb][4 * q + 1] + Dh * bfhi(xv[0]), Y[pb][4 * q + 2] + Dh * bflo(xv[1]), Y[pb][4 * q + 3] + Dh * bfhi(xv[1])};
          const float z[4] = {bflo(zv[0]), bfhi(zv[0]), bflo(zv[1]), bfhi(zv[1])};
#pragma unroll
          for (int e = 0; e < 4; ++e) { y[e] *= z[e] / (1.f + __expf(-z[e])); ssq += y[e] * y[e]; yb[4 * q + e] = y[e]; }
        }
        store_block_bf16(mix + (size_t)tok * 1024 + 512 + h * 64 + pb * 32, yb, half);
      }
    }
  }
  ssq += xor32(ssq);
  sc[512 + i] = ssq;
  __syncthreads();
  ssq += ((const float*)(lds_blk + (1 - g) * HALF_LDS + (2 * 128 * PITCH64 + 64 * PITCH128 + 2 * 64 * PITCH64)))[512 + i];
  const float rstd = rsqrtf(ssq * (1.f / 512.f) + EPS);
  const float* gn = p.in[33] + (size_t)l * 512;
  u32x4 vv[16];
#pragma unroll
  for (int e = 0; e < 16; ++e) {
    const int ch = (g * 4 + (e >> 2)) * 64 + ((e >> 1) & 1) * 32 + 16 * (e & 1) + 8 * half;
    vv[e] = *(const u32x4*)(mix + (size_t)tok * 1024 + 512 + ch);
  }
#pragma unroll
  for (int hq = 0; hq < 4; ++hq) {
    f32x4 gg[8];
#pragma unroll
    for (int e = 0; e < 4; ++e) {
      const int ch = (g * 4 + hq) * 64 + ((e >> 1) & 1) * 32 + 16 * (e & 1) + 8 * half;
      gg[2 * e] = *(const f32x4*)(gn + ch); gg[2 * e + 1] = *(const f32x4*)(gn + ch + 4);
    }
#pragma unroll
    for (int e = 0; e < 4; ++e) {
      const int ch = (g * 4 + hq) * 64 + ((e >> 1) & 1) * 32 + 16 * (e & 1) + 8 * half;
      const u32x4 v = vv[hq * 4 + e];
      u32x4 o;
      o[0] = pk2(bflo(v[0]) * rstd * gg[2 * e][0], bfhi(v[0]) * rstd * gg[2 * e][1]); o[1] = pk2(bflo(v[1]) * rstd * gg[2 * e][2], bfhi(v[1]) * rstd * gg[2 * e][3]);
      o[2] = pk2(bflo(v[2]) * rstd * gg[2 * e + 1][0], bfhi(v[2]) * rstd * gg[2 * e + 1][1]); o[3] = pk2(bflo(v[3]) * rstd * gg[2 * e + 1][2], bfhi(v[3]) * rstd * gg[2 * e + 1][3]);
      *(u32x4*)(mix + (size_t)tok * 1024 + 512 + ch) = o;
    }
  }
}

struct SeqInfo { int tok0, L, kbase, nk; };
DI SeqInfo seq_info(int s) { SeqInfo r; if (s < 16) { r.tok0 = s * 256; r.L = 256; r.kbase = s * 256; r.nk = 256; } else { r.tok0 = TP + (s - 16) * 2048; r.L = 2048; r.kbase = TP + (s - 16) * 2304; r.nk = 2304; } return r; }

DI void attn_mla_item(const Params& p, int item, char* lds) {
  const int tid = get_tid4(), lane = tid & 63, w = tid >> 6, l32 = lane & 31, half = lane >> 5;
  int seq, head, qb;
  if (item < 256) { seq = 16 + (item >> 6); head = (item >> 4) & 3; qb = item & 15; }
  else { const int it = item - 256; seq = it >> 3; head = (it >> 1) & 3; qb = it & 1; }
  const SeqInfo si = seq_info(seq);
  const int tok = si.tok0 + qb * 128 + w * 32 + l32;
  const bf16_t* qa = (const bf16_t*)(p.ws + OFF_QA) + (size_t)tok * 384 + head * 96;
  bf16x8 qf[6];
#pragma unroll
  for (int s = 0; s < 6; ++s) qf[s] = *(const bf16x8*)(qa + 16 * s + 8 * half);
  constexpr int KT = 64 * PITCH96, VT = 64 * PITCH64;
  char* Ks = lds; char* Vs = lds + 2 * KT;
  const bf16_t* kg = (const bf16_t*)(p.ws + OFF_KA) + (size_t)si.kbase * 384 + head * 96;
  const bf16_t* vg = (const bf16_t*)(p.ws + OFF_VAT) + (size_t)head * 64 * NKEY + si.kbase;
  u32x4 rk[3], rv[2];
  auto gload = [&](int t0) {
#pragma unroll
    for (int i = 0; i < 3; ++i) { const int c = tid + 256 * i, r = c / 12, cc = c % 12; rk[i] = *(const u32x4*)(kg + (size_t)(t0 + r) * 384 + cc * 8); }
#pragma unroll
    for (int i = 0; i < 2; ++i) { const int c = tid + 256 * i, r = c >> 3, cc = c & 7; rv[i] = *(const u32x4*)(vg + (size_t)r * NKEY + t0 + cc * 8); }
  };
  auto lstore = [&](int buf) {
#pragma unroll
    for (int i = 0; i < 3; ++i) { const int c = tid + 256 * i, r = c / 12, cc = c % 12; *(u32x4*)(Ks + buf * KT + r * PITCH96 + cc * 16) = rk[i]; }
#pragma unroll
    for (int i = 0; i < 2; ++i) { const int c = tid + 256 * i, r = c >> 3, cc = c & 7; *(u32x4*)(Vs + buf * VT + r * PITCH64 + cc * 16) = rv[i]; }
  };
  f32x16 O[2] = {zero16(), zero16()};
  float mrun = -1e30f, lsum = 0.f;
  const int nt = si.nk / 64;
  __syncthreads();
  gload(0); lstore(0);
  __syncthreads();
#pragma unroll 1
  for (int t = 0; t < nt; ++t) {
    const int cur = t & 1;
    if (t + 1 < nt) gload((t + 1) * 64);
    f32x16 S[2];
#pragma unroll
    for (int kb = 0; kb < 2; ++kb) {
      S[kb] = zero16();
#pragma unroll
      for (int s = 0; s < 6; ++s) {
        const bf16x8 a = *(const bf16x8*)(Ks + cur * KT + (kb * 32 + l32) * PITCH96 + s * 32 + half * 16);
        S[kb] = MFMA32(a, qf[s], S[kb]);
      }
    }
    float mx = S[0][0];
#pragma unroll
    for (int r = 0; r < 16; ++r) { mx = fmaxf(mx, S[0][r]); mx = fmaxf(mx, S[1][r]); }
    mx = fmaxf(mx, xor32(mx));
    if (__any(mx > mrun + 8.f)) {
      const float mnew = fmaxf(mrun, mx);
      const float alpha = __builtin_amdgcn_exp2f(mrun - mnew);
      mrun = mnew;
      lsum *= alpha;
#pragma unroll
      for (int r = 0; r < 16; ++r) { O[0][r] *= alpha; O[1][r] *= alpha; }
    }
    float ps = 0.f;
#pragma unroll
    for (int kb = 0; kb < 2; ++kb)
#pragma unroll
      for (int r = 0; r < 16; ++r) { const float e = __builtin_amdgcn_exp2f(S[kb][r] - mrun); S[kb][r] = e; ps += e; }
    lsum += ps;
#pragma unroll
    for (int kb = 0; kb < 2; ++kb)
#pragma unroll
      for (int s = 0; s < 2; ++s) {
        u32x4 pf; pf[0] = pk2(S[kb][8 * s], S[kb][8 * s + 1]); pf[1] = pk2(S[kb][8 * s + 2], S[kb][8 * s + 3]); pf[2] = pk2(S[kb][8 * s + 4], S[kb][8 * s + 5]); pf[3] = pk2(S[kb][8 * s + 6], S[kb][8 * s + 7]);
        const bf16x8 pfr = __builtin_bit_cast(bf16x8, pf);
#pragma unroll
        for (int dvb = 0; dvb < 2; ++dvb) {
          const char* va = Vs + cur * VT + (dvb * 32 + l32) * PITCH64 + (kb * 32 + 16 * s + 4 * half) * 2;
          u32x4 av; const u32x2 lo = *(const u32x2*)va, hi = *(const u32x2*)(va + 16);
          av[0] = lo[0]; av[1] = lo[1]; av[2] = hi[0]; av[3] = hi[1];
          O[dvb] = MFMA32(__builtin_bit_cast(bf16x8, av), pfr, O[dvb]);
        }
      }
    if (t + 1 < nt) lstore(cur ^ 1);
    __syncthreads();
  }
  lsum += xor32(lsum);
  const float inv = 1.f / lsum;
  bf16_t* mix = (bf16_t*)(p.ws + OFF_MIX) + (size_t)tok * 1024 + head * 64;
#pragma unroll
  for (int dvb = 0; dvb < 2; ++dvb) {
#pragma unroll
    for (int r = 0; r < 16; ++r) O[dvb][r] *= inv;
    store_block_bf16(mix + dvb * 32, O[dvb], half);
  }
}

constexpr int PITCH32 = 80;
DI void attn_diff_item(const Params& p, int l, int item, char* lds_blk) {
  const int tid = get_tid4(), lane = tid & 63, w = tid >> 6, l32 = lane & 31, half = lane >> 5;
  const int hbk = get_hb();
  char* lds = lds_blk + hbk * HALF_LDS;
  int seq, head, qb;
  if (item < 256) { seq = 16 + (item >> 6); head = (item >> 4) & 3; qb = item & 15; }
  else { const int it = item - 256; seq = it >> 3; head = (it >> 1) & 3; qb = it & 1; }
  const SeqInfo si = seq_info(seq);
  const int tok = si.tok0 + qb * 128 + w * 32 + l32;
  constexpr int KT = 64 * PITCH32, VT = 64 * PITCH64;
  char* Ks = lds; char* Vs = lds + 2 * KT;
  const bf16_t* vg = (const bf16_t*)(p.ws + OFF_VDT) + (size_t)head * 64 * NKEY + si.kbase;
  const int nt = si.nk / 64;
  const float lam_init = ((const float*)(p.ws + OFF_LAM))[l * 2 + 1];
  const float lam = ((const float*)(p.ws + OFF_LAM))[l * 2];
  f32x16 R[2] = {zero16(), zero16()};
#pragma unroll 1
  for (int mp = hbk; mp < hbk + 1; ++mp) {
    const bf16_t* qd = (const bf16_t*)(p.ws + OFF_QD) + (size_t)tok * 256 + head * 64 + mp * 32;
    bf16x8 qf[2];
#pragma unroll
    for (int s = 0; s < 2; ++s) qf[s] = *(const bf16x8*)(qd + 16 * s + 8 * half);
    const bf16_t* kg = (const bf16_t*)(p.ws + OFF_KD) + (size_t)si.kbase * 256 + head * 64 + mp * 32;
    u32x4 rk, rv[2];
    auto gload = [&](int t0) {
      rk = *(const u32x4*)(kg + (size_t)(t0 + (tid >> 2)) * 256 + (tid & 3) * 8);
#pragma unroll
      for (int i = 0; i < 2; ++i) { const int c = tid + 256 * i, r = c >> 3, cc = c & 7; rv[i] = *(const u32x4*)(vg + (size_t)r * NKEY + t0 + cc * 8); }
    };
    auto lstore = [&](int buf) {
      *(u32x4*)(Ks + buf * KT + (tid >> 2) * PITCH32 + (tid & 3) * 16) = rk;
#pragma unroll
      for (int i = 0; i < 2; ++i) { const int c = tid + 256 * i, r = c >> 3, cc = c & 7; *(u32x4*)(Vs + buf * VT + r * PITCH64 + cc * 16) = rv[i]; }
    };
    f32x16 O[2] = {zero16(), zero16()};
    float mrun = -1e30f, lsum = 0.f;
    __syncthreads();
    gload(0); lstore(0);
    __syncthreads();
#pragma unroll 1
    for (int t = 0; t < nt; ++t) {
      const int cur = t & 1;
      if (t + 1 < nt) gload((t + 1) * 64);
      f32x16 S[2];
#pragma unroll
      for (int kb = 0; kb < 2; ++kb) {
        S[kb] = zero16();
#pragma unroll
        for (int s = 0; s < 2; ++s) {
          const bf16x8 a = *(const bf16x8*)(Ks + cur * KT + (kb * 32 + l32) * PITCH32 + s * 32 + half * 16);
          S[kb] = MFMA32(a, qf[s], S[kb]);
        }
      }
      float mx = S[0][0];
#pragma unroll
      for (int r = 0; r < 16; ++r) { mx = fmaxf(mx, S[0][r]); mx = fmaxf(mx, S[1][r]); }
      mx = fmaxf(mx, xor32(mx));
      if (__any(mx > mrun + 8.f)) {
        const float mnew = fmaxf(mrun, mx);
        const float alpha = __builtin_amdgcn_exp2f(mrun - mnew);
        mrun = mnew;
        lsum *= alpha;
#pragma unroll
        for (int r = 0; r < 16; ++r) { O[0][r] *= alpha; O[1][r] *= alpha; }
      }
      float ps = 0.f;
#pragma unroll
      for (int kb = 0; kb < 2; ++kb)
#pragma unroll
        for (int r = 0; r < 16; ++r) { const float e = __builtin_amdgcn_exp2f(S[kb][r] - mrun); S[kb][r] = e; ps += e; }
      lsum += ps;
#pragma unroll
      for (int kb = 0; kb < 2; ++kb)
#pragma unroll
        for (int s = 0; s < 2; ++s) {
          u32x4 pf; pf[0] = pk2(S[kb][8 * s], S[kb][8 * s + 1]); pf[1] = pk2(S[kb][8 * s + 2], S[kb][8 * s + 3]); pf[2] = pk2(S[kb][8 * s + 4], S[kb][8 * s + 5]); pf[3] = pk2(S[kb][8 * s + 6], S[kb][8 * s + 7]);
          const bf16x8 pfr = __builtin_bit_cast(bf16x8, pf);
#pragma unroll
          for (int dvb = 0; dvb < 2; ++dvb) {
            const char* va = Vs + cur * VT + (dvb * 32 + l32) * PITCH64 + (kb * 32 + 16 * s + 4 * half) * 2;
            u32x4 av; const u32x2 lo = *(const u32x2*)va, hi = *(const u32x2*)(va + 16);
            av[0] = lo[0]; av[1] = lo[1]; av[2] = hi[0]; av[3] = hi[1];
            O[dvb] = MFMA32(__builtin_bit_cast(bf16x8, av), pfr, O[dvb]);
          }
        }
      if (t + 1 < nt) lstore(cur ^ 1);
      __syncthreads();
    }
    lsum += xor32(lsum);
    const float coef = (mp == 0) ? 1.f / lsum : -lam / lsum;
#pragma unroll
    for (int dvb = 0; dvb < 2; ++dvb)
#pragma unroll
      for (int r = 0; r < 16; ++r) R[dvb][r] += O[dvb][r] * coef;
  }
  {
    constexpr int XO = 32768;
    float* xo = (float*)(lds + XO);
    if (hbk == 1) {
#pragma unroll
      for (int dvb = 0; dvb < 2; ++dvb)
#pragma unroll
        for (int r = 0; r < 16; ++r) xo[((w * 2 + dvb) * 16 + r) * 64 + lane] = R[dvb][r];
    }
    __syncthreads();
    if (hbk == 1) return;
    const float* xi = (const float*)(lds_blk + HALF_LDS + XO);
#pragma unroll
    for (int dvb = 0; dvb < 2; ++dvb)
#pragma unroll
      for (int r = 0; r < 16; ++r) R[dvb][r] += xi[((w * 2 + dvb) * 16 + r) * 64 + lane];
  }
  float ss = sumsq16(R[0]) + sumsq16(R[1]);
  ss += xor32(ss);
  const float rstd = rsqrtf(ss * (1.f / 64.f) + EPS) * (1.f - lam_init);
  const float* gs = p.in[27] + (size_t)l * 64;
  bf16_t* mix = (bf16_t*)(p.ws + OFF_MIX) + (size_t)tok * 1024 + 256 + head * 64;
#pragma unroll
  for (int dvb = 0; dvb < 2; ++dvb) {
    { const f32x16 gb = gain_block(gs + dvb * 32, half);
#pragma unroll
      for (int r = 0; r < 16; ++r) R[dvb][r] *= rstd * gb[r]; }
    store_block_bf16(mix + dvb * 32, R[dvb], half);
  }
}

DI void run_phase(const Params& p, int ph, char* lds, int* s_item, int vb) {
#ifdef ONLY_SUB
  const int l = (ph - 1) / 10, sub = ONLY_SUB;
  if (ONLY_SUB == 10) { setup_phase(p, lds); return; }
#else
  if (ph == 0) { setup_phase(p, lds); return; }
  const int l = (ph - 1) / 10, sub = (ph - 1) % 10;
#endif
  const float* modl = (const float*)(p.ws + OFF_MOD) + (size_t)l * 5 * 6144;
  switch (sub) {
    case 0: norm_phase(p, l, 0); break;
    case 1: {
      EpiInProj epi{(bf16_t*)(p.ws + OFF_PROJ), (float*)(p.ws + OFF_DT)};
      const bf16_t* A = (const bf16_t*)(p.ws + OFF_HBUF);
      const bf16_t* Bt = (const bf16_t*)(p.ws + OFF_WIN) + (size_t)l * NPROJP * 1024;
      gemm_phase<256>(A, 1024, Bt, 1024, 1024, 48, 10, lds, vb, epi);
    } break;
    case 2: prep_phase(p, l, lds); break;
    case 3: {
      const int hb = get_hb();
      for (int pair = blockIdx.x; pair < NCHUNK * 4; pair += gridDim.x) ssd_states_item(p, l, pair * 2 + hb, lds + hb * HALF_LDS);
    } break;
    case 4: ssd_scan_phase(p, l); break;
    case 5: {
      unsigned* ctr = (unsigned*)(p.ws + OFF_CTR) + l;
      const int hb = get_hb();
      for (;;) {
        __syncthreads();
        if (threadIdx.x == 0) *s_item = (int)atomicAdd(ctr, 1u);
        __syncthreads();
        const int it = *s_item;
        if (it >= 672) break;
        if (it < 96) ssd_y_item(p, l, it, lds);
        else if (it < 224) attn_mla_item(p, (it - 96) * 2 + hb, lds + hb * HALF_LDS);
        else if (it < 480) attn_diff_item(p, l, it - 224, lds);
        else if (it < 544) attn_mla_item(p, 256 + (it - 480) * 2 + hb, lds + hb * HALF_LDS);
        else attn_diff_item(p, l, 256 + (it - 544), lds);
      }
    } break;
    case 6: {
      EpiResid epi{l == 0 ? p.in[0] : nullptr, l == 0 ? p.in[1] : nullptr, (bf16_t*)(p.ws + OFF_XB), nullptr, modl + 2048};
      const bf16_t* A = (const bf16_t*)(p.ws + OFF_MIX);
      const bf16_t* Bt = (const bf16_t*)(p.ws + OFF_WOUT) + (size_t)l * 1024 * 1024;
      gemm_phase<192>(A, 1024, Bt, 1024, 1024, 64, 4, lds, vb, epi);
    } break;
    case 7: norm_phase(p, l, 1); break;
    case 8: {
      EpiFF1 epi{(bf16_t*)(p.ws + OFF_UBUF)};
      const bf16_t* A = (const bf16_t*)(p.ws + OFF_HBUF);
      const bf16_t* Bt = (const bf16_t*)(p.ws + OFF_WFF1) + (size_t)l * 4096 * 1024;
      gemm_phase<256>(A, 1024, Bt, 1024, 1024, 48, 16, lds, vb, epi);
    } break;
    case 9: {
      EpiResid epi{nullptr, nullptr, (bf16_t*)(p.ws + OFF_XB), l == DEPTH - 1 ? p.out : nullptr, modl + 5120};
      const bf16_t* A = (const bf16_t*)(p.ws + OFF_UBUF);
      const bf16_t* Bt = (const bf16_t*)(p.ws + OFF_WFF2) + (size_t)l * 1024 * 4096;
      gemm_phase<192>(A, 4096, Bt, 4096, 4096, 64, 4, lds, vb, epi);
    } break;
  }
}

constexpr int N_PHASES = 1 + 10 * DEPTH;

__global__ void __launch_bounds__(512, 2) fwd_megakernel(Params p) {
  __shared__ __attribute__((aligned(1024))) char lds[LDS_BYTES + 64];
  uint4& xb_words = *(uint4*)(lds + LDS_BYTES);
  int* s_item = (int*)(lds + LDS_BYTES + 16);
  if (p.ph_end - p.ph_begin == 1) { run_phase(p, p.ph_begin, lds, s_item, blockIdx.x); return; }
  if (p.ph_begin < 0) { cg::this_grid().sync(); return; }
  if (threadIdx.x == 0) xb_words = make_uint4(0u, 0u, 0u, 0u);
  __syncthreads();
  XcdBarrier b = xcd_barrier_post((unsigned*)(p.ws + OFF_BAR), (volatile LAS unsigned*)&xb_words);
  const int vb = blockIdx.x;
  for (int ph = p.ph_begin; ph < p.ph_end; ++ph) {
    run_phase(p, ph, lds, s_item, vb);
    if (ph + 1 < p.ph_end) xcd_barrier(b);
  }
}

extern "C" void kernel_launch(void* const* d_in, const int* in_sizes, int n_in, void* d_out, int out_size, void* d_ws, size_t ws_size, hipStream_t stream) {
  static int grid_blocks = 0;
  if (!grid_blocks) {
    int dev = 0, cus = 0, per_cu = 0;
    (void)hipGetDevice(&dev);
    (void)hipDeviceGetAttribute(&cus, hipDeviceAttributeMultiprocessorCount, dev);
    (void)hipOccupancyMaxActiveBlocksPerMultiprocessor(&per_cu, fwd_megakernel, 512, 0);
    if (per_cu > 1) per_cu = 1;
    if (per_cu < 1) per_cu = 1;
    grid_blocks = cus * per_cu;
  }
  Params p{};
  for (int i = 0; i < 36; ++i) p.in[i] = (const float*)d_in[i];
  p.out = (float*)d_out;
  p.ws = (char*)d_ws;
  (void)hipMemsetAsync(d_ws, 0, 16384, stream);
#if MULTI_LAUNCH
  for (int ph = 0; ph < N_PHASES; ++ph) {
    p.ph_begin = ph; p.ph_end = ph + 1;
    hipLaunchKernelGGL(fwd_megakernel, dim3(grid_blocks), dim3(512), 0, stream, p);
  }
#else
  p.ph_begin = 0; p.ph_end = N_PHASES;
  void* args[] = {&p};
  hipError_t e = hipLaunchCooperativeKernel((void*)fwd_megakernel, dim3(grid_blocks), dim3(512), args, 0, stream);
  if (e != hipSuccess) fprintf(stderr, "cooperative launch failed: %s (grid %d)\n", hipGetErrorString(e), grid_blocks);
#endif
}
```

```cpp
#include <hip/hip_runtime.h>
#include <hip/hip_cooperative_groups.h>
#include <stdint.h>
#include <stdio.h>
namespace cg = cooperative_groups;

#ifndef MULTI_LAUNCH
#define MULTI_LAUNCH 0
#endif

#define DI __device__ __forceinline__
#define LAS __attribute__((address_space(3)))
typedef unsigned short bf16_t;
typedef short bf16x8 __attribute__((ext_vector_type(8)));
typedef short s16x4 __attribute__((ext_vector_type(4)));
typedef float f32x16 __attribute__((ext_vector_type(16)));
typedef float f32x4 __attribute__((ext_vector_type(4)));
typedef unsigned u32x4 __attribute__((ext_vector_type(4)));
typedef unsigned u32x2 __attribute__((ext_vector_type(2)));
#define MFMA32(a, b, c) __builtin_amdgcn_mfma_f32_32x32x16_bf16((a), (b), (c), 0, 0, 0)

constexpr int D = 1024, TP = 4096, TS = 8192, T = 12288, DEPTH = 4, PAST = 256;
constexpr int NPROJ = 2480, NPROJP = 2560, DFF = 4096;
constexpr int NKEY = 4096 + 4 * 2304;
constexpr int C_CQ = 0, C_CKV = 256, C_KR = 384, C_DQ = 416, C_DK = 672, C_DV = 928, C_Z = 1184, C_XBC = 1696, C_DT = 2464;
constexpr float EPS = 1e-6f;
constexpr int NCHUNK = 96;

constexpr size_t O_Y = 0, O_CKV = 12582912, O_KROPE = 14680064, O_DK = 15204352, O_DV = 19398656, O_SSM = 23592960;

constexpr size_t OFF_BAR = 0;
constexpr size_t OFF_XRANK = 14080;
constexpr size_t OFF_CTR = 14336;
constexpr size_t OFF_LAM = 15360;
constexpr size_t OFF_MOD = 16384;
constexpr size_t OFF_ROPE = OFF_MOD + 4ull * 5 * 6144 * 4;
constexpr size_t OFF_WIN = OFF_ROPE + 2048ull * 32 * 4;
constexpr size_t OFF_WOUT = OFF_WIN + 4ull * NPROJP * 1024 * 2;
constexpr size_t OFF_WFF1 = OFF_WOUT + 4ull * 1024 * 1024 * 2;
constexpr size_t OFF_WFF2 = OFF_WFF1 + 4ull * 4096 * 1024 * 2;
constexpr size_t OFF_WUQ = OFF_WFF2 + 4ull * 4096 * 1024 * 2;
constexpr size_t OFF_WUKV = OFF_WUQ + 4ull * 384 * 256 * 2;
constexpr size_t OFF_HBUF = OFF_WUKV + 4ull * 512 * 128 * 2;
constexpr size_t OFF_MIX = OFF_HBUF + (size_t)T * 1024 * 2;
constexpr size_t OFF_DT = OFF_MIX + (size_t)T * 1024 * 2;
constexpr size_t OFF_R = OFF_DT + (size_t)T * 16 * 4;
constexpr size_t OFF_UBUF = OFF_R;
constexpr size_t OFF_PROJ = OFF_R;
constexpr size_t OFF_QA = OFF_PROJ + (size_t)T * NPROJP * 2;
constexpr size_t OFF_KA = OFF_QA + (size_t)T * 384 * 2;
constexpr size_t OFF_VAT = OFF_KA + (size_t)NKEY * 384 * 2;
constexpr size_t OFF_QD = OFF_VAT + 256ull * NKEY * 2;
constexpr size_t OFF_KD = OFF_QD + (size_t)T * 256 * 2;
constexpr size_t OFF_VDT = OFF_KD + (size_t)NKEY * 256 * 2;
constexpr size_t OFF_XBC = OFF_VDT + 256ull * NKEY * 2;
constexpr size_t OFF_ST = OFF_XBC + (size_t)T * 768 * 2;
constexpr size_t OFF_HP = OFF_ST + 96ull * 8 * 2 * 4096 * 4;
constexpr size_t OFF_CDEC = OFF_HP + 96ull * 8 * 2 * 4096 * 2;
constexpr size_t OFF_XB = OFF_CDEC + 96ull * 16 * 4;
constexpr size_t WS_END = OFF_XB + (size_t)T * 1024 * 2;

struct Params {
  const float* in[36];
  float* out;
  char* ws;
  int ph_begin, ph_end;
};

DI unsigned pk2(float lo, float hi) { unsigned r; asm("v_cvt_pk_bf16_f32 %0, %1, %2" : "=v"(r) : "v"(lo), "v"(hi)); return r; }
DI float bflo(unsigned u) { return __uint_as_float(u << 16); }
DI float bfhi(unsigned u) { return __uint_as_float(u & 0xffff0000u); }
DI float bf1(bf16_t h) { return __uint_as_float(((unsigned)h) << 16); }
DI bf16_t f2bf(float x) { return (bf16_t)(pk2(x, 0.f) & 0xffffu); }
DI int crow(int r, int half) { return (r & 3) + 8 * (r >> 2) + 4 * half; }
DI float xor32(float v) { return __shfl_xor(v, 32); }
DI float wave_sum(float v) {
#pragma unroll
  for (int o = 32; o > 0; o >>= 1) v += __shfl_xor(v, o);
  return v;
}
DI f32x16 zero16() { f32x16 z; for (int i = 0; i < 16; ++i) z[i] = 0.f; return z; }
DI int get_tid() { int t = threadIdx.x; asm volatile("" : "+v"(t)); return t; }
DI int get_tid4() { return get_tid() & 255; }
DI int get_hb() { return get_tid() >> 8; }
DI int modrow_of(int m) { return m < TP ? 0 : 1 + ((m - TP) >> 11); }

#define XB_TMO      128
#define XB_XCNT(j)  (256  + 64 * (j))
#define XB_XSUB(j)  (1280 + 64 * (j))
#define XB_XGEN(j)  (2304 + 64 * (j))
#define XB_TOP      3328
#define XB_TOPGEN   3392
#define XCD_BAR_WORDS 3456
#define XB_SPIN_CAP (1u << 22)
DI unsigned xb_ld(unsigned* p) { return __hip_atomic_load(p, __ATOMIC_RELAXED, __HIP_MEMORY_SCOPE_AGENT); }
DI unsigned xb_add(unsigned* p, unsigned v) { return __hip_atomic_fetch_add(p, v, __ATOMIC_RELAXED, __HIP_MEMORY_SCOPE_AGENT); }
DI unsigned xb_xcc_id() { return (unsigned)__builtin_amdgcn_s_getreg((3 << 11) | 20) & 0xFu; }
#define XB_SPIN(cond, bar) do { unsigned _sp = 0; while (cond) { __builtin_amdgcn_s_sleep(1); \
    if ((++_sp & 255u) == 0u) { if (xb_ld(&(bar)[XB_TMO])) break; if (_sp > XB_SPIN_CAP) { atomicAdd(&(bar)[XB_TMO], 1u); break; } } } } while (0)
struct XcdBarrier { unsigned* bar; unsigned x; volatile LAS unsigned* st; };
DI XcdBarrier xcd_barrier_post(unsigned* bar, volatile LAS unsigned* st) {
  XcdBarrier b; b.bar = bar; b.x = xb_xcc_id(); b.st = st;
  if (threadIdx.x == 0) (void)xb_add(&bar[XB_XCNT(b.x)], 1u);
  return b;
}
DI void xcd_barrier_complete(unsigned* bar, unsigned x, unsigned& nloc, unsigned& nx) {
  const unsigned G = gridDim.x * gridDim.y * gridDim.z;
  unsigned sum, cnt, mine, sp = 0u;
  for (;;) {
    sum = 0u; cnt = 0u; mine = 0u;
#pragma unroll
    for (unsigned j = 0; j < 16; ++j) { const unsigned c = xb_ld(&bar[XB_XCNT(j)]); sum += c; cnt += (c > 0u) ? 1u : 0u; mine = (j == x) ? c : mine; }
    if (sum == G) break;
    __builtin_amdgcn_s_sleep(1);
    if ((++sp & 255u) == 0u) { if (xb_ld(&bar[XB_TMO])) break; if (sp > XB_SPIN_CAP) { atomicAdd(&bar[XB_TMO], 1u); break; } }
  }
  nloc = mine > 0u ? mine : 1u; nx = cnt > 0u ? cnt : 1u;
}
DI void xcd_barrier(const XcdBarrier& b) {
  asm volatile("s_waitcnt vmcnt(0)" ::: "memory");
  __syncthreads();
  if (threadIdx.x == 0) {
    unsigned* bar = b.bar;
    __builtin_amdgcn_s_waitcnt(0);
    unsigned nloc = b.st[0], nx = b.st[1];
    if (nloc == 0u) { xcd_barrier_complete(bar, b.x, nloc, nx); b.st[0] = nloc; b.st[1] = nx; }
    const unsigned old = xb_add(&bar[XB_XSUB(b.x)], 1u);
    const unsigned gen = old / nloc;
    if (old + 1u == (gen + 1u) * nloc) {
      __builtin_amdgcn_fence(__ATOMIC_RELEASE, "agent");
      asm volatile("s_waitcnt vmcnt(0)" ::: "memory");
      const unsigned og = xb_add(&bar[XB_TOP], 1u);
      const unsigned tg = og / nx;
      if (og + 1u == (tg + 1u) * nx) xb_add(&bar[XB_TOPGEN], 1u);
      else XB_SPIN(xb_ld(&bar[XB_TOPGEN]) == tg, bar);
      __builtin_amdgcn_fence(__ATOMIC_ACQUIRE, "agent");
      xb_add(&bar[XB_XGEN(b.x)], 1u);
      asm volatile("s_waitcnt vmcnt(0)" ::: "memory");
    } else {
      XB_SPIN(xb_ld(&bar[XB_XGEN(b.x)]) == gen, bar);
      __builtin_amdgcn_fence(__ATOMIC_ACQUIRE, "agent");
      asm volatile("s_waitcnt vmcnt(0)" ::: "memory");
    }
  }
  __syncthreads();
}

constexpr int HALF_LDS = 75776;
constexpr int LDS_BYTES = 2 * HALF_LDS;
constexpr int PITCH64 = 144;
constexpr int PITCH128 = 272;
constexpr int PITCH96 = 208;

DI void transpose_tile4(const float* src, int K, int N, bf16_t* dst, int t0, int ncols, char* lds) {
  float* tile = (float*)lds;
  const int tid = get_tid4();
  f32x4 v[4][4];
#pragma unroll
  for (int q = 0; q < 4; ++q) {
    const int k0 = ((t0 + q) / ncols) * 64, n0 = ((t0 + q) % ncols) * 64;
#pragma unroll
    for (int i = 0; i < 4; ++i) {
      const int r = (tid >> 4) + 16 * i, c4 = (tid & 15) * 4;
      v[q][i] = (f32x4){0.f, 0.f, 0.f, 0.f};
      if (n0 + c4 < N) v[q][i] = *(const f32x4*)(src + (size_t)(k0 + r) * N + n0 + c4);
    }
  }
  __syncthreads();
#pragma unroll
  for (int q = 0; q < 4; ++q)
#pragma unroll
    for (int i = 0; i < 4; ++i) {
      const int r = (tid >> 4) + 16 * i, c4 = (tid & 15) * 4;
      float* t = tile + q * (64 * 65) + r * 65 + c4;
      t[0] = v[q][i][0]; t[1] = v[q][i][1]; t[2] = v[q][i][2]; t[3] = v[q][i][3];
    }
  __syncthreads();
#pragma unroll
  for (int q = 0; q < 4; ++q) {
    const int k0 = ((t0 + q) / ncols) * 64, n0 = ((t0 + q) % ncols) * 64;
    const float* tq = tile + q * (64 * 65);
#pragma unroll
    for (int i = 0; i < 2; ++i) {
      const int n = (tid >> 3) + 32 * i, kc = (tid & 7) * 8;
      u32x4 w;
      w[0] = pk2(tq[(kc + 0) * 65 + n], tq[(kc + 1) * 65 + n]);
      w[1] = pk2(tq[(kc + 2) * 65 + n], tq[(kc + 3) * 65 + n]);
      w[2] = pk2(tq[(kc + 4) * 65 + n], tq[(kc + 5) * 65 + n]);
      w[3] = pk2(tq[(kc + 6) * 65 + n], tq[(kc + 7) * 65 + n]);
      *(u32x4*)(dst + (size_t)(n0 + n) * K + k0 + kc) = w;
    }
  }
}

DI void mod_item(const Params& p, int item, char* lds) {
  float* sc = (float*)lds;
  float* red = sc + 5 * 1024;
  const int tid = get_tid4(), lane = tid & 63, w = tid >> 6;
  const int l = item / 96, j0 = (item % 96) * 64;
  __syncthreads();
  for (int i = tid; i < 5 * 1024; i += 256) {
    const int r = i >> 10, k = i & 1023;
    const float v = (r == 0) ? p.in[8][k] : p.in[7][(r - 1) * 1024 + k];
    sc[i] = v / (1.f + __expf(-v));
  }
  __syncthreads();
  const float* W = p.in[11] + (size_t)l * 1024 * 6144 + j0 + lane;
  float a0 = 0.f, a1 = 0.f, a2 = 0.f, a3 = 0.f, a4 = 0.f;
  const int kb = w * 256;
#pragma unroll 32
  for (int k = 0; k < 256; ++k) {
    const float wv = W[(size_t)(kb + k) * 6144];
    a0 += sc[kb + k] * wv; a1 += sc[1024 + kb + k] * wv; a2 += sc[2048 + kb + k] * wv; a3 += sc[3072 + kb + k] * wv; a4 += sc[4096 + kb + k] * wv;
  }
  red[(w * 5 + 0) * 64 + lane] = a0; red[(w * 5 + 1) * 64 + lane] = a1; red[(w * 5 + 2) * 64 + lane] = a2;
  red[(w * 5 + 3) * 64 + lane] = a3; red[(w * 5 + 4) * 64 + lane] = a4;
  __syncthreads();
  for (int i = tid; i < 320; i += 256) {
    const int r = i / 64, c = i % 64;
    const float s = red[(0 * 5 + r) * 64 + c] + red[(1 * 5 + r) * 64 + c] + red[(2 * 5 + r) * 64 + c] + red[(3 * 5 + r) * 64 + c];
    float* mod = (float*)(p.ws + OFF_MOD);
    mod[((size_t)l * 5 + r) * 6144 + j0 + c] = s + p.in[12][(size_t)l * 6144 + j0 + c];
  }
}

DI void setup_phase(const Params& p, char* lds) {
  constexpr int N_IN = 16 * 40 / 4, N_OUT = 16 * 16 / 4, N_F1 = 16 * 64 / 4, N_F2 = 64 * 16 / 4, N_UQ = 4 * 6 / 4, N_UKV = 2 * 8 / 4;
  constexpr int PER_L = N_IN + N_OUT + N_F1 + N_F2 + N_UQ + N_UKV;
  constexpr int N_TR = PER_L * 4, N_MOD = 384, N_ROPE = 64;
  static_assert((N_MOD + N_TR) % 2 == 0, "pairing");
  if (blockIdx.x == 0 && get_tid() < 4) {
    const int l = get_tid();
    float d1 = 0.f, d2 = 0.f;
    for (int k = 0; k < 32; ++k) { d1 += p.in[23][l * 32 + k] * p.in[24][l * 32 + k]; d2 += p.in[25][l * 32 + k] * p.in[26][l * 32 + k]; }
    const float lam_init = 0.8f - 0.6f * expf(-0.3f * (float)l);
    float* lamp = (float*)(p.ws + OFF_LAM);
    lamp[l * 2] = expf(d1) - expf(d2) + lam_init; lamp[l * 2 + 1] = lam_init;
  }
  const int hb = get_hb();
  lds += hb * HALF_LDS;
  for (int pair = blockIdx.x; pair < (N_MOD + N_TR) / 2; pair += gridDim.x) {
    const int item = pair * 2 + hb;
    if (item < N_MOD) { mod_item(p, item, lds); continue; }
    int it = item - N_MOD;
    {
      const int l = it / PER_L; int r = it % PER_L;
      if (r < N_IN) { transpose_tile4(p.in[13] + (size_t)l * 1024 * NPROJ, 1024, NPROJ, (bf16_t*)(p.ws + OFF_WIN) + (size_t)l * NPROJP * 1024, r * 4, 40, lds); continue; }
      r -= N_IN;
      if (r < N_OUT) { transpose_tile4(p.in[14] + (size_t)l * 1024 * 1024, 1024, 1024, (bf16_t*)(p.ws + OFF_WOUT) + (size_t)l * 1024 * 1024, r * 4, 16, lds); continue; }
      r -= N_OUT;
      if (r < N_F1) { transpose_tile4(p.in[34] + (size_t)l * 1024 * 4096, 1024, 4096, (bf16_t*)(p.ws + OFF_WFF1) + (size_t)l * 4096 * 1024, r * 4, 64, lds); continue; }
      r -= N_F1;
      if (r < N_F2) { transpose_tile4(p.in[35] + (size_t)l * 4096 * 1024, 4096, 1024, (bf16_t*)(p.ws + OFF_WFF2) + (size_t)l * 1024 * 4096, r * 4, 16, lds); continue; }
      r -= N_F2;
      if (r < N_UQ) { transpose_tile4(p.in[17] + (size_t)l * 256 * 384, 256, 384, (bf16_t*)(p.ws + OFF_WUQ) + (size_t)l * 384 * 256, r * 4, 6, lds); continue; }
      r -= N_UQ;
      transpose_tile4(p.in[18] + (size_t)l * 128 * 512, 128, 512, (bf16_t*)(p.ws + OFF_WUKV) + (size_t)l * 512 * 128, r * 4, 8, lds);
    }
  }
  for (int it = blockIdx.x; it < N_ROPE; it += gridDim.x) {
    {
      const int idx = it * 512 + get_tid();
      const int pos = idx >> 4, j = idx & 15;
      const float fr = __builtin_amdgcn_exp2f(-(float)(j & 7) * (13.287712379549449f / 8.f));
      const float base = (j < 8) ? (float)(pos >> 6) : (float)(pos & 63);
      float rev = base * fr * 0.15915494309189535f;
      rev -= floorf(rev);
      float* tab = (float*)(p.ws + OFF_ROPE);
      tab[idx * 2 + 0] = __builtin_amdgcn_cosf(rev);
      tab[idx * 2 + 1] = __builtin_amdgcn_sinf(rev);
    }
  }
}

DI const float* x_row_in(const Params& p, int l, int m) {
  if (l == 0) return m < TP ? p.in[0] + (size_t)m * D : p.in[1] + (size_t)(m - TP) * D;
  return p.out + (size_t)m * D;
}
DI void norm_phase(const Params& p, int l, int which) {
  const int tid = get_tid(), lane = tid & 63, w = tid >> 6;
  const float* g = p.in[which == 0 ? 9 : 10] + (size_t)l * D;
  const float* modl = (const float*)(p.ws + OFF_MOD) + (size_t)l * 5 * 6144;
  bf16_t* hbuf = (bf16_t*)(p.ws + OFF_HBUF);
  constexpr int RW = 6;
  for (int item = blockIdx.x; item < T / (8 * RW); item += gridDim.x) {
    const int m0 = item * 8 * RW + w * RW;
    f32x4 v[RW][4];
#pragma unroll
    for (int rr = 0; rr < RW; ++rr) {
      if (which == 0 && l == 0) {
        const float* x = x_row_in(p, 0, m0 + rr);
#pragma unroll
        for (int i = 0; i < 4; ++i) v[rr][i] = *(const f32x4*)(x + (i >> 1) * 512 + lane * 8 + (i & 1) * 4);
      } else {
        const bf16_t* x = (const bf16_t*)(p.ws + OFF_XB) + (size_t)(m0 + rr) * D;
#pragma unroll
        for (int j = 0; j < 2; ++j) { const u32x4 r = *(const u32x4*)(x + j * 512 + lane * 8);
          v[rr][2 * j] = (f32x4){bflo(r[0]), bfhi(r[0]), bflo(r[1]), bfhi(r[1])}; v[rr][2 * j + 1] = (f32x4){bflo(r[2]), bfhi(r[2]), bflo(r[3]), bfhi(r[3])}; }
      }
    }
    f32x4 gg[4];
#pragma unroll
    for (int i = 0; i < 4; ++i) gg[i] = *(const f32x4*)(g + (i >> 1) * 512 + lane * 8 + (i & 1) * 4);
#pragma unroll
    for (int rr = 0; rr < RW; ++rr) {
      const int m = m0 + rr;
      const float* mod = modl + (size_t)modrow_of(m) * 6144 + (which == 0 ? 0 : 3072);
      float ss = 0.f;
#pragma unroll
      for (int i = 0; i < 4; ++i) ss += v[rr][i][0] * v[rr][i][0] + v[rr][i][1] * v[rr][i][1] + v[rr][i][2] * v[rr][i][2] + v[rr][i][3] * v[rr][i][3];
      ss = wave_sum(ss);
      const float rstd = rsqrtf(ss * (1.f / D) + EPS);
#pragma unroll
      for (int j = 0; j < 2; ++j) {
        u32x4 wv;
#pragma unroll
        for (int ii = 0; ii < 2; ++ii) {
          const int i = 2 * j + ii, c = j * 512 + lane * 8 + ii * 4;
          const f32x4 sh = *(const f32x4*)(mod + c), scl = *(const f32x4*)(mod + 1024 + c);
          float o[4];
#pragma unroll
          for (int e = 0; e < 4; ++e) o[e] = v[rr][i][e] * rstd * gg[i][e] * (1.f + scl[e]) + sh[e];
          wv[2 * ii] = pk2(o[0], o[1]); wv[2 * ii + 1] = pk2(o[2], o[3]);
        }
        *(u32x4*)(hbuf + (size_t)m * D + j * 512 + lane * 8) = wv;
      }
    }
  }
}

DI int lds_byte2(int r, int c) { const int st = (r >> 4) * 2 + (c >> 5), ob = (r & 15) * 64 + (c & 31) * 2; return st * 1024 + (ob ^ (((ob >> 9) & 1) << 5)); }
DI void stage_rc2(int b, int& R, int& C) { const int st = b >> 10, sb = b & 1023, swz = sb ^ (((sb >> 9) & 1) << 5); R = (st >> 1) * 16 + swz / 64; C = (st & 1) * 32 + (swz % 64) / 2; }
#define WAIT_V0() asm volatile("s_waitcnt vmcnt(0)" ::: "memory")
DI bool unit_next(int vb, int i, int nM, int nN, int& pm, int& pn) {
  const int nwg = nM * nN;
  const long L = (long)i * gridDim.x + vb; if (L >= nwg) return false;
  int wgid = (int)L; { const int q = nwg / 8, r = nwg % 8, xcd = wgid % 8, off = wgid / 8; wgid = (xcd < r ? xcd * (q + 1) : r * (q + 1) + (xcd - r) * q) + off; }
  const int nig = 8 * nN, gid = wgid / nig, fm = gid * 8, gsz = (nM - fm) < 8 ? (nM - fm) : 8;
  pm = fm + ((wgid % nig) % gsz); pn = (wgid % nig) / gsz; return true;
}
template <int BM, class Epi>
DI void gemm_phase(const bf16_t* __restrict__ A, int lda, const bf16_t* __restrict__ Bt, int ldb, int K, int nM, int nN, char* shm, int vb, Epi epi) {
  constexpr int BK = 64, TILE_B = 256 * BK * 2, GL = 4, STAGE_B = 2 * TILE_B, GLA = BM / 64, MB = BM / 32;
  const int tid = get_tid(), wid = tid >> 6, lane = tid & 63, wr = wid >> 2, wc = wid & 3, fr = lane & 15, fq = lane >> 4;
  int sR[GL], sC[GL];
#pragma unroll
  for (int i = 0; i < GL; ++i) stage_rc2(wid * 1024 + i * 8192 + lane * 16, sR[i], sC[i]);
  const int lo_ = (fr * 64 + fq * 16) ^ ((fr >> 3) << 5);
  const int aoff = wr * (BM / 32) * 2048 + lo_, boff = TILE_B + wc * 8192 + lo_;
  int sRB[GL];
#pragma unroll
  for (int i = 0; i < GL; ++i) { const int rho = sR[i] & 31, nn = rho >> 4, ii = rho & 15; sRB[i] = (sR[i] & ~31) + 8 * (ii >> 2) + 4 * nn + (ii & 3); }
#define SA_(b) (shm + (b) * STAGE_B)
#define SB_(b) (shm + (b) * STAGE_B + TILE_B)
#define GLDS_STAGE(buf, Ab_, Bb_, kt) do { _Pragma("unroll") for (int i = 0; i < GL; ++i) { \
    if (i < GLA) __builtin_amdgcn_global_load_lds((const unsigned*)((Ab_) + (size_t)sR[i] * lda + (kt) * BK + sC[i]), (LAS unsigned*)(SA_(buf) + wid * 1024 + i * 8192), 16, 0, 0); \
    __builtin_amdgcn_global_load_lds((const unsigned*)((Bb_) + (size_t)sRB[i] * ldb + (kt) * BK + sC[i]), (LAS unsigned*)(SB_(buf) + wid * 1024 + i * 8192), 16, 0, 0); } } while (0)
  int pm, pn;
  if (!unit_next(vb, 0, nM, nN, pm, pn)) return;
  const int nt = K / BK;
  GLDS_STAGE(0, A + (size_t)pm * BM * lda, Bt + (size_t)pn * 256 * ldb, 0);
#pragma unroll 1
  for (int ui = 0;; ++ui) {
    int npm = 0, npn = 0;
    const bool hn = unit_next(vb, ui + 1, nM, nN, npm, npn);
    f32x4 acc[MB][4];
#pragma unroll
    for (int m = 0; m < MB; ++m)
#pragma unroll
      for (int n = 0; n < 4; ++n) acc[m][n] = (f32x4){0.f, 0.f, 0.f, 0.f};
    WAIT_V0(); __syncthreads();
#pragma unroll 1
    for (int t = 0; t < nt; ++t) {
      const int cur = t & 1;
      {
        const bool last = t + 1 >= nt;
        if (!last || hn) {
          const bf16_t* Ab = A + (size_t)(last ? npm : pm) * BM * lda + (last ? 0 : (t + 1) * BK);
          const bf16_t* Bb = Bt + (size_t)(last ? npn : pn) * 256 * ldb + (last ? 0 : (t + 1) * BK);
          GLDS_STAGE(cur ^ 1, Ab, Bb, 0);
        }
      }
      if constexpr (BM == 192) {
        bf16x8 At[2][MB], Bf[2][4];
#pragma unroll
        for (int ks = 0; ks < 2; ++ks) {
#pragma unroll
          for (int n = 0; n < 4; ++n) Bf[ks][n] = *(const bf16x8*)(shm + cur * STAGE_B + boff + (n * 2 + ks) * 1024);
#pragma unroll
          for (int m = 0; m < MB; ++m) At[ks][m] = *(const bf16x8*)(shm + cur * STAGE_B + aoff + (m * 2 + ks) * 1024);
          __builtin_amdgcn_sched_barrier(0);
        }
#pragma unroll
        for (int ks = 0; ks < 2; ++ks) {
#pragma unroll
          for (int m = 0; m < MB; ++m)
#pragma unroll
            for (int n = 0; n < 4; ++n) acc[m][n] = __builtin_amdgcn_mfma_f32_16x16x32_bf16(Bf[ks][n], At[ks][m], acc[m][n], 0, 0, 0);
          __builtin_amdgcn_sched_barrier(0);
        }
      } else {
#pragma unroll
        for (int ks = 0; ks < 2; ++ks) {
          bf16x8 At[MB], Bf[4];
#pragma unroll
          for (int n = 0; n < 4; ++n) Bf[n] = *(const bf16x8*)(shm + cur * STAGE_B + boff + (n * 2 + ks) * 1024);
#pragma unroll
          for (int m = 0; m < MB; ++m) At[m] = *(const bf16x8*)(shm + cur * STAGE_B + aoff + (m * 2 + ks) * 1024);
          __builtin_amdgcn_sched_barrier(0);
#pragma unroll
          for (int m = 0; m < MB; ++m)
#pragma unroll
            for (int n = 0; n < 4; ++n) acc[m][n] = __builtin_amdgcn_mfma_f32_16x16x32_bf16(Bf[n], At[m], acc[m][n], 0, 0, 0);
          __builtin_amdgcn_sched_barrier(0);
        }
      }
      if (t + 1 < nt) { WAIT_V0(); __syncthreads(); }
    }
    const int brow = pm * BM, bcol = pn * 256;
    if constexpr (Epi::PRELOAD) {
      u32x4 xr[MB][2];
#pragma unroll
      for (int m = 0; m < MB; ++m)
#pragma unroll
        for (int g2 = 0; g2 < 2; ++g2) xr[m][g2] = epi.preload(brow + wr * (BM / 2) + m * 16 + fr, bcol + wc * 64 + g2 * 32 + fq * 8);
#pragma unroll
      for (int m = 0; m < MB; ++m)
#pragma unroll
        for (int g2 = 0; g2 < 2; ++g2) epi(brow + wr * (BM / 2) + m * 16 + fr, bcol + wc * 64 + g2 * 32 + fq * 8, acc[m][2 * g2], acc[m][2 * g2 + 1], xr[m][g2]);
    } else {
#pragma unroll
      for (int m = 0; m < MB; ++m)
#pragma unroll
        for (int g2 = 0; g2 < 2; ++g2) epi(brow + wr * (BM / 2) + m * 16 + fr, bcol + wc * 64 + g2 * 32 + fq * 8, acc[m][2 * g2], acc[m][2 * g2 + 1]);
    }
    if (!hn) break;
    pm = npm; pn = npn;
  }
  __syncthreads();
#undef SA_
#undef SB_
#undef GLDS_STAGE
}

struct EpiInProj {
  static constexpr bool PRELOAD = false;
  bf16_t* proj; float* dt;
  DI void operator()(int m, int n, const f32x4& v0, const f32x4& v1) const {
    u32x4 o; o[0] = pk2(v0[0], v0[1]); o[1] = pk2(v0[2], v0[3]); o[2] = pk2(v1[0], v1[1]); o[3] = pk2(v1[2], v1[3]);
    *(u32x4*)(proj + (size_t)m * NPROJP + n) = o;
    if (n >= C_DT && n < NPROJ) { float* d = dt + (size_t)m * 16 + (n - C_DT); *(f32x4*)d = v0; *(f32x4*)(d + 4) = v1; }
  }
};
struct EpiResid {
  static constexpr bool PRELOAD = true;
  const float* xin_p; const float* xin_s;
  bf16_t* xb; float* xout_f;
  const float* gate;
  DI u32x4 preload(int m, int n) const { return xin_p ? (u32x4){0u, 0u, 0u, 0u} : *(const u32x4*)(xb + (size_t)m * D + n); }
  DI void operator()(int m, int n, const f32x4& v0, const f32x4& v1, const u32x4& r) const {
    const float* gp = gate + (size_t)modrow_of(m) * 6144 + n;
    const f32x4 g0 = *(const f32x4*)gp, g1 = *(const f32x4*)(gp + 4);
    f32x4 x0, x1;
    if (xin_p) { const float* xi = ((m < TP) ? xin_p + (size_t)m * D : xin_s + (size_t)(m - TP) * D) + n; x0 = *(const f32x4*)xi; x1 = *(const f32x4*)(xi + 4); }
    else { x0 = (f32x4){bflo(r[0]), bfhi(r[0]), bflo(r[1]), bfhi(r[1])}; x1 = (f32x4){bflo(r[2]), bfhi(r[2]), bflo(r[3]), bfhi(r[3])}; }
    const f32x4 y0 = x0 + g0 * v0, y1 = x1 + g1 * v1;
    if (xout_f) { float* o = xout_f + (size_t)m * D + n; *(f32x4*)o = y0; *(f32x4*)(o + 4) = y1; }
    else { u32x4 o; o[0] = pk2(y0[0], y0[1]); o[1] = pk2(y0[2], y0[3]); o[2] = pk2(y1[0], y1[1]); o[3] = pk2(y1[2], y1[3]); *(u32x4*)(xb + (size_t)m * D + n) = o; }
  }
};
struct EpiFF1 {
  static constexpr bool PRELOAD = false;
  bf16_t* u;
  DI void operator()(int m, int n, const f32x4& v0, const f32x4& v1) const {
    float r[8];
#pragma unroll
    for (int e = 0; e < 4; ++e) { const float t0 = v0[e] > 0.f ? v0[e] : 0.f, t1 = v1[e] > 0.f ? v1[e] : 0.f; r[e] = t0 * t0; r[4 + e] = t1 * t1; }
    u32x4 o; o[0] = pk2(r[0], r[1]); o[1] = pk2(r[2], r[3]); o[2] = pk2(r[4], r[5]); o[3] = pk2(r[6], r[7]);
    *(u32x4*)(u + (size_t)m * DFF + n) = o;
  }
};

DI void rope_block(f32x16& v, const float* tab, int pos, int half) {
  const float* t = tab + (size_t)pos * 32;
#pragma unroll
  for (int q = 0; q < 2; ++q)
#pragma unroll
    for (int r = 0; r < 4; ++r) {
      const int fi = q * 8 + r + 4 * half;
      const float c = t[fi * 2], s = t[fi * 2 + 1];
      const float x1 = v[q * 8 + r], x2 = v[q * 8 + r + 4];
      v[q * 8 + r] = x1 * c - x2 * s;
      v[q * 8 + r + 4] = x2 * c + x1 * s;
    }
}
DI void store_block_bf16(bf16_t* dst, const f32x16& v, int half) {
#pragma unroll
  for (int q = 0; q < 4; q += 2) {
    unsigned ax = pk2(v[4 * q], v[4 * q + 1]), ay = pk2(v[4 * q + 2], v[4 * q + 3]);
    unsigned bx = pk2(v[4 * q + 4], v[4 * q + 5]), by = pk2(v[4 * q + 6], v[4 * q + 7]);
    { auto r = __builtin_amdgcn_permlane32_swap(ax, bx, false, false); ax = r[0]; bx = r[1]; }
    { auto r = __builtin_amdgcn_permlane32_swap(ay, by, false, false); ay = r[0]; by = r[1]; }
    u32x4 wv; wv[0] = ax; wv[1] = ay; wv[2] = bx; wv[3] = by;
    *(u32x4*)(dst + 8 * q + 8 * half) = wv;
  }
}
DI f32x16 gain_block(const float* g, int half) {
  f32x16 o;
#pragma unroll
  for (int q = 0; q < 4; ++q) { const f32x4 v = *(const f32x4*)(g + 8 * q + 4 * half); o[4 * q] = v[0]; o[4 * q + 1] = v[1]; o[4 * q + 2] = v[2]; o[4 * q + 3] = v[3]; }
  return o;
}
DI float sumsq16(const f32x16& v) { float s = 0.f;
#pragma unroll
  for (int i = 0; i < 16; ++i) s += v[i] * v[i];
  return s; }

DI void mla_q_item(const Params& p, int l, int item4, char* lds) {
  const int item = item4 >> 2, head0 = item4 & 3;
  const int lane = get_tid() & 63, w = get_tid() >> 6, l32 = lane & 31, half = lane >> 5;
  {
    const bf16_t* Wg = (const bf16_t*)(p.ws + OFF_WUQ) + ((size_t)l * 384 + head0 * 96) * 256;
    u32x4 t[6];
#pragma unroll
    for (int i = 0; i < 6; ++i) { const int c = get_tid() + 512 * i; t[i] = *(const u32x4*)(Wg + (size_t)(c >> 5) * 256 + (c & 31) * 8); }
    __syncthreads();
#pragma unroll
    for (int i = 0; i < 6; ++i) { const int c = get_tid() + 512 * i; *(u32x4*)(lds + (c >> 5) * 528 + (c & 31) * 16) = t[i]; }
    if (get_tid() < 64) *(f32x4*)(lds + 50688 + get_tid() * 16) = *(const f32x4*)(p.in[15] + (size_t)l * 256 + get_tid() * 4);
  }
  const int tok = item * 256 + w * 32 + l32;
  const bf16_t* proj = (const bf16_t*)(p.ws + OFF_PROJ) + (size_t)tok * NPROJP + C_CQ;
  const float* gq = p.in[15] + (size_t)l * 256;
  float ss = 0.f;
  u32x4 raw[16];
#pragma unroll
  for (int s = 0; s < 16; ++s) raw[s] = *(const u32x4*)(proj + 16 * s + 8 * half);
#pragma unroll
  for (int s = 0; s < 16; ++s) {
#pragma unroll
    for (int e = 0; e < 4; ++e) { const float a = bflo(raw[s][e]), b = bfhi(raw[s][e]); ss += a * a + b * b; }
  }
  ss += xor32(ss);
  const float rstd = rsqrtf(ss * (1.f / 256.f) + EPS);
  __syncthreads();
  bf16x8 fr[16];
#pragma unroll
  for (int s = 0; s < 16; ++s) {
    const f32x4 g0 = *(const f32x4*)(lds + 50688 + (16 * s + 8 * half) * 4), g1 = *(const f32x4*)(lds + 50688 + (16 * s + 8 * half + 4) * 4);
    u32x4 o;
    o[0] = pk2(bflo(raw[s][0]) * rstd * g0[0], bfhi(raw[s][0]) * rstd * g0[1]);
    o[1] = pk2(bflo(raw[s][1]) * rstd * g0[2], bfhi(raw[s][1]) * rstd * g0[3]);
    o[2] = pk2(bflo(raw[s][2]) * rstd * g1[0], bfhi(raw[s][2]) * rstd * g1[1]);
    o[3] = pk2(bflo(raw[s][3]) * rstd * g1[2], bfhi(raw[s][3]) * rstd * g1[3]);
    fr[s] = __builtin_bit_cast(bf16x8, o);
  }
  const bf16_t* W = (const bf16_t*)(p.ws + OFF_WUQ) + (size_t)l * 384 * 256;
  const float* gqk = p.in[19] + (size_t)l * 96;
  const float* tab = (const float*)(p.ws + OFF_ROPE);
  const bool rope = tok >= TP;
  const int pos = rope ? ((tok - TP) & 2047) : 0;
  const float qscale = 0.10206207261596577f * 1.4426950408889634f;
  bf16_t* qa = (bf16_t*)(p.ws + OFF_QA) + (size_t)tok * 384;
#pragma unroll 1
  for (int head = head0; head < head0 + 1; ++head) {
    f32x16 acc[3];
#pragma unroll
    for (int db = 0; db < 3; ++db) acc[db] = zero16();
#pragma unroll
    for (int db = 0; db < 3; ++db) {
      bf16x8 a[16];
      const char* wrow = lds + (db * 32 + l32) * 528 + 16 * half;
#pragma unroll
      for (int s = 0; s < 16; ++s) a[s] = *(const bf16x8*)(wrow + 32 * s);
      __builtin_amdgcn_sched_barrier(0);
#pragma unroll
      for (int s = 0; s < 16; ++s) acc[db] = MFMA32(a[s], fr[s], acc[db]);
      __builtin_amdgcn_sched_barrier(0);
    }
    float s2 = sumsq16(acc[0]) + sumsq16(acc[1]) + sumsq16(acc[2]);
    s2 += xor32(s2);
    const float r2 = rsqrtf(s2 * (1.f / 96.f) + EPS);
#pragma unroll
    for (int db = 0; db < 3; ++db) {
      const f32x16 gb = gain_block(gqk + db * 32, half);
#pragma unroll
      for (int r = 0; r < 16; ++r) acc[db][r] *= r2 * gb[r];
    }
    if (rope) rope_block(acc[2], tab, pos, half);
#pragma unroll
    for (int db = 0; db < 3; ++db) {
#pragma unroll
      for (int r = 0; r < 16; ++r) acc[db][r] *= qscale;
      store_block_bf16(qa + head * 96 + db * 32, acc[db], half);
    }
  }
}

DI void mla_kv_item(const Params& p, int l, int item4, char* lds) {
  const int item = item4 >> 2, head0 = item4 & 3;
  const int lane = get_tid() & 63, w = get_tid() >> 6, l32 = lane & 31, half = lane >> 5;
  {
    const bf16_t* Wg = (const bf16_t*)(p.ws + OFF_WUKV) + ((size_t)l * 512 + head0 * 128) * 128;
    u32x4 t[4];
#pragma unroll
    for (int i = 0; i < 4; ++i) { const int c = get_tid() + 512 * i; t[i] = *(const u32x4*)(Wg + (size_t)(c >> 4) * 128 + (c & 15) * 8); }
    __syncthreads();
#pragma unroll
    for (int i = 0; i < 4; ++i) { const int c = get_tid() + 512 * i; *(u32x4*)(lds + (c >> 4) * PITCH128 + (c & 15) * 16) = t[i]; }
  }
  const int kr = item * 256 + w * 32 + l32;
  int tok = -1, b = 0, j = 0; bool cached = false, rope = false; int pos = 0;
  if (kr < TP) { tok = kr; }
  else { b = (kr - TP) / 2304; j = (kr - TP) % 2304; if (j < PAST) cached = true; else { tok = TP + b * 2048 + (j - PAST); rope = true; pos = j - PAST; } }
  bf16x8 fr[8];
  f32x16 krb;
  if (!cached) {
    const bf16_t* proj = (const bf16_t*)(p.ws + OFF_PROJ) + (size_t)tok * NPROJP;
    const float* gkv = p.in[16] + (size_t)l * 128;
    u32x4 raw[8]; float ss = 0.f;
    f32x4 gv0[8], gv1[8]; u32x2 rvv[4];
#pragma unroll
    for (int s = 0; s < 8; ++s) raw[s] = *(const u32x4*)(proj + C_CKV + 16 * s + 8 * half);
#pragma unroll
    for (int s = 0; s < 8; ++s) { gv0[s] = *(const f32x4*)(gkv + 16 * s + 8 * half); gv1[s] = *(const f32x4*)(gkv + 16 * s + 8 * half + 4); }
#pragma unroll
    for (int q = 0; q < 4; ++q) rvv[q] = *(const u32x2*)(proj + C_KR + 8 * q + 4 * half);
#pragma unroll
    for (int s = 0; s < 8; ++s) {
#pragma unroll
      for (int e = 0; e < 4; ++e) { const float a = bflo(raw[s][e]), bb = bfhi(raw[s][e]); ss += a * a + bb * bb; }
    }
    ss += xor32(ss);
    const float rstd = rsqrtf(ss * (1.f / 128.f) + EPS);
#pragma unroll
    for (int s = 0; s < 8; ++s) {
      const f32x4 g0 = gv0[s], g1 = gv1[s];
      f32x4 o0, o1;
      o0[0] = bflo(raw[s][0]) * rstd * g0[0]; o0[1] = bfhi(raw[s][0]) * rstd * g0[1]; o0[2] = bflo(raw[s][1]) * rstd * g0[2]; o0[3] = bfhi(raw[s][1]) * rstd * g0[3];
      o1[0] = bflo(raw[s][2]) * rstd * g1[0]; o1[1] = bfhi(raw[s][2]) * rstd * g1[1]; o1[2] = bflo(raw[s][3]) * rstd * g1[2]; o1[3] = bfhi(raw[s][3]) * rstd * g1[3];
      u32x4 o; o[0] = pk2(o0[0], o0[1]); o[1] = pk2(o0[2], o0[3]); o[2] = pk2(o1[0], o1[1]); o[3] = pk2(o1[2], o1[3]);
      fr[s] = __builtin_bit_cast(bf16x8, o);
      if (tok < TP && head0 == 0) {
        float* dst = p.out + O_CKV + (((size_t)(tok >> 8) * DEPTH + l) * 256 + (tok & 255)) * 128 + 16 * s + 8 * half;
        *(f32x4*)dst = o0; *(f32x4*)(dst + 4) = o1;
      }
    }
#pragma unroll
    for (int q = 0; q < 4; ++q) {
      const u32x2 rv = rvv[q];
      krb[4 * q] = bflo(rv[0]); krb[4 * q + 1] = bfhi(rv[0]); krb[4 * q + 2] = bflo(rv[1]); krb[4 * q + 3] = bfhi(rv[1]);
      if (tok < TP && head0 == 0) {
        float* dst = p.out + O_KROPE + (((size_t)(tok >> 8) * DEPTH + l) * 256 + (tok & 255)) * 32 + 8 * q + 4 * half;
        f32x4 o = {krb[4 * q], krb[4 * q + 1], krb[4 * q + 2], krb[4 * q + 3]};
        *(f32x4*)dst = o;
      }
    }
  } else {
    const float* src = p.in[2] + (((size_t)b * DEPTH + l) * PAST + j) * 128;
#pragma unroll
    for (int s = 0; s < 8; ++s) {
      const f32x4 v0 = *(const f32x4*)(src + 16 * s + 8 * half), v1 = *(const f32x4*)(src + 16 * s + 8 * half + 4);
      u32x4 o; o[0] = pk2(v0[0], v0[1]); o[1] = pk2(v0[2], v0[3]); o[2] = pk2(v1[0], v1[1]); o[3] = pk2(v1[2], v1[3]);
      fr[s] = __builtin_bit_cast(bf16x8, o);
    }
    const float* ks = p.in[3] + (((size_t)b * DEPTH + l) * PAST + j) * 32;
#pragma unroll
    for (int q = 0; q < 4; ++q) {
      const f32x4 v = *(const f32x4*)(ks + 8 * q + 4 * half);
      krb[4 * q] = v[0]; krb[4 * q + 1] = v[1]; krb[4 * q + 2] = v[2]; krb[4 * q + 3] = v[3];
    }
  }
  const bf16_t* W = (const bf16_t*)(p.ws + OFF_WUKV) + (size_t)l * 512 * 128;
  const float* gk = p.in[20] + (size_t)l * 96;
  const float* tab = (const float*)(p.ws + OFF_ROPE);
  bf16_t* ka = (bf16_t*)(p.ws + OFF_KA) + (size_t)kr * 384;
  bf16_t* vat = (bf16_t*)(p.ws + OFF_VAT);
  const float ssr = sumsq16(krb);
  __syncthreads();
#pragma unroll 1
  for (int head = head0; head < head0 + 1; ++head) {
    f32x16 acc[4];
#pragma unroll
    for (int db = 0; db < 4; ++db) acc[db] = zero16();
#pragma unroll
    for (int dp = 0; dp < 2; ++dp) {
      bf16x8 a[2][8];
#pragma unroll
      for (int d2 = 0; d2 < 2; ++d2)
#pragma unroll
        for (int s = 0; s < 8; ++s) a[d2][s] = *(const bf16x8*)(lds + ((dp * 2 + d2) * 32 + l32) * PITCH128 + 32 * s + 16 * half);
      __builtin_amdgcn_sched_barrier(0);
#pragma unroll
      for (int d2 = 0; d2 < 2; ++d2)
#pragma unroll
        for (int s = 0; s < 8; ++s) acc[dp * 2 + d2] = MFMA32(a[d2][s], fr[s], acc[dp * 2 + d2]);
      __builtin_amdgcn_sched_barrier(0);
    }
    float s2 = sumsq16(acc[0]) + sumsq16(acc[1]) + ssr;
    s2 += xor32(s2);
    const float r2 = rsqrtf(s2 * (1.f / 96.f) + EPS);
    f32x16 k2;
    {
      const f32x16 g0 = gain_block(gk, half), g1 = gain_block(gk + 32, half), g2 = gain_block(gk + 64, half);
#pragma unroll
      for (int r = 0; r < 16; ++r) { acc[0][r] *= r2 * g0[r]; acc[1][r] *= r2 * g1[r]; k2[r] = krb[r] * r2 * g2[r]; }
    }
    if (rope) rope_block(k2, tab, pos, half);
    store_block_bf16(ka + head * 96, acc[0], half);
    store_block_bf16(ka + head * 96 + 32, acc[1], half);
    store_block_bf16(ka + head * 96 + 64, k2, half);
    {
      char* ldsw = lds + 53248 + w * 9216;
#pragma unroll
      for (int db = 2; db < 4; ++db)
#pragma unroll
        for (int r = 0; r < 16; ++r) *(bf16_t*)(ldsw + ((db - 2) * 32 + crow(r, half)) * 80 + l32 * 2) = f2bf(acc[db][r]);
      const int kr0w = kr - l32;
#pragma unroll
      for (int c = 0; c < 4; ++c) {
        const int ch = c * 64 + lane, dv = ch >> 2, cc = ch & 3;
        *(u32x4*)(vat + ((size_t)head * 64 + dv) * NKEY + kr0w + cc * 8) = *(const u32x4*)(ldsw + dv * 80 + cc * 16);
      }
    }
  }
}

DI void diff_qk_thread(const Params& p, int l, int idx, bool isk) {
  const float* tab = (const float*)(p.ws + OFF_ROPE);
  const int hm = idx & 7, row = idx >> 3;
  float x[32];
  int tok = -1, pos = 0; bool rope = false, cached = false;
  if (!isk) { tok = row; if (tok >= TP) { rope = true; pos = (tok - TP) & 2047; } }
  else {
    if (row < TP) tok = row;
    else { const int b = (row - TP) / 2304, j = (row - TP) % 2304;
      if (j < PAST) { cached = true;
        const float* src = p.in[4] + ((((size_t)b * DEPTH + l) * PAST + j) * 8 + hm) * 32;
#pragma unroll
        for (int i = 0; i < 8; ++i) { const f32x4 v = *(const f32x4*)(src + 4 * i); x[4 * i] = v[0]; x[4 * i + 1] = v[1]; x[4 * i + 2] = v[2]; x[4 * i + 3] = v[3]; }
      } else { tok = TP + b * 2048 + (j - PAST); rope = true; pos = j - PAST; } }
  }
  if (!cached) {
    const bf16_t* src = (const bf16_t*)(p.ws + OFF_PROJ) + (size_t)tok * NPROJP + (isk ? C_DK : C_DQ) + hm * 32;
    float ss = 0.f;
#pragma unroll
    for (int i = 0; i < 4; ++i) {
      const u32x4 v = *(const u32x4*)(src + 8 * i);
#pragma unroll
      for (int e = 0; e < 4; ++e) { x[8 * i + 2 * e] = bflo(v[e]); x[8 * i + 2 * e + 1] = bfhi(v[e]); }
    }
#pragma unroll
    for (int i = 0; i < 32; ++i) ss += x[i] * x[i];
    const float rstd = rsqrtf(ss * (1.f / 32.f) + EPS);
    const float* g = p.in[isk ? 22 : 21] + (size_t)l * 32;
#pragma unroll
    for (int i = 0; i < 32; ++i) x[i] *= rstd * g[i];
    if (isk && tok < TP) {
      float* dst = p.out + O_DK + (((size_t)(tok >> 8) * DEPTH + l) * 256 + (tok & 255)) * 256 + hm * 32;
#pragma unroll
      for (int i = 0; i < 8; ++i) { f32x4 o = {x[4 * i], x[4 * i + 1], x[4 * i + 2], x[4 * i + 3]}; *(f32x4*)(dst + 4 * i) = o; }
    }
    if (rope) {
      const float* t = tab + (size_t)pos * 32;
#pragma unroll
      for (int q = 0; q < 2; ++q)
#pragma unroll
        for (int m = 0; m < 8; ++m) {
          const float c = t[(q * 8 + m) * 2], s = t[(q * 8 + m) * 2 + 1];
          const float x1 = x[q * 16 + m], x2 = x[q * 16 + 8 + m];
          x[q * 16 + m] = x1 * c - x2 * s; x[q * 16 + 8 + m] = x2 * c + x1 * s;
        }
    }
  }
  const float sc = isk ? 1.f : 0.17677669529663687f * 1.4426950408889634f;
  bf16_t* dst = (bf16_t*)(p.ws + (isk ? OFF_KD : OFF_QD)) + (size_t)row * 256 + hm * 32;
#pragma unroll
  for (int i = 0; i < 4; ++i) {
    u32x4 o;
#pragma unroll
    for (int e = 0; e < 4; ++e) o[e] = pk2(x[8 * i + 2 * e] * sc, x[8 * i + 2 * e + 1] * sc);
    *(u32x4*)(dst + 8 * i) = o;
  }
}
DI void diff_v_thread(const Params& p, int l, int idx, char* ldsw) {
  const int lane = get_tid() & 63;
  const int head = idx / NKEY, kr = idx % NKEY, kr0 = kr - lane;
  constexpr int VP = 144;
  int tok = -1;
  if (kr < TP) tok = kr;
  else { const int b = (kr - TP) / 2304, j = (kr - TP) % 2304;
    if (j < PAST) {
      const float* src = p.in[5] + ((((size_t)b * DEPTH + l) * PAST + j) * 4 + head) * 64;
#pragma unroll
      for (int i = 0; i < 16; ++i) { const f32x4 v = *(const f32x4*)(src + 4 * i);
#pragma unroll
        for (int e = 0; e < 4; ++e) *(bf16_t*)(ldsw + (4 * i + e) * VP + lane * 2) = f2bf(v[e]); }
      tok = -2;
    } else tok = TP + b * 2048 + (j - PAST);
  }
  if (tok >= 0) {
    const bf16_t* src = (const bf16_t*)(p.ws + OFF_PROJ) + (size_t)tok * NPROJP + C_DV + head * 64;
    float* od = (tok < TP) ? p.out + O_DV + (((size_t)(tok >> 8) * DEPTH + l) * 256 + (tok & 255)) * 256 + head * 64 : nullptr;
#pragma unroll
    for (int i = 0; i < 8; ++i) {
      const u32x4 v = *(const u32x4*)(src + 8 * i);
#pragma unroll
      for (int e = 0; e < 4; ++e) {
        *(bf16_t*)(ldsw + (8 * i + 2 * e) * VP + lane * 2) = (bf16_t)(v[e] & 0xffffu);
        *(bf16_t*)(ldsw + (8 * i + 2 * e + 1) * VP + lane * 2) = (bf16_t)(v[e] >> 16);
      }
      if (od) {
        f32x4 o0 = {bflo(v[0]), bfhi(v[0]), bflo(v[1]), bfhi(v[1])}, o1 = {bflo(v[2]), bfhi(v[2]), bflo(v[3]), bfhi(v[3])};
        *(f32x4*)(od + 8 * i) = o0; *(f32x4*)(od + 8 * i + 4) = o1;
      }
    }
  }
  bf16_t* vdt = (bf16_t*)(p.ws + OFF_VDT) + (size_t)head * 64 * NKEY + kr0;
#pragma unroll
  for (int c = 0; c < 8; ++c) {
    const int ch = c * 64 + lane, dv = ch >> 3, cc = ch & 7;
    *(u32x4*)(vdt + (size_t)dv * NKEY + cc * 8) = *(const u32x4*)(ldsw + dv * VP + cc * 16);
  }
}
template <int CU>
DI void conv_threads(const Params& p, int l, int idx0, int stride) {
  u32x4 v[CU][5]; f32x4 bia[CU][2];
  int tokv[CU], c0v[CU];
  f32x4 wt[5][2];
  {
    const float* cw = p.in[28] + (size_t)l * 5 * 768 + (idx0 % 96) * 8;
#pragma unroll
    for (int k = 0; k < 5; ++k) { wt[k][0] = *(const f32x4*)(cw + k * 768); wt[k][1] = *(const f32x4*)(cw + k * 768 + 4); }
  }
#pragma unroll
  for (int u = 0; u < CU; ++u) {
    const int idx = idx0 + u * stride;
    const int tok = idx / 96, c0 = (idx % 96) * 8;
    tokv[u] = tok; c0v[u] = c0;
    int pos, L;
    if (tok < TP) { pos = tok & 255; L = 256; } else { pos = (tok - TP) & 2047; L = 2048; }
    const bf16_t* src = (const bf16_t*)(p.ws + OFF_PROJ) + (size_t)tok * NPROJP + C_XBC + c0;
#pragma unroll
    for (int k = 0; k < 5; ++k) {
      const int pp = pos + k - 2;
      v[u][k] = (u32x4){0u, 0u, 0u, 0u};
      if (pp >= 0 && pp < L) v[u][k] = *(const u32x4*)(src + (ptrdiff_t)(k - 2) * NPROJP);
    }
    const float* cb = p.in[29] + (size_t)l * 768 + c0;
    bia[u][0] = *(const f32x4*)cb; bia[u][1] = *(const f32x4*)(cb + 4);
  }
#pragma unroll
  for (int u = 0; u < CU; ++u) {
    float acc[8] = {bia[u][0][0], bia[u][0][1], bia[u][0][2], bia[u][0][3], bia[u][1][0], bia[u][1][1], bia[u][1][2], bia[u][1][3]};
#pragma unroll
    for (int k = 0; k < 5; ++k) {
      const f32x4 w0 = wt[k][0], w1 = wt[k][1];
      const u32x4 x = v[u][k];
      acc[0] += w0[0] * bflo(x[0]); acc[1] += w0[1] * bfhi(x[0]); acc[2] += w0[2] * bflo(x[1]); acc[3] += w0[3] * bfhi(x[1]);
      acc[4] += w1[0] * bflo(x[2]); acc[5] += w1[1] * bfhi(x[2]); acc[6] += w1[2] * bflo(x[3]); acc[7] += w1[3] * bfhi(x[3]);
    }
#pragma unroll
    for (int e = 0; e < 8; ++e) acc[e] = acc[e] / (1.f + __expf(-acc[e]));
    u32x4 o; o[0] = pk2(acc[0], acc[1]); o[1] = pk2(acc[2], acc[3]); o[2] = pk2(acc[4], acc[5]); o[3] = pk2(acc[6], acc[7]);
    *(u32x4*)((bf16_t*)(p.ws + OFF_XBC) + (size_t)tokv[u] * 768 + c0v[u]) = o;
  }
}
DI void dt_thread(const Params& p, int l, int idx) {
  float* dt = (float*)(p.ws + OFF_DT);
  const float v = dt[idx] + p.in[31][(size_t)l * 16 + (idx & 15)];
  dt[idx] = fmaxf(v, 0.f) + log1pf(__expf(-fabsf(v)));
}

DI void prep_phase(const Params& p, int l, char* lds) {
  constexpr int N_Q = 48 * 4, N_KV = 52 * 4, N_DQ = T * 8 / 512, N_DKK = NKEY * 8 / 512, N_DV = NKEY * 4 / 512, N_CONV = T * 96 / 512 / 3, N_DTT = T * 16 / 512;
  constexpr int TOT = N_Q + N_KV + N_DQ + N_DKK + N_DV + N_CONV + N_DTT;
  for (int item = blockIdx.x; item < TOT; item += gridDim.x) {
    int it = item;
    if (it < N_Q) { mla_q_item(p, l, it, lds); continue; }
    it -= N_Q;
    if (it < N_KV) { mla_kv_item(p, l, it, lds); continue; }
    it -= N_KV;
    if (it < N_DQ) { diff_qk_thread(p, l, it * 512 + get_tid(), false); continue; }
    it -= N_DQ;
    if (it < N_DKK) { diff_qk_thread(p, l, it * 512 + get_tid(), true); continue; }
    it -= N_DKK;
    if (it < N_DV) { diff_v_thread(p, l, it * 512 + get_tid(), lds + 53248 + (get_tid() >> 6) * 9216); continue; }
    it -= N_DV;
    if (it < N_CONV) { conv_threads<3>(p, l, it * 512 + get_tid(), N_CONV * 512); continue; }
    it -= N_CONV;
    dt_thread(p, l, it * 512 + get_tid());
  }
}

DI void wave_scan2(float e0, float e1, float& o0, float& o1) {
  const int lane = get_tid() & 63;
  const float s = e0 + e1;
  float inc = s;
#pragma unroll
  for (int o = 1; o < 64; o <<= 1) { const float t = __shfl_up(inc, o); if (lane >= o) inc += t; }
  const float excl = inc - s;
  o0 = excl + e0; o1 = excl + s;
}
DI void ssd_dt_load(const Params& p, int cg_, int h, float& d0, float& d1) {
  const int lane = get_tid() & 63, w = get_tid4() >> 6;
  const float* dt = (const float*)(p.ws + OFF_DT) + (size_t)cg_ * 128 * 16;
  d0 = 0.f; d1 = 0.f;
  if (w == 0) { d0 = dt[(2 * lane) * 16 + h]; d1 = dt[(2 * lane + 1) * 16 + h]; }
  else if (w == 1) { d0 = dt[(127 - 2 * lane) * 16 + 8 + h]; d1 = dt[(126 - 2 * lane) * 16 + 8 + h]; }
}
DI void ssd_scalars_from(const Params& p, int l, int h, float d0, float d1, float* acf, float* sb, float* dtf, float* dtb) {
  const int lane = get_tid() & 63, w = get_tid4() >> 6;
  if (w == 0) {
    const float a = -__expf(p.in[30][(size_t)l * 16 + h]);
    float o0, o1; wave_scan2(d0 * a, d1 * a, o0, o1);
    acf[2 * lane] = o0; acf[2 * lane + 1] = o1; dtf[2 * lane] = d0; dtf[2 * lane + 1] = d1;
  } else if (w == 1) {
    const float a = -__expf(p.in[30][(size_t)l * 16 + 8 + h]);
    const int j0 = 127 - 2 * lane, j1 = 126 - 2 * lane;
    float o0, o1; wave_scan2(d0 * a, d1 * a, o0, o1);
    sb[j0] = o0; sb[j1] = o1; dtb[j0] = d0; dtb[j1] = d1;
  }
}
DI void ssd_scalars(const Params& p, int l, int cg_, int h, float* acf, float* sb, float* dtf, float* dtb) {
  const int lane = get_tid() & 63, w = get_tid4() >> 6;
  const float* dt = (const float*)(p.ws + OFF_DT) + (size_t)cg_ * 128 * 16;
  if (w == 0) {
    const float a = -__expf(p.in[30][(size_t)l * 16 + h]);
    const float d0 = dt[(2 * lane) * 16 + h], d1 = dt[(2 * lane + 1) * 16 + h];
    float o0, o1; wave_scan2(d0 * a, d1 * a, o0, o1);
    acf[2 * lane] = o0; acf[2 * lane + 1] = o1; dtf[2 * lane] = d0; dtf[2 * lane + 1] = d1;
  } else if (w == 1) {
    const float a = -__expf(p.in[30][(size_t)l * 16 + 8 + h]);
    const int j0 = 127 - 2 * lane, j1 = 126 - 2 * lane;
    const float d0 = dt[j0 * 16 + 8 + h], d1 = dt[j1 * 16 + 8 + h];
    float o0, o1; wave_scan2(d0 * a, d1 * a, o0, o1);
    sb[j0] = o0; sb[j1] = o1; dtb[j0] = d0; dtb[j1] = d1;
  }
}

DI void ssd_states_item(const Params& p, int l, int item, char* lds) {
  const int tid = get_tid4(), lane = tid & 63, w = tid >> 6, l32 = lane & 31, half = lane >> 5;
  const int cg_ = item >> 3, h = item & 7, g = h >> 2;
  char* XF = lds; char* XB = lds + 64 * PITCH128; char* BT = lds + 2 * 64 * PITCH128;
  float* sc = (float*)(lds + 3 * 64 * PITCH128);
  float* acf = sc, *sb = sc + 128, *dtf = sc + 256, *dtb = sc + 384;
  __syncthreads();
  ssd_scalars(p, l, cg_, h, acf, sb, dtf, dtb);
  __syncthreads();
  const bf16_t* xbc = (const bf16_t*)(p.ws + OFF_XBC) + (size_t)cg_ * 128 * 768;
  const float aL = acf[127], s0 = sb[0];
#pragma unroll
  for (int it = 0; it < 2; ++it) {
    const int t = tid + 256 * it, jp = t & 63, pc = t >> 6, j0 = 2 * jp;
    const u32x4 x0 = *(const u32x4*)(xbc + (size_t)j0 * 768 + h * 64 + pc * 8), x1 = *(const u32x4*)(xbc + (size_t)(j0 + 1) * 768 + h * 64 + pc * 8);
    const u32x4 b0 = *(const u32x4*)(xbc + (size_t)j0 * 768 + 512 + g * 64 + pc * 8), b1 = *(const u32x4*)(xbc + (size_t)(j0 + 1) * 768 + 512 + g * 64 + pc * 8);
    const float wf0 = __expf(aL - acf[j0]) * dtf[j0], wf1 = __expf(aL - acf[j0 + 1]) * dtf[j0 + 1];
    const float wb0 = __expf(s0 - sb[j0]) * dtb[j0], wb1 = __expf(s0 - sb[j0 + 1]) * dtb[j0 + 1];
#pragma unroll
    for (int e = 0; e < 4; ++e) {
      const float a0 = bflo(x0[e]), a1 = bfhi(x0[e]), c0 = bflo(x1[e]), c1 = bfhi(x1[e]);
      const int pr = pc * 8 + 2 * e;
      *(unsigned*)(XF + pr * PITCH128 + j0 * 2) = pk2(a0 * wf0, c0 * wf1);
      *(unsigned*)(XF + (pr + 1) * PITCH128 + j0 * 2) = pk2(a1 * wf0, c1 * wf1);
      *(unsigned*)(XB + pr * PITCH128 + j0 * 2) = pk2(a0 * wb0, c0 * wb1);
      *(unsigned*)(XB + (pr + 1) * PITCH128 + j0 * 2) = pk2(a1 * wb0, c1 * wb1);
      *(unsigned*)(BT + pr * PITCH128 + j0 * 2) = (b0[e] & 0xffffu) | (b1[e] << 16);
      *(unsigned*)(BT + (pr + 1) * PITCH128 + j0 * 2) = (b0[e] >> 16) | (b1[e] & 0xffff0000u);
    }
  }
  __syncthreads();
  const int dir = w >> 1, pb = w & 1;
  const char* Xs = (dir ? XB : XF) + (pb * 32 + l32) * PITCH128 + half * 16;
  const char* Bsrc = BT + l32 * PITCH128 + half * 16;
  f32x16 acc[2] = {zero16(), zero16()};
#pragma unroll
  for (int s = 0; s < 8; ++s) {
    const bf16x8 a = *(const bf16x8*)(Xs + s * 32);
    const bf16x8 b0 = *(const bf16x8*)(Bsrc + s * 32), b1 = *(const bf16x8*)(Bsrc + 32 * PITCH128 + s * 32);
    acc[0] = MFMA32(a, b0, acc[0]); acc[1] = MFMA32(a, b1, acc[1]);
  }
  float* ST = (float*)(p.ws + OFF_ST) + ((size_t)(cg_ * 8 + h) * 2 + dir) * 4096;
#pragma unroll
  for (int nb = 0; nb < 2; ++nb)
#pragma unroll
    for (int r = 0; r < 16; ++r) ST[(pb * 32 + crow(r, half)) * 64 + nb * 32 + l32] = acc[nb][r];
  if (tid == 0) { float* cd = (float*)(p.ws + OFF_CDEC) + (size_t)(cg_ * 8 + h) * 2; cd[0] = __expf(aL); cd[1] = __expf(s0); }
}

template <int NC>
DI void ssd_scan_thread(const Params& p, int l, int seq, int r, int cg0, f32x4 hs) {
  const float* ST = (const float*)(p.ws + OFF_ST);
  bf16_t* HP = (bf16_t*)(p.ws + OFF_HP);
  const float* CD = (const float*)(p.ws + OFF_CDEC);
  const int h = r >> 11, dir = (r >> 10) & 1, pn = r & 1023;
  f32x4 st[NC]; float dec[NC];
#pragma unroll
  for (int c = 0; c < NC; ++c) {
    const int cgi = cg0 + (dir ? NC - 1 - c : c);
    st[c] = *(const f32x4*)(ST + ((size_t)(cgi * 8 + h) * 2 + dir) * 4096 + pn * 4);
    dec[c] = CD[(size_t)(cgi * 8 + h) * 2 + dir];
  }
#pragma unroll
  for (int c = 0; c < NC; ++c) {
    const int cgi = cg0 + (dir ? NC - 1 - c : c);
    u32x2 hv; hv[0] = pk2(hs[0], hs[1]); hv[1] = pk2(hs[2], hs[3]);
    *(u32x2*)(HP + ((size_t)(cgi * 8 + h) * 2 + dir) * 4096 + pn * 4) = hv;
    hs = dec[c] * hs + st[c];
  }
  if (seq < 16) *(f32x4*)(p.out + O_SSM + ((((size_t)seq * DEPTH + l) * 2 + dir) * 8 + h) * 4096 + pn * 4) = hs;
}
DI void ssd_scan_phase(const Params& p, int l) {
  constexpr int PER_SEQ = 8 * 2 * 64 * 16;
  for (int item = blockIdx.x; item < 20 * PER_SEQ / 512; item += gridDim.x) {
    const int idx = item * 512 + get_tid();
    const int sq = idx / PER_SEQ; const int r = idx % PER_SEQ;
    const int seq = (sq < 4) ? 16 + sq : sq - 4;
    if (seq < 16) ssd_scan_thread<2>(p, l, seq, r, 2 * seq, (f32x4){0.f, 0.f, 0.f, 0.f});
    else {
      const int dir = (r >> 10) & 1, h = r >> 11, pn = r & 1023;
      const f32x4 h0 = *(const f32x4*)(p.in[6] + ((((size_t)(seq - 16) * DEPTH + l) * 2 + dir) * 8 + h) * 4096 + pn * 4);
      ssd_scan_thread<16>(p, l, seq, r, 32 + 16 * (seq - 16), h0);
    }
  }
}

DI void ssd_y_item(const Params& p, int l, int cg_, char* lds_blk) {
  const int tid = get_tid4(), lane = tid & 63, w = tid >> 6, l32 = lane & 31, half = lane >> 5;
  const int g = get_hb();
  char* lds = lds_blk + g * HALF_LDS;
  char* Bs = lds; char* Cs = lds + 128 * PITCH64; char* XT = lds + 2 * 128 * PITCH64;
  char* Hf = XT + 64 * PITCH128; char* Hb = Hf + 64 * PITCH64;
  float* sc = (float*)(Hb + 64 * PITCH64);
  float* acf = sc, *sb = sc + 128, *dtf = sc + 256, *dtb = sc + 384;
  const int tok0 = cg_ * 128;
  const int i = w * 32 + l32, tok = tok0 + i;
  const bf16_t* xbc = (const bf16_t*)(p.ws + OFF_XBC) + (size_t)tok0 * 768;
  const bf16_t* proj = (const bf16_t*)(p.ws + OFF_PROJ);
  bf16_t* mix = (bf16_t*)(p.ws + OFF_MIX);
  float ssq = 0.f;
  {
    __syncthreads();
#pragma unroll
    for (int it = 0; it < 4; ++it) {
      const int t = tid + 256 * it, r = t >> 3, c = (t & 7) * 8;
      *(u32x4*)(Bs + r * PITCH64 + c * 2) = *(const u32x4*)(xbc + (size_t)r * 768 + 512 + g * 64 + c);
      *(u32x4*)(Cs + r * PITCH64 + c * 2) = *(const u32x4*)(xbc + (size_t)r * 768 + 640 + g * 64 + c);
    }
    __syncthreads();
    u32x4 xr[2][2]; float dpre0, dpre1;
    auto head_loads = [&](int h) {
#pragma unroll
      for (int it = 0; it < 2; ++it) {
        const int t = tid + 256 * it, jp = t & 63, pc = t >> 6, j0 = 2 * jp;
        xr[it][0] = *(const u32x4*)(xbc + (size_t)j0 * 768 + h * 64 + pc * 8);
        xr[it][1] = *(const u32x4*)(xbc + (size_t)(j0 + 1) * 768 + h * 64 + pc * 8);
      }
      ssd_dt_load(p, cg_, h, dpre0, dpre1);
    };
    head_loads(g * 4);
#pragma unroll 1
    for (int hh = 0; hh < 4; ++hh) {
      const int h = g * 4 + hh;
      u32x4 hr[2][2];
      {
        const bf16_t* hp = (const bf16_t*)(p.ws + OFF_HP) + (size_t)(cg_ * 8 + h) * 2 * 4096;
#pragma unroll
        for (int it = 0; it < 2; ++it) { const int t = tid + 256 * it, r = t >> 3, c = (t & 7) * 8; hr[it][0] = *(const u32x4*)(hp + r * 64 + c); hr[it][1] = *(const u32x4*)(hp + 4096 + r * 64 + c); }
      }
      __syncthreads();
#pragma unroll
      for (int it = 0; it < 2; ++it) {
        const int t = tid + 256 * it, jp = t & 63, pc = t >> 6, j0 = 2 * jp;
        const u32x4 x0 = xr[it][0], x1 = xr[it][1];
#pragma unroll
        for (int e = 0; e < 4; ++e) {
          const int pr = pc * 8 + 2 * e;
          *(unsigned*)(XT + pr * PITCH128 + j0 * 2) = (x0[e] & 0xffffu) | (x1[e] << 16);
          *(unsigned*)(XT + (pr + 1) * PITCH128 + j0 * 2) = (x0[e] >> 16) | (x1[e] & 0xffff0000u);
        }
        const int r = t >> 3, c = (t & 7) * 8;
        *(u32x4*)(Hf + r * PITCH64 + c * 2) = hr[it][0];
        *(u32x4*)(Hb + r * PITCH64 + c * 2) = hr[it][1];
      }
      ssd_scalars_from(p, l, h, dpre0, dpre1, acf, sb, dtf, dtb);
      __syncthreads();
      if (hh < 3) head_loads(h + 1);
      const float aif = acf[i], aib = sb[i];
      f32x16 Y[2] = {zero16(), zero16()};
      int iv = i, hv = half;
      asm volatile("" : "+v"(iv), "+v"(hv));
      bf16x8 cfr[4];
#pragma unroll
      for (int s = 0; s < 4; ++s) cfr[s] = *(const bf16x8*)(Cs + i * PITCH64 + s * 32 + hv * 16);
      u32x2 xpre[8], zpre[8];
#pragma unroll
      for (int q8 = 0; q8 < 8; ++q8) {
        const int pc = (q8 >> 2) * 32 + 8 * (q8 & 3) + 4 * hv;
        xpre[q8] = *(const u32x2*)(xbc + (size_t)i * 768 + h * 64 + pc);
        zpre[q8] = *(const u32x2*)(proj + (size_t)tok * NPROJP + C_Z + h * 64 + pc);
      }
#pragma unroll 1
      for (int jb = 0; jb < 4; ++jb) {
        f32x16 G = zero16();
#pragma unroll
        for (int s = 0; s < 4; ++s) {
          const bf16x8 a = *(const bf16x8*)(Bs + (jb * 32 + l32) * PITCH64 + s * 32 + hv * 16);
          G = MFMA32(a, cfr[s], G);
        }
        f32x16 m;
#pragma unroll
        for (int q = 0; q < 4; ++q) {
          const int jq = jb * 32 + 8 * q + 4 * hv;
          const f32x4 af4 = *(const f32x4*)(acf + jq), sb4 = *(const f32x4*)(sb + jq), df4 = *(const f32x4*)(dtf + jq), db4 = *(const f32x4*)(dtb + jq);
#pragma unroll
          for (int e = 0; e < 4; ++e) {
            const int j = jq + e;
            const bool lo_ = j < iv;
            const float arg = lo_ ? (aif - af4[e]) : (aib - sb4[e]);
            const float dsel = lo_ ? df4[e] : db4[e];
            float wgt = __expf(arg) * dsel;
            wgt = (j == iv) ? (df4[e] + db4[e]) : wgt;
            m[4 * q + e] = G[4 * q + e] * wgt;
          }
        }
#pragma unroll
        for (int s = 0; s < 2; ++s) {
          u32x4 mf; mf[0] = pk2(m[8 * s], m[8 * s + 1]); mf[1] = pk2(m[8 * s + 2], m[8 * s + 3]); mf[2] = pk2(m[8 * s + 4], m[8 * s + 5]); mf[3] = pk2(m[8 * s + 6], m[8 * s + 7]);
          const bf16x8 mfr = __builtin_bit_cast(bf16x8, mf);
#pragma unroll
          for (int pb = 0; pb < 2; ++pb) {
            const char* xa = XT + (pb * 32 + l32) * PITCH128 + (jb * 32 + 16 * s + 4 * hv) * 2;
            u32x4 av; const u32x2 lo = *(const u32x2*)xa, hi = *(const u32x2*)(xa + 16);
            av[0] = lo[0]; av[1] = lo[1]; av[2] = hi[0]; av[3] = hi[1];
            Y[pb] = MFMA32(__builtin_bit_cast(bf16x8, av), mfr, Y[pb]);
          }
        }
      }
      {
        const float ef = __expf(aif), eb = __expf(aib);
#pragma unroll
        for (int pb = 0; pb < 2; ++pb) {
#pragma unroll
          for (int d = 0; d < 2; ++d) {
            f32x16 tf = zero16();
            const char* Hs = d ? Hb : Hf;
#pragma unroll
            for (int s = 0; s < 4; ++s) {
              const bf16x8 a = *(const bf16x8*)(Hs + (pb * 32 + l32) * PITCH64 + s * 32 + hv * 16);
              tf = MFMA32(a, cfr[s], tf);
            }
            const float ee = d ? eb : ef;
#pragma unroll
            for (int r = 0; r < 16; ++r) Y[pb][r] += ee * tf[r];
          }
        }
      }
      const float Dh = p.in[32][(size_t)l * 8 + h];
#pragma unroll
      for (int pb = 0; pb < 2; ++pb) {
        f32x16 yb;
#pragma unroll
        for (int q = 0; q < 4; ++q) {
          const u32x2 xv = xpre[pb * 4 + q];
          const u32x2 zv = zpre[pb * 4 + q];
          float y[4] = {Y[pb][4 * q] + Dh * bflo(xv[0]), Y[pb][4 * q + 1] + Dh * bfhi(xv[0]), Y[pb][4 * q + 2] + Dh * bflo(xv[1]), Y[pb][4 * q + 3] + Dh * bfhi(xv[1])};
          const float z[4] = {bflo(zv[0]), bfhi(zv[0]), bflo(zv[1]), bfhi(zv[1])};
#pragma unroll
          for (int e = 0; e < 4; ++e) { y[e] *= z[e] / (1.f + __expf(-z[e])); ssq += y[e] * y[e]; yb[4 * q + e] = y[e]; }
        }
        store_block_bf16(mix + (size_t)tok * 1024 + 512 + h * 64 + pb * 32, yb, half);
      }
    }
  }
  ssq += xor32(ssq);
  sc[512 + i] = ssq;
  __syncthreads();
  ssq += ((const float*)(lds_blk + (1 - g) * HALF_LDS + (2 * 128 * PITCH64 + 64 * PITCH128 + 2 * 64 * PITCH64)))[512 + i];
  const float rstd = rsqrtf(ssq * (1.f / 512.f) + EPS);
  const float* gn = p.in[33] + (size_t)l * 512;
  u32x4 vv[16];
#pragma unroll
  for (int e = 0; e < 16; ++e) {
    const int ch = (g * 4 + (e >> 2)) * 64 + ((e >> 1) & 1) * 32 + 16 * (e & 1) + 8 * half;
    vv[e] = *(const u32x4*)(mix + (size_t)tok * 1024 + 512 + ch);
  }
#pragma unroll
  for (int hq = 0; hq < 4; ++hq) {
    f32x4 gg[8];
#pragma unroll
    for (int e = 0; e < 4; ++e) {
      const int ch = (g * 4 + hq) * 64 + ((e >> 1) & 1) * 32 + 16 * (e & 1) + 8 * half;
      gg[2 * e] = *(const f32x4*)(gn + ch); gg[2 * e + 1] = *(const f32x4*)(gn + ch + 4);
    }
#pragma unroll
    for (int e = 0; e < 4; ++e) {
      const int ch = (g * 4 + hq) * 64 + ((e >> 1) & 1) * 32 + 16 * (e & 1) + 8 * half;
      const u32x4 v = vv[hq * 4 + e];
      u32x4 o;
      o[0] = pk2(bflo(v[0]) * rstd * gg[2 * e][0], bfhi(v[0]) * rstd * gg[2 * e][1]); o[1] = pk2(bflo(v[1]) * rstd * gg[2 * e][2], bfhi(v[1]) * rstd * gg[2 * e][3]);
      o[2] = pk2(bflo(v[2]) * rstd * gg[2 * e + 1][0], bfhi(v[2]) * rstd * gg[2 * e + 1][1]); o[3] = pk2(bflo(v[3]) * rstd * gg[2 * e + 1][2], bfhi(v[3]) * rstd * gg[2 * e + 1][3]);
      *(u32x4*)(mix + (size_t)tok * 1024 + 512 + ch) = o;
    }
  }
}

struct SeqInfo { int tok0, L, kbase, nk; };
DI SeqInfo seq_info(int s) { SeqInfo r; if (s < 16) { r.tok0 = s * 256; r.L = 256; r.kbase = s * 256; r.nk = 256; } else { r.tok0 = TP + (s - 16) * 2048; r.L = 2048; r.kbase = TP + (s - 16) * 2304; r.nk = 2304; } return r; }

DI void attn_mla_item(const Params& p, int item, char* lds) {
  const int tid = get_tid4(), lane = tid & 63, w = tid >> 6, l32 = lane & 31, half = lane >> 5;
  int seq, head, qb;
  if (item < 256) { seq = 16 + (item >> 6); head = (item >> 4) & 3; qb = item & 15; }
  else { const int it = item - 256; seq = it >> 3; head = (it >> 1) & 3; qb = it & 1; }
  const SeqInfo si = seq_info(seq);
  const int tok = si.tok0 + qb * 128 + w * 32 + l32;
  const bf16_t* qa = (const bf16_t*)(p.ws + OFF_QA) + (size_t)tok * 384 + head * 96;
  bf16x8 qf[6];
#pragma unroll
  for (int s = 0; s < 6; ++s) qf[s] = *(const bf16x8*)(qa + 16 * s + 8 * half);
  constexpr int KT = 64 * PITCH96, VT = 64 * PITCH64;
  char* Ks = lds; char* Vs = lds + 2 * KT;
  const bf16_t* kg = (const bf16_t*)(p.ws + OFF_KA) + (size_t)si.kbase * 384 + head * 96;
  const bf16_t* vg = (const bf16_t*)(p.ws + OFF_VAT) + (size_t)head * 64 * NKEY + si.kbase;
  u32x4 rk[3], rv[2];
  auto gload = [&](int t0) {
#pragma unroll
    for (int i = 0; i < 3; ++i) { const int c = tid + 256 * i, r = c / 12, cc = c % 12; rk[i] = *(const u32x4*)(kg + (size_t)(t0 + r) * 384 + cc * 8); }
#pragma unroll
    for (int i = 0; i < 2; ++i) { const int c = tid + 256 * i, r = c >> 3, cc = c & 7; rv[i] = *(const u32x4*)(vg + (size_t)r * NKEY + t0 + cc * 8); }
  };
  auto lstore = [&](int buf) {
#pragma unroll
    for (int i = 0; i < 3; ++i) { const int c = tid + 256 * i, r = c / 12, cc = c % 12; *(u32x4*)(Ks + buf * KT + r * PITCH96 + cc * 16) = rk[i]; }
#pragma unroll
    for (int i = 0; i < 2; ++i) { const int c = tid + 256 * i, r = c >> 3, cc = c & 7; *(u32x4*)(Vs + buf * VT + r * PITCH64 + cc * 16) = rv[i]; }
  };
  f32x16 O[2] = {zero16(), zero16()};
  float mrun = -1e30f, lsum = 0.f;
  const int nt = si.nk / 64;
  __syncthreads();
  gload(0); lstore(0);
  __syncthreads();
#pragma unroll 1
  for (int t = 0; t < nt; ++t) {
    const int cur = t & 1;
    if (t + 1 < nt) gload((t + 1) * 64);
    f32x16 S[2];
#pragma unroll
    for (int kb = 0; kb < 2; ++kb) {
      S[kb] = zero16();
#pragma unroll
      for (int s = 0; s < 6; ++s) {
        const bf16x8 a = *(const bf16x8*)(Ks + cur * KT + (kb * 32 + l32) * PITCH96 + s * 32 + half * 16);
        S[kb] = MFMA32(a, qf[s], S[kb]);
      }
    }
    float mx = S[0][0];
#pragma unroll
    for (int r = 0; r < 16; ++r) { mx = fmaxf(mx, S[0][r]); mx = fmaxf(mx, S[1][r]); }
    mx = fmaxf(mx, xor32(mx));
    if (__any(mx > mrun + 8.f)) {
      const float mnew = fmaxf(mrun, mx);
      const float alpha = __builtin_amdgcn_exp2f(mrun - mnew);
      mrun = mnew;
      lsum *= alpha;
#pragma unroll
      for (int r = 0; r < 16; ++r) { O[0][r] *= alpha; O[1][r] *= alpha; }
    }
    float ps = 0.f;
#pragma unroll
    for (int kb = 0; kb < 2; ++kb)
#pragma unroll
      for (int r = 0; r < 16; ++r) { const float e = __builtin_amdgcn_exp2f(S[kb][r] - mrun); S[kb][r] = e; ps += e; }
    lsum += ps;
#pragma unroll
    for (int kb = 0; kb < 2; ++kb)
#pragma unroll
      for (int s = 0; s < 2; ++s) {
        u32x4 pf; pf[0] = pk2(S[kb][8 * s], S[kb][8 * s + 1]); pf[1] = pk2(S[kb][8 * s + 2], S[kb][8 * s + 3]); pf[2] = pk2(S[kb][8 * s + 4], S[kb][8 * s + 5]); pf[3] = pk2(S[kb][8 * s + 6], S[kb][8 * s + 7]);
        const bf16x8 pfr = __builtin_bit_cast(bf16x8, pf);
#pragma unroll
        for (int dvb = 0; dvb < 2; ++dvb) {
          const char* va = Vs + cur * VT + (dvb * 32 + l32) * PITCH64 + (kb * 32 + 16 * s + 4 * half) * 2;
          u32x4 av; const u32x2 lo = *(const u32x2*)va, hi = *(const u32x2*)(va + 16);
          av[0] = lo[0]; av[1] = lo[1]; av[2] = hi[0]; av[3] = hi[1];
          O[dvb] = MFMA32(__builtin_bit_cast(bf16x8, av), pfr, O[dvb]);
        }
      }
    if (t + 1 < nt) lstore(cur ^ 1);
    __syncthreads();
  }
  lsum += xor32(lsum);
  const float inv = 1.f / lsum;
  bf16_t* mix = (bf16_t*)(p.ws + OFF_MIX) + (size_t)tok * 1024 + head * 64;
#pragma unroll
  for (int dvb = 0; dvb < 2; ++dvb) {
#pragma unroll
    for (int r = 0; r < 16; ++r) O[dvb][r] *= inv;
    store_block_bf16(mix + dvb * 32, O[dvb], half);
  }
}

constexpr int PITCH32 = 80;
DI void attn_diff_item(const Params& p, int l, int item, char* lds_blk) {
  const int tid = get_tid4(), lane = tid & 63, w = tid >> 6, l32 = lane & 31, half = lane >> 5;
  const int hbk = get_hb();
  char* lds = lds_blk + hbk * HALF_LDS;
  int seq, head, qb;
  if (item < 256) { seq = 16 + (item >> 6); head = (item >> 4) & 3; qb = item & 15; }
  else { const int it = item - 256; seq = it >> 3; head = (it >> 1) & 3; qb = it & 1; }
  const SeqInfo si = seq_info(seq);
  const int tok = si.tok0 + qb * 128 + w * 32 + l32;
  constexpr int KT = 64 * PITCH32, VT = 64 * PITCH64;
  char* Ks = lds; char* Vs = lds + 2 * KT;
  const bf16_t* vg = (const bf16_t*)(p.ws + OFF_VDT) + (size_t)head * 64 * NKEY + si.kbase;
  const int nt = si.nk / 64;
  const float lam_init = ((const float*)(p.ws + OFF_LAM))[l * 2 + 1];
  const float lam = ((const float*)(p.ws + OFF_LAM))[l * 2];
  f32x16 R[2] = {zero16(), zero16()};
#pragma unroll 1
  for (int mp = hbk; mp < hbk + 1; ++mp) {
    const bf16_t* qd = (const bf16_t*)(p.ws + OFF_QD) + (size_t)tok * 256 + head * 64 + mp * 32;
    bf16x8 qf[2];
#pragma unroll
    for (int s = 0; s < 2; ++s) qf[s] = *(const bf16x8*)(qd + 16 * s + 8 * half);
    const bf16_t* kg = (const bf16_t*)(p.ws + OFF_KD) + (size_t)si.kbase * 256 + head * 64 + mp * 32;
    u32x4 rk, rv[2];
    auto gload = [&](int t0) {
      rk = *(const u32x4*)(kg + (size_t)(t0 + (tid >> 2)) * 256 + (tid & 3) * 8);
#pragma unroll
      for (int i = 0; i < 2; ++i) { const int c = tid + 256 * i, r = c >> 3, cc = c & 7; rv[i] = *(const u32x4*)(vg + (size_t)r * NKEY + t0 + cc * 8); }
    };
    auto lstore = [&](int buf) {
      *(u32x4*)(Ks + buf * KT + (tid >> 2) * PITCH32 + (tid & 3) * 16) = rk;
#pragma unroll
      for (int i = 0; i < 2; ++i) { const int c = tid + 256 * i, r = c >> 3, cc = c & 7; *(u32x4*)(Vs + buf * VT + r * PITCH64 + cc * 16) = rv[i]; }
    };
    f32x16 O[2] = {zero16(), zero16()};
    float mrun = -1e30f, lsum = 0.f;
    __syncthreads();
    gload(0); lstore(0);
    __syncthreads();
#pragma unroll 1
    for (int t = 0; t < nt; ++t) {
      const int cur = t & 1;
      if (t + 1 < nt) gload((t + 1) * 64);
      f32x16 S[2];
#pragma unroll
      for (int kb = 0; kb < 2; ++kb) {
        S[kb] = zero16();
#pragma unroll
        for (int s = 0; s < 2; ++s) {
          const bf16x8 a = *(const bf16x8*)(Ks + cur * KT + (kb * 32 + l32) * PITCH32 + s * 32 + half * 16);
          S[kb] = MFMA32(a, qf[s], S[kb]);
        }
      }
      float mx = S[0][0];
#pragma unroll
      for (int r = 0; r < 16; ++r) { mx = fmaxf(mx, S[0][r]); mx = fmaxf(mx, S[1][r]); }
      mx = fmaxf(mx, xor32(mx));
      if (__any(mx > mrun + 8.f)) {
        const float mnew = fmaxf(mrun, mx);
        const float alpha = __builtin_amdgcn_exp2f(mrun - mnew);
        mrun = mnew;
        lsum *= alpha;
#pragma unroll
        for (int r = 0; r < 16; ++r) { O[0][r] *= alpha; O[1][r] *= alpha; }
      }
      float ps = 0.f;
#pragma unroll
      for (int kb = 0; kb < 2; ++kb)
#pragma unroll
        for (int r = 0; r < 16; ++r) { const float e = __builtin_amdgcn_exp2f(S[kb][r] - mrun); S[kb][r] = e; ps += e; }
      lsum += ps;
#pragma unroll
      for (int kb = 0; kb < 2; ++kb)
#pragma unroll
        for (int s = 0; s < 2; ++s) {
          u32x4 pf; pf[0] = pk2(S[kb][8 * s], S[kb][8 * s + 1]); pf[1] = pk2(S[kb][8 * s + 2], S[kb][8 * s + 3]); pf[2] = pk2(S[kb][8 * s + 4], S[kb][8 * s + 5]); pf[3] = pk2(S[kb][8 * s + 6], S[kb][8 * s + 7]);
          const bf16x8 pfr = __builtin_bit_cast(bf16x8, pf);
#pragma unroll
          for (int dvb = 0; dvb < 2; ++dvb) {
            const char* va = Vs + cur * VT + (dvb * 32 + l32) * PITCH64 + (kb * 32 + 16 * s + 4 * half) * 2;
            u32x4 av; const u32x2 lo = *(const u32x2*)va, hi = *(const u32x2*)(va + 16);
            av[0] = lo[0]; av[1] = lo[1]; av[2] = hi[0]; av[3] = hi[1];
            O[dvb] = MFMA32(__builtin_bit_cast(bf16x8, av), pfr, O[dvb]);
          }
        }
      if (t + 1 < nt) lstore(cur ^ 1);
      __syncthreads();
    }
    lsum += xor32(lsum);
    const float coef = (mp == 0) ? 1.f / lsum : -lam / lsum;
#pragma unroll
    for (int dvb = 0; dvb < 2; ++dvb)
#pragma unroll
      for (int r = 0; r < 16; ++r) R[dvb][r] += O[dvb][r] * coef;
  }
  {
    constexpr int XO = 32768;
    float* xo = (float*)(lds + XO);
    if (hbk == 1) {
#pragma unroll
      for (int dvb = 0; dvb < 2; ++dvb)
#pragma unroll
        for (int r = 0; r < 16; ++r) xo[((w * 2 + dvb) * 16 + r) * 64 + lane] = R[dvb][r];
    }
    __syncthreads();
    if (hbk == 1) return;
    const float* xi = (const float*)(lds_blk + HALF_LDS + XO);
#pragma unroll
    for (int dvb = 0; dvb < 2; ++dvb)
#pragma unroll
      for (int r = 0; r < 16; ++r) R[dvb][r] += xi[((w * 2 + dvb) * 16 + r) * 64 + lane];
  }
  float ss = sumsq16(R[0]) + sumsq16(R[1]);
  ss += xor32(ss);
  const float rstd = rsqrtf(ss * (1.f / 64.f) + EPS) * (1.f - lam_init);
  const float* gs = p.in[27] + (size_t)l * 64;
  bf16_t* mix = (bf16_t*)(p.ws + OFF_MIX) + (size_t)tok * 1024 + 256 + head * 64;
#pragma unroll
  for (int dvb = 0; dvb < 2; ++dvb) {
    { const f32x16 gb = gain_block(gs + dvb * 32, half);
#pragma unroll
      for (int r = 0; r < 16; ++r) R[dvb][r] *= rstd * gb[r]; }
    store_block_bf16(mix + dvb * 32, R[dvb], half);
  }
}

DI void run_phase(const Params& p, int ph, char* lds, int* s_item, int vb) {
#ifdef ONLY_SUB
  const int l = (ph - 1) / 10, sub = ONLY_SUB;
  if (ONLY_SUB == 10) { setup_phase(p, lds); return; }
#else
  if (ph == 0) { setup_phase(p, lds); return; }
  const int l = (ph - 1) / 10, sub = (ph - 1) % 10;
#endif
  const float* modl = (const float*)(p.ws + OFF_MOD) + (size_t)l * 5 * 6144;
  switch (sub) {
    case 0: norm_phase(p, l, 0); break;
    case 1: {
      EpiInProj epi{(bf16_t*)(p.ws + OFF_PROJ), (float*)(p.ws + OFF_DT)};
      const bf16_t* A = (const bf16_t*)(p.ws + OFF_HBUF);
      const bf16_t* Bt = (const bf16_t*)(p.ws + OFF_WIN) + (size_t)l * NPROJP * 1024;
      gemm_phase<256>(A, 1024, Bt, 1024, 1024, 48, 10, lds, vb, epi);
    } break;
    case 2: prep_phase(p, l, lds); break;
    case 3: {
      const int hb = get_hb();
      for (int pair = blockIdx.x; pair < NCHUNK * 4; pair += gridDim.x) ssd_states_item(p, l, pair * 2 + hb, lds + hb * HALF_LDS);
    } break;
    case 4: ssd_scan_phase(p, l); break;
    case 5: {
      unsigned* ctr = (unsigned*)(p.ws + OFF_CTR) + l;
      const int hb = get_hb();
      for (;;) {
        __syncthreads();
        if (threadIdx.x == 0) *s_item = (int)atomicAdd(ctr, 1u);
        __syncthreads();
        const int it = *s_item;
        if (it >= 672) break;
        if (it < 96) ssd_y_item(p, l, it, lds);
        else if (it < 224) attn_mla_item(p, (it - 96) * 2 + hb, lds + hb * HALF_LDS);
        else if (it < 480) attn_diff_item(p, l, it - 224, lds);
        else if (it < 544) attn_mla_item(p, 256 + (it - 480) * 2 + hb, lds + hb * HALF_LDS);
        else attn_diff_item(p, l, 256 + (it - 544), lds);
      }
    } break;
    case 6: {
      EpiResid epi{l == 0 ? p.in[0] : nullptr, l == 0 ? p.in[1] : nullptr, (bf16_t*)(p.ws + OFF_XB), nullptr, modl + 2048};
      const bf16_t* A = (const bf16_t*)(p.ws + OFF_MIX);
      const bf16_t* Bt = (const bf16_t*)(p.ws + OFF_WOUT) + (size_t)l * 1024 * 1024;
      gemm_phase<192>(A, 1024, Bt, 1024, 1024, 64, 4, lds, vb, epi);
    } break;
    case 7: norm_phase(p, l, 1); break;
    case 8: {
      EpiFF1 epi{(bf16_t*)(p.ws + OFF_UBUF)};
      const bf16_t* A = (const bf16_t*)(p.ws + OFF_HBUF);
      const bf16_t* Bt = (const bf16_t*)(p.ws + OFF_WFF1) + (size_t)l * 4096 * 1024;
      gemm_phase<256>(A, 1024, Bt, 1024, 1024, 48, 16, lds, vb, epi);
    } break;
    case 9: {
      EpiResid epi{nullptr, nullptr, (bf16_t*)(p.ws + OFF_XB), l == DEPTH - 1 ? p.out : nullptr, modl + 5120};
      const bf16_t* A = (const bf16_t*)(p.ws + OFF_UBUF);
      const bf16_t* Bt = (const bf16_t*)(p.ws + OFF_WFF2) + (size_t)l * 1024 * 4096;
      gemm_phase<192>(A, 4096, Bt, 4096, 4096, 64, 4, lds, vb, epi);
    } break;
  }
}

constexpr int N_PHASES = 1 + 10 * DEPTH;

__global__ void __launch_bounds__(512, 2) fwd_megakernel(Params p) {
  __shared__ __attribute__((aligned(1024))) char lds[LDS_BYTES + 64];
  uint4& xb_words = *(uint4*)(lds + LDS_BYTES);
  int* s_item = (int*)(lds + LDS_BYTES + 16);
  if (p.ph_end - p.ph_begin == 1) { run_phase(p, p.ph_begin, lds, s_item, blockIdx.x); return; }
  if (p.ph_begin < 0) { cg::this_grid().sync(); return; }
  if (threadIdx.x == 0) xb_words = make_uint4(0u, 0u, 0u, 0u);
  __syncthreads();
  XcdBarrier b = xcd_barrier_post((unsigned*)(p.ws + OFF_BAR), (volatile LAS unsigned*)&xb_words);
  const int vb = blockIdx.x;
  for (int ph = p.ph_begin; ph < p.ph_end; ++ph) {
    run_phase(p, ph, lds, s_item, vb);
    if (ph + 1 < p.ph_end) xcd_barrier(b);
  }
}

extern "C" void kernel_launch(void* const* d_in, const int* in_sizes, int n_in, void* d_out, int out_size, void* d_ws, size_t ws_size, hipStream_t stream) {
  static int grid_blocks = 0;
  if (!grid_blocks) {
    int dev = 0, cus = 0, per_cu = 0;
    (void)hipGetDevice(&dev);
    (void)hipDeviceGetAttribute(&cus, hipDeviceAttributeMultiprocessorCount, dev);
    (void)hipOccupancyMaxActiveBlocksPerMultiprocessor(&per_cu, fwd_megakernel, 512, 0);
    if (per_cu > 1) per_cu = 1;
    if (per_cu < 1) per_cu = 1;
    grid_blocks = cus * per_cu;
  }
  Params p{};
  for (int i = 0; i < 36; ++i) p.in[i] = (const float*)d_in[i];
  p.out = (float*)d_out;
  p.ws = (char*)d_ws;
  (void)hipMemsetAsync(d_ws, 0, 16384, stream);
#if MULTI_LAUNCH
  for (int ph = 0; ph < N_PHASES; ++ph) {
    p.ph_begin = ph; p.ph_end = ph + 1;
    hipLaunchKernelGGL(fwd_megakernel, dim3(grid_blocks), dim3(512), 0, stream, p);
  }
#else
  p.ph_begin = 0; p.ph_end = N_PHASES;
  void* args[] = {&p};
  hipError_t e = hipLaunchCooperativeKernel((void*)fwd_megakernel, dim3(grid_blocks), dim3(512), args, 0, stream);
  if (e != hipSuccess) fprintf(stderr, "cooperative launch failed: %s (grid %d)\n", hipGetErrorString(e), grid_blocks);
#endif
}
```
